# Optimizing an MI355X kernel written in HIP

```python
import jax
import jax.numpy as jnp
from jax import lax
import numpy as np

D_MODEL = 1024
BATCH = 32
SEQ = 2048
DEPTH = 1

CHUNK = 64
N_META = 16
Q_BLOCK = 128
ROPE_THETA = 10000.0
NORM_EPS = 1e-6
NEG_INF = -1e30

FOX_HEADS = 8
FOX_HEAD_DIM = 64
DSA_HEADS = 8
Q_RANK = 256
KV_RANK = 128
QK_NOPE_DIM = 64
QK_ROPE_DIM = 32
V_HEAD_DIM = 64
IDX_HEADS = 4
IDX_HEAD_DIM = 64
IDX_ROPE_DIM = 32
IDX_TOPK_MAX = 256
N_EXPERTS = 32
TOP_K = 4
D_EXPERT = D_MODEL
SWIGLU_ALPHA = 1.702
SWIGLU_LIMIT = 7.0
EXPERT_BLOCK = 128

FOX_WIDTH = FOX_HEADS * FOX_HEAD_DIM
DSA_WIDTH = DSA_HEADS * V_HEAD_DIM
IN_SPLITS = (FOX_WIDTH, FOX_WIDTH, FOX_WIDTH, FOX_HEADS, Q_RANK, KV_RANK, QK_ROPE_DIM, IDX_HEAD_DIM, IDX_HEADS, D_MODEL, D_MODEL)
D_IN = sum(IN_SPLITS)

kernel_name = 'hybrid_fox_dsa_moe_meta_layer'


def rms_norm(x, g):
    xf = x.astype(jnp.float32)
    y = xf * lax.rsqrt(jnp.mean(xf * xf, axis=-1, keepdims=True) + NORM_EPS)
    return (y * g.astype(jnp.float32)).astype(x.dtype)


def layer_norm(x, g, b):
    xf = x.astype(jnp.float32)
    mu = jnp.mean(xf, axis=-1, keepdims=True)
    xc = xf - mu
    var = jnp.mean(xc * xc, axis=-1, keepdims=True)
    return (xc * lax.rsqrt(var + NORM_EPS) * g.astype(jnp.float32) + b.astype(jnp.float32)).astype(x.dtype)


def rope(x, pos):
    d = x.shape[-1]
    half = d // 2
    inv = ROPE_THETA ** (-jnp.arange(half, dtype=jnp.float32) / half)
    ang = pos.astype(jnp.float32)[:, None] * inv[None, :]
    ang = ang.reshape(ang.shape[:1] + (1,) * (x.ndim - 3) + (half,))
    cos, sin = jnp.cos(ang), jnp.sin(ang)
    x1 = x[..., :half].astype(jnp.float32)
    x2 = x[..., half:].astype(jnp.float32)
    return jnp.concatenate([x1 * cos - x2 * sin, x1 * sin + x2 * cos], axis=-1).astype(x.dtype)


def rope_partial(x, pos, n_rot):
    return jnp.concatenate([rope(x[..., :n_rot], pos), x[..., n_rot:]], axis=-1)


def chunk_ids(pos):
    return jnp.where(pos < N_META, 0, 1 + (pos - N_META) // CHUNK)


def chunk_end(last):
    if last < N_META:
        return N_META
    return N_META + CHUNK * (1 + (last - N_META) // CHUNK)


def fox_attention(q, k, v, log_f_cum, pos, n_valid):
    Tp, Dh = q.shape[1], q.shape[-1]
    scale = Dh ** -0.5
    outs = []
    for start in range(0, Tp, Q_BLOCK):
        end = start + Q_BLOCK
        s = jnp.einsum('bqhd,bkhd->bhqk', q[:, start:end], k[:, :end]).astype(jnp.float32) * scale
        f_q = jnp.transpose(log_f_cum[:, start:end], (0, 2, 1))[..., None]
        f_k = jnp.transpose(log_f_cum[:, :end], (0, 2, 1))[:, :, None, :]
        qpos, kpos = pos[start:end], pos[:end]
        allowed = (kpos[None, :] <= qpos[:, None]) & (kpos[None, :] < n_valid)
        s = jnp.where(allowed, s + f_q - f_k, NEG_INF)
        p = jax.nn.softmax(s, axis=-1).astype(v.dtype)
        outs.append(jnp.einsum('bhqk,bkhd->bqhd', p, v[:, :end]))
    return jnp.concatenate(outs, axis=1)


def dsa_attention(q_lat, q_rope, c_kv, k_rope, q_idx, k_idx, idx_w, pos, n_valid, k_sel):
    Tp = q_lat.shape[1]
    chunk = chunk_ids(pos)
    scale = (QK_NOPE_DIM + QK_ROPE_DIM) ** -0.5
    gather = jax.vmap(lambda a, i: a[i])
    outs = []
    for start in range(0, Tp, Q_BLOCK):
        end = start + Q_BLOCK
        kend = min(Tp, max(chunk_end(end - 1), k_sel))
        dots = jnp.einsum('bqhd,bkd->bhqk', q_idx[:, start:end], k_idx[:, :kend]).astype(jnp.float32)
        iscore = jnp.einsum('bqh,bhqk->bqk', idx_w[:, start:end].astype(jnp.float32), jax.nn.relu(dots)) * (IDX_HEAD_DIM ** -0.5)
        admissible = (chunk[:kend][None, :] <= chunk[start:end][:, None]) & (pos[:kend][None, :] < n_valid)
        iscore = jnp.where(admissible[None], iscore, NEG_INF)
        top_score, top_idx = lax.top_k(iscore, k_sel)
        sel_ok = top_score > 0.5 * NEG_INF
        kv_sel = gather(c_kv, top_idx)
        kr_sel = gather(k_rope, top_idx)
        s = (jnp.einsum('bqhr,bqkr->bhqk', q_lat[:, start:end], kv_sel)
             + jnp.einsum('bqhd,bqkd->bhqk', q_rope[:, start:end], kr_sel)).astype(jnp.float32) * scale
        s = jnp.where(sel_ok[:, None], s, NEG_INF)
        p = jax.nn.softmax(s, axis=-1).astype(kv_sel.dtype)
        outs.append(jnp.einsum('bhqk,bqkr->bqhr', p, kv_sel))
    return jnp.concatenate(outs, axis=1)


def hybrid_mixer(xn, pos, n_valid, k_sel, w_in, b_forget, q_norm_g, w_uq, kv_norm_g, w_uk, w_uv,
                 w_qidx, kidx_ln_g, kidx_ln_b, w_branch_a, w_branch_b, w_out):
    B, Tp, _ = xn.shape
    proj = xn @ w_in
    offs = [int(o) for o in np.cumsum(IN_SPLITS)[:-1]]
    qa, ka, va, fa, cq, ckv, kr, kidx, iw, ga, gb = jnp.split(proj, offs, axis=-1)

    qa = qa.reshape(B, Tp, FOX_HEADS, FOX_HEAD_DIM)
    ka = ka.reshape(B, Tp, FOX_HEADS, FOX_HEAD_DIM)
    va = va.reshape(B, Tp, FOX_HEADS, FOX_HEAD_DIM)
    log_f = jax.nn.log_sigmoid((fa + b_forget).astype(jnp.float32))
    log_f_cum = jnp.cumsum(log_f, axis=1)
    o_a = fox_attention(qa, ka, va, log_f_cum, pos, n_valid).reshape(B, Tp, FOX_WIDTH)

    cq_n = rms_norm(cq, q_norm_g)
    q = (cq_n @ w_uq).reshape(B, Tp, DSA_HEADS, QK_NOPE_DIM + QK_ROPE_DIM)
    q_nope, q_rope = q[..., :QK_NOPE_DIM], rope(q[..., QK_NOPE_DIM:], pos)
    q_lat = jnp.einsum('bthn,hnr->bthr', q_nope, w_uk)
    c_kv = rms_norm(ckv, kv_norm_g)
    k_rope = rope(kr, pos)
    q_idx = rope_partial((cq_n @ w_qidx).reshape(B, Tp, IDX_HEADS, IDX_HEAD_DIM), pos, IDX_ROPE_DIM)
    k_idx = rope_partial(layer_norm(kidx, kidx_ln_g, kidx_ln_b), pos, IDX_ROPE_DIM)
    idx_w = iw * (IDX_HEADS ** -0.5)
    o_lat = dsa_attention(q_lat, q_rope, c_kv, k_rope, q_idx, k_idx, idx_w, pos, n_valid, k_sel)
    o_b = jnp.einsum('bthr,hrv->bthv', o_lat, w_uv).reshape(B, Tp, DSA_WIDTH)

    merged = jax.nn.sigmoid(ga) * (o_a @ w_branch_a) + jax.nn.sigmoid(gb) * (o_b @ w_branch_b)
    return merged @ w_out


def moe_ffn(h, w_router, b_router, w_gate_up, b_gate_up, w_down, b_down):
    N, D = h.shape
    logits = (h @ w_router + b_router).astype(jnp.float32)
    top_val, top_idx = lax.top_k(logits, TOP_K)
    gate = jax.nn.softmax(top_val, axis=-1)
    flat_e = top_idx.reshape(-1)
    flat_tok = jnp.repeat(jnp.arange(N, dtype=jnp.int32), TOP_K)
    flat_gate = gate.reshape(-1)
    order = jnp.argsort(flat_e, stable=True)
    se = flat_e[order]
    counts = jnp.bincount(flat_e, length=N_EXPERTS)
    padded = (counts + EXPERT_BLOCK - 1) // EXPERT_BLOCK * EXPERT_BLOCK
    start = jnp.cumsum(counts) - counts
    pstart = jnp.cumsum(padded) - padded
    dest = pstart[se] + jnp.arange(N * TOP_K, dtype=jnp.int32) - start[se]
    n_slots = (-(-(N * TOP_K) // EXPERT_BLOCK) + N_EXPERTS) * EXPERT_BLOCK
    n_blocks = n_slots // EXPERT_BLOCK
    slot_tok = jnp.full((n_slots,), N, jnp.int32).at[dest].set(flat_tok[order])
    slot_gate = jnp.zeros((n_slots,), jnp.float32).at[dest].set(flat_gate[order])
    block_start = jnp.arange(n_blocks, dtype=jnp.int32) * EXPERT_BLOCK
    block_expert = jnp.minimum(jnp.searchsorted(jnp.cumsum(padded), block_start, side='right'), N_EXPERTS - 1)
    h_pad = jnp.concatenate([h, jnp.zeros((1, D), h.dtype)], axis=0)

    def expert_block(args):
        tok, e, g = args
        xb = h_pad[tok]
        gu = xb @ w_gate_up[e] + b_gate_up[e]
        x_glu, x_lin = gu[:, :D_EXPERT], gu[:, D_EXPERT:]
        x_glu = jnp.minimum(x_glu, SWIGLU_LIMIT)
        x_lin = jnp.clip(x_lin, -SWIGLU_LIMIT, SWIGLU_LIMIT)
        act = x_glu * jax.nn.sigmoid(SWIGLU_ALPHA * x_glu) * (x_lin + 1)
        yb = act @ w_down[e] + b_down[e]
        return yb * g[:, None].astype(yb.dtype)

    y = lax.map(expert_block, (slot_tok.reshape(n_blocks, EXPERT_BLOCK), block_expert,
                               slot_gate.reshape(n_blocks, EXPERT_BLOCK)))
    out = jnp.zeros((N + 1, D), y.dtype).at[slot_tok].add(y.reshape(n_slots, D))
    return out[:N].astype(h.dtype)


def setup_inputs(seed: int = 0) -> dict:
    key = jax.random.key(seed)
    ks = jax.random.split(key, 24)
    f32 = jnp.float32
    L = DEPTH

    def nrm(k, shape, scale):
        return jax.random.normal(k, shape, f32) * scale

    def gain(k, shape):
        return 1.0 + 0.02 * jax.random.normal(k, shape, f32)

    return {
        'x': nrm(ks[0], (BATCH, SEQ, D_MODEL), 1.0),
        'meta_tokens': nrm(ks[1], (N_META, D_MODEL), 1.0),
        'norm_mix_g': gain(ks[2], (L, D_MODEL)),
        'w_in': nrm(ks[3], (L, D_MODEL, D_IN), D_MODEL ** -0.5),
        'b_forget': nrm(ks[4], (L, FOX_HEADS), 0.1),
        'q_norm_g': gain(ks[5], (L, Q_RANK)),
        'w_uq': nrm(ks[6], (L, Q_RANK, DSA_HEADS * (QK_NOPE_DIM + QK_ROPE_DIM)), Q_RANK ** -0.5),
        'kv_norm_g': gain(ks[7], (L, KV_RANK)),
        'w_uk': nrm(ks[8], (L, DSA_HEADS, QK_NOPE_DIM, KV_RANK), KV_RANK ** -0.5),
        'w_uv': nrm(ks[9], (L, DSA_HEADS, KV_RANK, V_HEAD_DIM), KV_RANK ** -0.5),
        'w_qidx': nrm(ks[10], (L, Q_RANK, IDX_HEADS * IDX_HEAD_DIM), Q_RANK ** -0.5),
        'kidx_ln_g': gain(ks[11], (L, IDX_HEAD_DIM)),
        'kidx_ln_b': nrm(ks[12], (L, IDX_HEAD_DIM), 0.02),
        'w_branch_a': nrm(ks[13], (L, FOX_WIDTH, D_MODEL), FOX_WIDTH ** -0.5),
        'w_branch_b': nrm(ks[14], (L, DSA_WIDTH, D_MODEL), DSA_WIDTH ** -0.5),
        'w_out': nrm(ks[15], (L, D_MODEL, D_MODEL), D_MODEL ** -0.5),
        'norm_ffn_g': gain(ks[16], (L, D_MODEL)),
        'w_router': nrm(ks[17], (L, D_MODEL, N_EXPERTS), D_MODEL ** -0.5),
        'b_router': nrm(ks[18], (L, N_EXPERTS), 0.01),
        'w_gate_up': nrm(ks[19], (L, N_EXPERTS, D_MODEL, 2 * D_EXPERT), D_MODEL ** -0.5),
        'b_gate_up': nrm(ks[20], (L, N_EXPERTS, 2 * D_EXPERT), 0.01),
        'w_down': nrm(ks[21], (L, N_EXPERTS, D_EXPERT, D_MODEL), D_EXPERT ** -0.5),
        'b_down': nrm(ks[22], (L, N_EXPERTS, D_MODEL), 0.01),
        'norm_final_g': gain(ks[23], (D_MODEL,)),
    }


def reference(x, meta_tokens, norm_mix_g, w_in, b_forget, q_norm_g, w_uq, kv_norm_g, w_uk, w_uv,
              w_qidx, kidx_ln_g, kidx_ln_b, w_branch_a, w_branch_b, w_out, norm_ffn_g, w_router,
              b_router, w_gate_up, b_gate_up, w_down, b_down, norm_final_g):
    B, S, D = x.shape
    T = S + N_META
    Tp = -(-T // Q_BLOCK) * Q_BLOCK
    k_sel = min(IDX_TOPK_MAX, S // 4)
    pos = jnp.arange(Tp, dtype=jnp.int32)
    h = jnp.concatenate([jnp.broadcast_to(meta_tokens.astype(x.dtype)[None], (B, N_META, D)), x], axis=1)
    for l in range(DEPTH):
        xn = jnp.pad(rms_norm(h, norm_mix_g[l]), ((0, 0), (0, Tp - T), (0, 0)))
        mix = hybrid_mixer(xn, pos, T, k_sel, w_in[l], b_forget[l], q_norm_g[l], w_uq[l], kv_norm_g[l],
                           w_uk[l], w_uv[l], w_qidx[l], kidx_ln_g[l], kidx_ln_b[l], w_branch_a[l],
                           w_branch_b[l], w_out[l])
        h = h + mix[:, :T]
        hn = rms_norm(h, norm_ffn_g[l]).reshape(B * T, D)
        h = h + moe_ffn(hn, w_router[l], b_router[l], w_gate_up[l], b_gate_up[l], w_down[l], b_down[l]).reshape(B, T, D)
    return rms_norm(h, norm_final_g)[:, N_META:]
```

```cpp
#include <hip/hip_runtime.h>
#include <cstdio>
#include <cstdint>

#ifndef PHM
#define PHM 0xFFFFF
#endif
#define PH(k) if ((PHM >> (k)) & 1)
#ifndef REPM
#define REPM 0
#endif
#ifndef IDXREP
#define IDXREP 0
#endif
#ifndef SELHIST
#define SELP0 1
#define SELHIST 1
#endif
#ifndef P8REP
#define P8REP 0
#endif
#ifndef DSABL
#define DSABL 0
#endif
#ifndef DSACHECK
#define DSACHECK 0
#endif
#ifndef SELCHECK
#define SELCHECK 0
#endif
#define NREP(k) (((REPM >> (k)) & 1) ? 2 : 1)
#if REPM
#define REPBEG(k) { int nrep_ = NREP(k); asm volatile("" : "+s"(nrep_)); _Pragma("unroll 1") for (int rep_ = 0; rep_ < nrep_; ++rep_) {
#define REPEND(k) if (rep_ + 1 < nrep_) GRID_BAR(); } }
#else
#define REPBEG(k) {
#define REPEND(k) }
#endif
#ifndef DBG_STAGE
#define DBG_STAGE 3
#endif

#define GAS __attribute__((address_space(1)))
#define LAS __attribute__((address_space(3)))
typedef unsigned short bf16_t;
typedef short bf16x8 __attribute__((ext_vector_type(8)));
typedef short s16x4 __attribute__((ext_vector_type(4)));
typedef float f32x4 __attribute__((ext_vector_type(4)));
typedef float f32x2 __attribute__((ext_vector_type(2)));
typedef float f32x16 __attribute__((ext_vector_type(16)));
typedef unsigned u32x4 __attribute__((ext_vector_type(4)));
typedef unsigned u32x2 __attribute__((ext_vector_type(2)));
typedef __bf16 bf16x2_t __attribute__((ext_vector_type(2)));
typedef unsigned long long u64;

constexpr int NB = 32, SEQ = 2048, DM = 1024, NMETA = 16;
constexpr int M = NB * SEQ;
constexpr int TPB = 2112;
constexpr int NKT = 33;
constexpr int D_IN = 4076;
constexpr int NEXP = 32;
constexpr float EPS = 1e-6f;
constexpr float LOG2E = 1.4426950408889634f;
constexpr float FOX_C = 0.125f * LOG2E;
constexpr float DSA_C = 0.10206207261596575f * LOG2E;
constexpr float NEGBIG = -1.0e30f;

constexpr size_t MiB = 1u << 20;
constexpr size_t WS_CTL = 0, CTL_ZERO_BYTES = 1 * MiB;
constexpr size_t WS_TOPE = 1 * MiB, WS_TOPG = 2 * MiB, WS_LR = 3 * MiB, WS_TOKSLOT = 4 * MiB, WS_SLOTG = 5 * MiB;
constexpr size_t WS_BC = 6 * MiB + 512 * 1024, WS_TILEE = 6 * MiB + 768 * 1024, WS_GRP = 7 * MiB;
constexpr size_t WS_WIN_T = 16 * MiB, WS_WQ2_T = 24 * MiB, WS_WA_T = 25 * MiB, WS_WOB_T = 26 * MiB, WS_WOUT_T = 28 * MiB;
constexpr size_t WS_COS = 30 * MiB, WS_SIN = 30 * MiB + 256 * 1024, WS_PROJM = 30 * MiB + 512 * 1024, WS_RSTDQ = 30 * MiB + 768 * 1024;
constexpr size_t WS_IW = 31 * MiB, WS_BIAS = 32 * MiB, WS_MASKW = 35 * MiB;
constexpr size_t WS_OA = 408 * MiB;
constexpr size_t WS_XN = 52 * MiB, WS_OLAT = 52 * MiB, WS_QA = 180 * MiB, WS_KA = 244 * MiB, WS_VA = 310 * MiB, WS_CQ = 376 * MiB, WS_T7 = 408 * MiB;
constexpr size_t WS_XN8 = 950 * MiB, WS_WIN8 = 1014 * MiB;
constexpr size_t WS_VT8 = 888 * MiB;
constexpr size_t WS_SGA = 472 * MiB, WS_SGB = 600 * MiB, WS_KVR = 728 * MiB, WS_KIDX = 749 * MiB, WS_QIDX = 758 * MiB, WS_QL = 790 * MiB;
constexpr size_t WS_WGU_T = 16 * MiB, WS_WD_T = 80 * MiB, WS_XBY = 112 * MiB, WS_Y = WS_XBY  , WS_H1B = 600 * MiB  , WS_ACT = 728 * MiB, WS_END = 1024 * MiB;
constexpr float WSC = 32.0f, WSC_INV = 1.0f / 32.0f;
constexpr float QSC = 16.0f;
constexpr float PSC = 128.0f;
constexpr float OLSC = 16.0f;
constexpr int MAX_TILES = 1064;
constexpr int ACT_CAP_TILES = (int)((WS_END - WS_ACT) / (256 * 1024));
constexpr int MAXG = 8;
static_assert(WS_XBY + (size_t)MAX_TILES * 256 * 1024 <= WS_H1B && WS_H1B + (size_t)M * 2048 <= WS_ACT && WS_ACT + (size_t)MAX_TILES * 256 * 1024 <= WS_END && ACT_CAP_TILES >= MAX_TILES, "XBY/H1B/ACT");
static_assert(WS_MASKW + (size_t)M * NKT * 8 <= WS_XN, "maskw");
static_assert(WS_QL + (size_t)M * 1536 <= WS_VT8 && WS_VT8 + (size_t)NB * NKT * 128 * 64 <= WS_XN8 && WS_KVR + (size_t)NB * TPB * 192 <= WS_KIDX, "ql8 / vt8 / k8");

constexpr int CW_BAR = 4096;
constexpr int CW_KMAX = 1024;
constexpr int CW_ERR = 64;

constexpr int LDS_BYTES = 147456;
constexpr int MISC_OFF = LDS_BYTES - 512;

__device__ __forceinline__ unsigned pk2(float lo, float hi) { f32x2 v = {lo, hi}; bf16x2_t b = __builtin_convertvector(v, bf16x2_t); return __builtin_bit_cast(unsigned, b); }
__device__ __forceinline__ unsigned pk4_fp8(float a, float b, float c, float d) { int w = __builtin_amdgcn_cvt_pk_fp8_f32(a, b, 0, false); w = __builtin_amdgcn_cvt_pk_fp8_f32(c, d, w, true); return (unsigned)w; }
__device__ __forceinline__ float bf2f(unsigned short x) { return __uint_as_float((unsigned)x << 16); }
__device__ __forceinline__ float bflo(unsigned w) { return __uint_as_float(w << 16); }
__device__ __forceinline__ float bfhi(unsigned w) { return __uint_as_float(w & 0xffff0000u); }
__device__ __forceinline__ f32x4 ld4bf(const bf16_t* p) { const u32x2 w = *(const u32x2*)p; return (f32x4){bflo(w.x), bfhi(w.x), bflo(w.y), bfhi(w.y)}; }
template <int CTRL, int RM> __device__ __forceinline__ float dpp_addf(float v) { return v + __int_as_float(__builtin_amdgcn_update_dpp(0, __float_as_int(v), CTRL, RM, 0xf, false)); }
__device__ __forceinline__ float wave_sum(float v) {
    v = dpp_addf<0x111, 0xf>(v); v = dpp_addf<0x112, 0xf>(v); v = dpp_addf<0x114, 0xf>(v); v = dpp_addf<0x118, 0xf>(v);
    v = dpp_addf<0x142, 0xa>(v); v = dpp_addf<0x143, 0xc>(v);
    return __int_as_float(__builtin_amdgcn_readlane(__float_as_int(v), 63));
}
__device__ __forceinline__ float wave_max(float v) {
#pragma unroll
    for (int o = 1; o < 64; o <<= 1) v = fmaxf(v, __shfl_xor(v, o));
    return v;
}
__device__ __forceinline__ float fast_exp2(float x) { return __builtin_amdgcn_exp2f(x); }
__device__ __forceinline__ float fast_rcp(float x) { return __builtin_amdgcn_rcpf(x); }
__device__ __forceinline__ float sigmoidf_(float x) { return fast_rcp(1.0f + fast_exp2(-x * LOG2E)); }
__device__ __forceinline__ int crow(int r, int hi) { return (r & 3) + 8 * (r >> 2) + 4 * hi; }
__device__ __forceinline__ unsigned ld_agent(const unsigned* p) { return __hip_atomic_load(p, __ATOMIC_RELAXED, __HIP_MEMORY_SCOPE_AGENT); }
__device__ __forceinline__ int ld_agent_i(const int* p) { return (int)__hip_atomic_load((const unsigned*)p, __ATOMIC_RELAXED, __HIP_MEMORY_SCOPE_AGENT); }
#define LDS_WAIT() asm volatile("s_waitcnt lgkmcnt(0)" ::: "memory")

#define XB_TMO      128
#define XB_XCNT(j)  (256  + 64 * (j))
#define XB_XSUB(j)  (1280 + 64 * (j))
#define XB_XGEN(j)  (2304 + 64 * (j))
#define XB_TOP      3328
#define XB_TOPGEN   3392
#define XCD_BAR_WORDS 3456
#define XB_SPIN_CAP (1u << 24)
__device__ __forceinline__ unsigned xb_ld(unsigned* p)              { return __hip_atomic_load(p, __ATOMIC_RELAXED, __HIP_MEMORY_SCOPE_AGENT); }
__device__ __forceinline__ unsigned xb_add(unsigned* p, unsigned v) { return __hip_atomic_fetch_add(p, v, __ATOMIC_RELAXED, __HIP_MEMORY_SCOPE_AGENT); }
__device__ __forceinline__ unsigned xb_xcc_id() { return (unsigned)__builtin_amdgcn_s_getreg((3 << 11) | 20) & 0xFu; }
#define XB_SPIN(cond, bar) do { unsigned _sp = 0; while (cond) { __builtin_amdgcn_s_sleep(1); \
    if ((++_sp & 255u) == 0u) { if (xb_ld(&(bar)[XB_TMO])) break; if (_sp > XB_SPIN_CAP) { atomicAdd(&(bar)[XB_TMO], 1u); break; } } } } while (0)
struct XcdBarrier { unsigned* bar; unsigned x; volatile LAS unsigned* st; };
__device__ __forceinline__ XcdBarrier xcd_barrier_post(unsigned* bar, volatile LAS unsigned* st) {
    XcdBarrier b; b.bar = bar; b.x = xb_xcc_id(); b.st = st;
    if (threadIdx.x == 0) (void)xb_add(&bar[XB_XCNT(b.x)], 1u);
    return b;
}
__device__ __forceinline__ void xcd_barrier_complete(unsigned* bar, unsigned x, unsigned& nloc, unsigned& nx) {
    const unsigned G = gridDim.x * gridDim.y * gridDim.z;
    unsigned sum, cnt, mine, sp = 0u;
    for (;;) {
        sum = 0u; cnt = 0u; mine = 0u;
#pragma unroll 1
        for (unsigned j = 0; j < 16; ++j) { const unsigned c = xb_ld(&bar[XB_XCNT(j)]); sum += c; cnt += (c > 0u) ? 1u : 0u; mine = (j == x) ? c : mine; }
        if (sum == G) break;
        __builtin_amdgcn_s_sleep(1);
        if ((++sp & 255u) == 0u) { if (xb_ld(&bar[XB_TMO])) break; if (sp > XB_SPIN_CAP) { atomicAdd(&bar[XB_TMO], 1u); break; } }
    }
    nloc = mine > 0u ? mine : 1u; nx = cnt > 0u ? cnt : 1u;
}
__device__ __forceinline__ void xcd_barrier(const XcdBarrier& b) {
    asm volatile("s_waitcnt vmcnt(0)" ::: "memory");
    __syncthreads();
    if (threadIdx.x == 0) {
        unsigned* bar = b.bar;
        __builtin_amdgcn_s_waitcnt(0);
        unsigned nloc = b.st[0], nx = b.st[1];
        if (nloc == 0u) { xcd_barrier_complete(bar, b.x, nloc, nx); b.st[0] = nloc; b.st[1] = nx; }
        const unsigned old = xb_add(&bar[XB_XSUB(b.x)], 1u);
        const unsigned gen = old / nloc;
        if (old + 1u == (gen + 1u) * nloc) {
            __builtin_amdgcn_fence(__ATOMIC_RELEASE, "agent");
            asm volatile("s_waitcnt vmcnt(0)" ::: "memory");
            const unsigned og = xb_add(&bar[XB_TOP], 1u);
            const unsigned tg = og / nx;
            if (og + 1u == (tg + 1u) * nx) xb_add(&bar[XB_TOPGEN], 1u);
            else XB_SPIN(xb_ld(&bar[XB_TOPGEN]) == tg, bar);
            __builtin_amdgcn_fence(__ATOMIC_ACQUIRE, "agent");
            xb_add(&bar[XB_XGEN(b.x)], 1u);
            asm volatile("s_waitcnt vmcnt(0)" ::: "memory");
        } else {
            XB_SPIN(xb_ld(&bar[XB_XGEN(b.x)]) == gen, bar);
            __builtin_amdgcn_fence(__ATOMIC_ACQUIRE, "agent");
            asm volatile("s_waitcnt vmcnt(0)" ::: "memory");
        }
    }
    __syncthreads();
}

__device__ __forceinline__ int tid_fresh() { int t = threadIdx.x; asm volatile("" : "+v"(t)); return t; }
namespace pg8 {
constexpr int BM = 256, BK = 64, HALF = 128, HTB = HALF * BK * 2, STAGE_BYTES = 8 * HTB, NXCD = 8, WGM = 8;
__host__ __device__ __forceinline__ int lds_byte(int r, int c) { const int st = (r >> 4) * 2 + (c >> 5), rr = r & 15, cc = c & 31, ob = rr * 64 + cc * 2; return st * 1024 + (ob ^ (((ob >> 9) & 1) << 5)); }
__host__ __device__ __forceinline__ void stage_rc(int b, int& R, int& C) { const int st = b / 1024, sb = b % 1024, swz = sb ^ (((sb >> 9) & 1) << 5); R = (st >> 1) * 16 + swz / 64; C = (st & 1) * 32 + (swz % 64) / 2; }
__host__ __device__ __forceinline__ int perm32(int rho) { const int n = rho >> 4, i = rho & 15; return 8 * (i >> 2) + 4 * n + (i & 3); }
struct Unit { int pm, pn, aux; };

struct DenseSched {
    const char* A; const char* Bt; size_t tstep; int nM, nN, nwg, G, c;
    __device__ __forceinline__ void init(const void* A_, const void* Bt_, int Mrows, int N, int K, int G_, int c_) { A = (const char*)A_; Bt = (const char*)Bt_; tstep = (size_t)BM * K * 2; nM = Mrows / BM; nN = N / BM; nwg = nM * nN; G = G_; c = c_; }
    __device__ __forceinline__ bool next(int i, Unit& u) const {
        const long L = (long)i * G + c; if (L >= nwg) return false;
        int wgid = (int)L; { const int q = nwg / NXCD, r = nwg % NXCD, xcd = wgid % NXCD, off = wgid / NXCD; wgid = (xcd < r ? xcd * (q + 1) : r * (q + 1) + (xcd - r) * q) + off; }
        const int nig = WGM * nN, gid = wgid / nig, fm = gid * WGM, gsz = (nM - fm) < WGM ? (nM - fm) : WGM;
        u.pm = fm + ((wgid % nig) % gsz); u.pn = (wgid % nig) / gsz; u.aux = 0; return true;
    }
    __device__ __forceinline__ const char* a_ptr(const Unit& u) const { return A + (size_t)u.pm * tstep; }
    __device__ __forceinline__ const char* b_ptr(const Unit& u) const { return Bt + (size_t)u.pn * tstep; }
};
template <int nN, int ROWB> struct GroupSched {
    static constexpr size_t tstep = (size_t)256 * ROWB, estride = (size_t)nN * tstep;
    const char* A; const char* Bt; const LAS int* tile_e; int t_lo, a_t0, nun, G, c;
    __device__ __forceinline__ bool next(int i, Unit& u) const {
        int t, pn;
        if ((G & 7) == 0) {
            const int x = c & 7, r = c >> 3, W = G >> 3;
            const int q = i * W + r; t = x + 8 * (q / nN); pn = q % nN;
            if (t * nN >= nun) return false;
        } else {
            const long L = (long)i * G + c; if (L >= nun) return false;
            t = (int)(L / nN); pn = (int)(L % nN);
        }
        u.pm = t_lo + t; u.pn = pn;
        u.aux = __builtin_amdgcn_readfirstlane(tile_e[u.pm]); return true;
    }
    __device__ __forceinline__ const char* a_ptr(const Unit& u) const { return A + (size_t)(u.pm - a_t0) * tstep; }
    __device__ __forceinline__ const char* b_ptr(const Unit& u) const { return Bt + (size_t)u.aux * estride + (size_t)u.pn * tstep; }
};

typedef int v8i_t __attribute__((ext_vector_type(8)));
typedef int v4i_t __attribute__((ext_vector_type(4)));
template <class Epi, class Sched, bool ALIGN_EPI, bool SP2, bool FP8 = false>
__device__ __forceinline__ void gemm_phase(LAS unsigned char* lds, const int K, const Sched& S, const Epi& E) {
    const int tid = tid_fresh(), wid = __builtin_amdgcn_readfirstlane(tid >> 6), lane = tid & 63, wr = wid >> 2, wc = wid & 3, fr = lane & 15, fq = lane >> 4;
    const int nt = K / BK;
    unsigned voffA[2], voffB[2];
#pragma unroll
    for (int i = 0; i < 2; ++i) { int R, C; stage_rc(tid * 16 + i * 8192, R, C); const int Rb = Epi::PERM ? ((R & ~31) + perm32(R & 31)) : R;
        voffA[i] = (unsigned)(R * K + C) * 2u; voffB[i] = (unsigned)(Rb * K + C) * 2u; }
    const size_t kstep = (size_t)(BK * 2);
    const size_t hstep = (size_t)HALF * K * 2;
    const unsigned ldsw = (unsigned)wid * 1024u;
    const int aoff = lds_byte(wr * 64 + fr, fq * 8), boff = lds_byte(wc * 32 + fr, fq * 8);
#define PG8_SA(b, h) (((b) * 2 + (h)) * HTB)
#define PG8_SB(b, h) ((4 + (b) * 2 + (h)) * HTB)
#define PG8_STAGE(bufoff, gbase, voff) do { _Pragma("unroll") for (int _i = 0; _i < 2; ++_i) \
        __builtin_amdgcn_global_load_lds((const unsigned*)((const char*)(gbase) + (voff)[_i]), (LAS unsigned*)(lds + (bufoff) + ldsw + _i * 8192), 16, 0, 0); } while (0)
#define PG8_LD8(p) __builtin_shufflevector(*(const LAS v4i_t*)(p), *(const LAS v4i_t*)((p) + 1024), 0, 1, 2, 3, 4, 5, 6, 7)
#define PG8_LDA(dst, b, h) do { if constexpr (FP8) { _Pragma("unroll") for (int m = 0; m < 4; ++m) dst##8[m] = PG8_LD8(lds + PG8_SA(b, h) + aoff + m * 2048); } \
        else { _Pragma("unroll") for (int m = 0; m < 4; ++m) _Pragma("unroll") for (int k = 0; k < 2; ++k) dst[m][k] = *(const LAS bf16x8*)(lds + PG8_SA(b, h) + aoff + m * 2048 + k * 1024); } } while (0)
#define PG8_LDB(dst, b, h) do { if constexpr (FP8) { _Pragma("unroll") for (int n = 0; n < 2; ++n) dst##8[n] = PG8_LD8(lds + PG8_SB(b, h) + boff + n * 2048); } \
        else { _Pragma("unroll") for (int n = 0; n < 2; ++n) _Pragma("unroll") for (int k = 0; k < 2; ++k) dst[n][k] = *(const LAS bf16x8*)(lds + PG8_SB(b, h) + boff + n * 2048 + k * 1024); } } while (0)
#define PG8_CAT(x) __builtin_shufflevector(__builtin_bit_cast(v4i_t, (x)[0]), __builtin_bit_cast(v4i_t, (x)[1]), 0, 1, 2, 3, 4, 5, 6, 7)
#define PG8_MMA(ai, bj, At, Bt) do { __builtin_amdgcn_s_setprio(1); \
        if constexpr (FP8) { _Pragma("unroll") for (int m = 0; m < 4; ++m) _Pragma("unroll") for (int n = 0; n < 2; ++n) \
            asm volatile("v_mfma_scale_f32_16x16x128_f8f6f4 %0, %1, %2, %0, %3, %3 op_sel_hi:[0,0,0]" : "+v"(acc[ai][bj][m][n]) : "v"(Bt##8[n]), "v"(At##8[m]), "v"(sc1)); } \
        else { _Pragma("unroll") for (int m = 0; m < 4; ++m) _Pragma("unroll") for (int n = 0; n < 2; ++n) _Pragma("unroll") for (int k = 0; k < 2; ++k) \
            acc[ai][bj][m][n] = __builtin_amdgcn_mfma_f32_16x16x32_bf16(Bt[n][k], At[m][k], acc[ai][bj][m][n], 0, 0, 0); } \
        __builtin_amdgcn_s_setprio(0); } while (0)
#define PG8_WAIT_V(n) asm volatile("s_waitcnt vmcnt(" #n ")" ::: "memory")
#define PG8_WAIT_L(n) asm volatile("s_waitcnt lgkmcnt(" #n ")" ::: "memory")
#define PG8_BAR __builtin_amdgcn_s_barrier()
#define PG8_SCHED __builtin_amdgcn_sched_barrier(0)
    Unit cur, nxt; int ui = 0;
    if (!S.next(0, cur)) return;
    f32x4 acc[2][2][4][2];
#pragma unroll
    for (int a = 0; a < 2; ++a)
#pragma unroll
        for (int b = 0; b < 2; ++b)
#pragma unroll
            for (int m = 0; m < 4; ++m)
#pragma unroll
                for (int n = 0; n < 2; ++n) acc[a][b][m][n] = (f32x4){0.f, 0.f, 0.f, 0.f};
    bf16x8 At[4][2], B0[2][2], B1[2][2]; v8i_t At8[4], B08[2], B18[2];
    int sc1 = 0x7f7f7f7f; asm volatile("" : "+v"(sc1));
    const char* cA = S.a_ptr(cur); const char* cB = S.b_ptr(cur);
    if constexpr (SP2) {
        PG8_STAGE(PG8_SB(0, 0), cB, voffB); PG8_STAGE(PG8_SB(0, 1), cB + hstep, voffB); PG8_STAGE(PG8_SA(0, 0), cA, voffA); PG8_STAGE(PG8_SA(0, 1), cA + hstep, voffA);
        if (wr == 1) PG8_BAR;
        PG8_WAIT_V(2); PG8_BAR;
        PG8_STAGE(PG8_SB(1, 0), cB + kstep, voffB); PG8_STAGE(PG8_SA(1, 0), cA + kstep, voffA); PG8_STAGE(PG8_SB(1, 1), cB + hstep + kstep, voffB);
        PG8_WAIT_V(6); PG8_BAR;
    } else {
        PG8_STAGE(PG8_SB(0, 0), cB, voffB); PG8_STAGE(PG8_SA(0, 0), cA, voffA); PG8_STAGE(PG8_SB(0, 1), cB + hstep, voffB); PG8_STAGE(PG8_SA(0, 1), cA + hstep, voffA);
        if (wr == 1) PG8_BAR;
        PG8_WAIT_V(4); PG8_BAR;
        PG8_STAGE(PG8_SB(1, 0), cB + kstep, voffB); PG8_STAGE(PG8_SA(1, 0), cA + kstep, voffA); PG8_STAGE(PG8_SB(1, 1), cB + hstep + kstep, voffB);
        PG8_WAIT_V(6); PG8_BAR;
    }
    for (;;) {
        const bool has_next = S.next(ui + 1, nxt);
        const char* nA = has_next ? S.a_ptr(nxt) : cA; const char* nB = has_next ? S.b_ptr(nxt) : cB;
#pragma unroll 1
        for (int t = 0; t < nt; t += 2) {
            const bool last = (t == nt - 2);
            const char* a1 = cA + (size_t)(t + 1) * kstep;
            const char* a2 = last ? nA : cA + (size_t)(t + 2) * kstep; const char* b2 = last ? nB : cB + (size_t)(t + 2) * kstep;
            const char* a3 = a2 + kstep; const char* b3 = b2 + kstep;
            if constexpr (SP2) {
            PG8_LDB(B0, 0, 0); PG8_LDB(B1, 0, 1); PG8_SCHED; PG8_LDA(At, 0, 0); PG8_STAGE(PG8_SA(1, 1), a1 + hstep, voffA);
            PG8_WAIT_V(8); PG8_WAIT_L(0); PG8_BAR; PG8_MMA(0, 0, At, B0); PG8_MMA(0, 1, At, B1); PG8_BAR; PG8_SCHED;
            PG8_LDA(At, 0, 1); PG8_STAGE(PG8_SB(0, 0), b2, voffB); PG8_STAGE(PG8_SB(0, 1), b2 + hstep, voffB); PG8_STAGE(PG8_SA(0, 0), a2, voffA);
            PG8_WAIT_V(8); PG8_WAIT_L(0); PG8_BAR; PG8_MMA(1, 0, At, B0); PG8_MMA(1, 1, At, B1); PG8_BAR; PG8_SCHED;
            PG8_LDB(B0, 1, 0); PG8_LDB(B1, 1, 1); PG8_SCHED; PG8_LDA(At, 1, 0); PG8_STAGE(PG8_SA(0, 1), a2 + hstep, voffA);
            PG8_WAIT_V(8); PG8_WAIT_L(0); PG8_BAR; PG8_MMA(0, 0, At, B0); PG8_MMA(0, 1, At, B1); PG8_BAR; PG8_SCHED;
            PG8_LDA(At, 1, 1); PG8_STAGE(PG8_SB(1, 0), b3, voffB); PG8_STAGE(PG8_SB(1, 1), b3 + hstep, voffB); PG8_STAGE(PG8_SA(1, 0), a3, voffA);
            PG8_WAIT_V(8); PG8_WAIT_L(0); PG8_BAR; PG8_MMA(1, 0, At, B0); PG8_MMA(1, 1, At, B1); PG8_BAR; PG8_SCHED;
            } else {
            PG8_LDB(B0, 0, 0); PG8_SCHED; PG8_LDA(At, 0, 0); PG8_STAGE(PG8_SA(1, 1), a1 + hstep, voffA);
            PG8_WAIT_L(8); PG8_BAR; PG8_WAIT_L(0); PG8_MMA(0, 0, At, B0); PG8_BAR; PG8_SCHED;
            PG8_LDB(B1, 0, 1); PG8_STAGE(PG8_SB(0, 0), b2, voffB);
            PG8_BAR; PG8_WAIT_L(0); PG8_MMA(0, 1, At, B1); PG8_BAR;
            PG8_LDA(At, 0, 1); PG8_STAGE(PG8_SA(0, 0), a2, voffA);
            PG8_BAR; PG8_WAIT_L(0); PG8_MMA(1, 0, At, B0); PG8_BAR; PG8_SCHED;
            PG8_STAGE(PG8_SB(0, 1), b2 + hstep, voffB);
            PG8_WAIT_V(6); PG8_BAR; PG8_MMA(1, 1, At, B1); PG8_BAR;
            PG8_LDB(B0, 1, 0); PG8_SCHED; PG8_LDA(At, 1, 0); PG8_STAGE(PG8_SA(0, 1), a2 + hstep, voffA);
            PG8_WAIT_L(8); PG8_BAR; PG8_WAIT_L(0); PG8_MMA(0, 0, At, B0); PG8_BAR; PG8_SCHED;
            PG8_LDB(B1, 1, 1); PG8_STAGE(PG8_SB(1, 0), b3, voffB);
            PG8_BAR; PG8_WAIT_L(0); PG8_MMA(0, 1, At, B1); PG8_BAR;
            PG8_LDA(At, 1, 1); PG8_STAGE(PG8_SA(1, 0), a3, voffA);
            PG8_BAR; PG8_WAIT_L(0); PG8_MMA(1, 0, At, B0); PG8_BAR; PG8_SCHED;
            PG8_STAGE(PG8_SB(1, 1), b3 + hstep, voffB);
            PG8_WAIT_V(6); PG8_BAR; PG8_MMA(1, 1, At, B1); PG8_BAR;
            }
        }
        if constexpr (ALIGN_EPI) { if (wr == 0) PG8_BAR; }
        if constexpr (FP8) asm volatile("s_nop 15\n\ts_nop 7" ::: "memory");
        E(acc, cur, wr, wc, fr, fq);
        if (!has_next) break;
#pragma unroll
        for (int a = 0; a < 2; ++a)
#pragma unroll
            for (int b = 0; b < 2; ++b)
#pragma unroll
                for (int m = 0; m < 4; ++m)
#pragma unroll
                    for (int n = 0; n < 2; ++n) acc[a][b][m][n] = (f32x4){0.f, 0.f, 0.f, 0.f};
        cur = nxt; cA = nA; cB = nB; ++ui;
        if constexpr (ALIGN_EPI) { if (wr == 1) PG8_BAR; }
    }
    PG8_WAIT_V(0);
    if constexpr (!ALIGN_EPI) { if (wr == 0) PG8_BAR; }
    PG8_BAR;
#undef PG8_SA
#undef PG8_SB
#undef PG8_STAGE
#undef PG8_LDA
#undef PG8_LD8
#undef PG8_LDB
#undef PG8_MMA
#undef PG8_CAT
#undef PG8_WAIT_V
#undef PG8_WAIT_L
#undef PG8_BAR
#undef PG8_SCHED
}
}
using pg8::Unit; using pg8::v8i_t; using pg8::v4i_t;

typedef f32x4 AccT[2][2][4][2];
struct EpiProj {
    static constexpr bool PERM = true;
    bf16_t *QA, *KA, *VA, *CQ, *SGA, *SGB; float* T7;
    __device__ __forceinline__ void operator()(const AccT& acc, const Unit& u, int wr, int wc, int fr, int fq) const {
        const int pn = u.pn;
        const int row0 = u.pm * 256 + wr * 64 + fr;
        const int colw = wc * 32 + 8 * fq;
#pragma unroll
        for (int ai = 0; ai < 2; ++ai)
#pragma unroll
            for (int m = 0; m < 4; ++m) {
                const int row = row0 + ai * 128 + m * 16;
                const int b = row >> 11, i = row & 2047;
                const size_t krow = (size_t)b * TPB + NMETA + i;
#pragma unroll
                for (int bj = 0; bj < 2; ++bj) {
                    const f32x4 v0 = acc[ai][bj][m][0], v1 = acc[ai][bj][m][1];
                    const int ct = bj * 128 + colw;
                    if (pn == 7) {
                        float* d = T7 + (size_t)row * 256 + ct; *(f32x4*)d = v0; *(f32x4*)(d + 4) = v1;
                    } else {
                        f32x4 a = v0, c = v1; bf16_t* d;
                        if (pn < 2)       { a = a * FOX_C; c = c * FOX_C; d = QA + (size_t)row * 512 + pn * 256 + ct; }
                        else if (pn < 4)  { d = KA + krow * 512 + (pn - 2) * 256 + ct; }
                        else if (pn < 6)  { d = VA + krow * 512 + (pn - 4) * 256 + ct; }
                        else if (pn == 6) { d = CQ + (size_t)row * 256 + ct; }
                        else {
                            a = (f32x4){sigmoidf_(a[0]), sigmoidf_(a[1]), sigmoidf_(a[2]), sigmoidf_(a[3])};
                            c = (f32x4){sigmoidf_(c[0]), sigmoidf_(c[1]), sigmoidf_(c[2]), sigmoidf_(c[3])};
                            d = (pn < 12) ? SGA + (size_t)row * 1024 + (pn - 8) * 256 + ct : SGB + (size_t)row * 1024 + (pn - 12) * 256 + ct;
                        }
                        u32x4 w; w.x = pk2(a[0], a[1]); w.y = pk2(a[2], a[3]); w.z = pk2(c[0], c[1]); w.w = pk2(c[2], c[3]);
                        *(u32x4*)d = w;
                    }
                }
            }
    }
};
struct EpiGate {
    static constexpr bool PERM = true;
    bf16_t *SGA, *SGB;
    __device__ __forceinline__ void operator()(const AccT& acc, const Unit& u, int wr, int wc, int fr, int fq) const {
        const int pn = u.pn;
        const int row0 = u.pm * 256 + wr * 64 + fr, col0 = (pn & 3) * 256 + wc * 32 + 8 * fq;
        bf16_t* base = (pn < 4) ? SGA : SGB;
#pragma unroll
        for (int ai = 0; ai < 2; ++ai)
#pragma unroll
            for (int m = 0; m < 4; ++m)
#pragma unroll
                for (int bj = 0; bj < 2; ++bj) {
                    const f32x4 a = acc[ai][bj][m][0] * WSC_INV, c = acc[ai][bj][m][1] * WSC_INV;
                    u32x4 w; w.x = pk2(sigmoidf_(a[0]), sigmoidf_(a[1])); w.y = pk2(sigmoidf_(a[2]), sigmoidf_(a[3])); w.z = pk2(sigmoidf_(c[0]), sigmoidf_(c[1])); w.w = pk2(sigmoidf_(c[2]), sigmoidf_(c[3]));
                    *(u32x4*)(base + (size_t)(row0 + ai * 128 + m * 16) * 1024 + col0 + bj * 128) = w;
                }
    }
};
struct EpiQ {
    static constexpr bool PERM = false;
    bf16_t *QL, *QIDX; const float *RSTD, *COS, *SIN;
    __device__ __forceinline__ void operator()(const AccT& acc, const Unit& u, int wr, int wc, int fr, int fq) const {
        const int pn = u.pn;
        const unsigned row0 = (unsigned)(u.pm * 256 + wr * 64 + fr);
        float rsv[8];
#pragma unroll
        for (int q = 0; q < 8; ++q) rsv[q] = RSTD[row0 + (q >> 2) * 128 + (q & 3) * 16];
        if (pn < 4) {
            unsigned char* base = (unsigned char*)QL;
#pragma unroll
            for (int ai = 0; ai < 2; ++ai)
#pragma unroll
                for (int m = 0; m < 4; ++m) {
                    const unsigned row = row0 + ai * 128 + m * 16;
                    const float rs = rsv[ai * 4 + m] * (DSA_C * QSC);
#pragma unroll
                    for (int bj = 0; bj < 2; ++bj) {
                        const f32x4 x1 = acc[ai][bj][m][0] * rs, x2 = acc[ai][bj][m][1] * rs;
                        const int cc = pn * 256 + (bj * 4 + wc) * 32;
                        const unsigned off = row * 1536u + (unsigned)((cc >> 7) * 192 + (cc & 127) + 4 * fq);
                        *(unsigned*)(base + off) = pk4_fp8(x1[0], x1[1], x1[2], x1[3]); *(unsigned*)(base + off + 16) = pk4_fp8(x2[0], x2[1], x2[2], x2[3]);
                    }
                    asm volatile("" ::: "memory");
                }
        } else {
            unsigned char* base = (pn == 4) ? (unsigned char*)QL : (unsigned char*)QIDX;
            const float sc = (pn == 4) ? DSA_C * QSC : 1.0f;
#pragma unroll
            for (int ai = 0; ai < 2; ++ai)
#pragma unroll
                for (int m = 0; m < 4; ++m) {
                    const unsigned row = row0 + ai * 128 + m * 16;
                    const float rs = rsv[ai * 4 + m] * sc;
                    const unsigned pos = NMETA + (row & 2047u);
                    const f32x4 cs = *(const f32x4*)(COS + pos * 16 + 4 * fq), sn = *(const f32x4*)(SIN + pos * 16 + 4 * fq);
#pragma unroll
                    for (int bj = 0; bj < 2; ++bj) {
                        const f32x4 x1 = acc[ai][bj][m][0] * rs, x2 = acc[ai][bj][m][1] * rs;
                        const int g = bj * 4 + wc;
                        const bool rope = (pn == 4) || ((g & 1) == 0);
                        const f32x4 o1 = rope ? (x1 * cs - x2 * sn) : x1, o2 = rope ? (x1 * sn + x2 * cs) : x2;
                        if (pn == 4) {
                            const unsigned off = row * 1536u + (unsigned)(g * 192 + 128 + 4 * fq);
                            *(unsigned*)(base + off) = pk4_fp8(o1[0], o1[1], o1[2], o1[3]); *(unsigned*)(base + off + 16) = pk4_fp8(o2[0], o2[1], o2[2], o2[3]);
                            *(unsigned*)(base + off + 32) = 0u; *(unsigned*)(base + off + 48) = 0u;
                        } else {
                            const unsigned off = (row * 256u + (unsigned)(g * 32 + 4 * fq)) * 2u;
                            u32x2 w0 = {pk2(o1[0], o1[1]), pk2(o1[2], o1[3])}, w1 = {pk2(o2[0], o2[1]), pk2(o2[2], o2[3])};
                            *(u32x2*)(base + off) = w0; *(u32x2*)(base + off + 32) = w1;
                        }
                    }
                    asm volatile("" ::: "memory");
                }
        }
    }
};
template <bool SECOND> struct EpiBranch {
    static constexpr bool PERM = true;
    bf16_t* T; const bf16_t* SG2; float asc;
    __device__ __forceinline__ void operator()(const AccT& acc, const Unit& u, int wr, int wc, int fr, int fq) const {
        const int row0 = u.pm * 256 + wr * 64 + fr, col0 = u.pn * 256 + wc * 32 + 8 * fq;
#pragma unroll
        for (int ai = 0; ai < 2; ++ai)
#pragma unroll
            for (int mp = 0; mp < 4; mp += 2) {
                u32x4 tq[4], sq[4];
#pragma unroll
                for (int q = 0; q < 4; ++q) { const size_t off = (size_t)(row0 + ai * 128 + (mp + (q >> 1)) * 16) * 1024 + col0 + (q & 1) * 128;
                    tq[q] = *(const u32x4*)(T + off); if (SECOND) sq[q] = *(const u32x4*)(SG2 + off); }
#pragma unroll
                for (int q = 0; q < 4; ++q) {
                    const int m = mp + (q >> 1), bj = q & 1;
                    const size_t off = (size_t)(row0 + ai * 128 + m * 16) * 1024 + col0 + bj * 128;
                    const f32x4 v0 = acc[ai][bj][m][0] * asc, v1 = acc[ai][bj][m][1] * asc;
                    const u32x4 t = tq[q];
                    float r[8];
                    if (!SECOND) {
                        r[0] = bflo(t.x) * v0[0]; r[1] = bfhi(t.x) * v0[1]; r[2] = bflo(t.y) * v0[2]; r[3] = bfhi(t.y) * v0[3];
                        r[4] = bflo(t.z) * v1[0]; r[5] = bfhi(t.z) * v1[1]; r[6] = bflo(t.w) * v1[2]; r[7] = bfhi(t.w) * v1[3];
                    } else {
                        const u32x4 s = sq[q];
                        r[0] = bflo(t.x) + bflo(s.x) * v0[0]; r[1] = bfhi(t.x) + bfhi(s.x) * v0[1]; r[2] = bflo(t.y) + bflo(s.y) * v0[2]; r[3] = bfhi(t.y) + bfhi(s.y) * v0[3];
                        r[4] = bflo(t.z) + bflo(s.z) * v1[0]; r[5] = bfhi(t.z) + bfhi(s.z) * v1[1]; r[6] = bflo(t.w) + bflo(s.w) * v1[2]; r[7] = bfhi(t.w) + bfhi(s.w) * v1[3];
                    }
                    u32x4 w; w.x = pk2(r[0], r[1]); w.y = pk2(r[2], r[3]); w.z = pk2(r[4], r[5]); w.w = pk2(r[6], r[7]);
                    *(u32x4*)(T + off) = w;
                }
            }
    }
};
struct EpiOut {
    static constexpr bool PERM = true;
    const float* X; bf16_t* H1;
    __device__ __forceinline__ void operator()(const AccT& acc, const Unit& u, int wr, int wc, int fr, int fq) const {
        const int row0 = u.pm * 256 + wr * 64 + fr, col0 = u.pn * 256 + wc * 32 + 8 * fq;
#pragma unroll
        for (int ai = 0; ai < 2; ++ai)
#pragma unroll
            for (int m = 0; m < 4; ++m)
#pragma unroll
                for (int bj = 0; bj < 2; ++bj) {
                    const size_t off = (size_t)(row0 + ai * 128 + m * 16) * 1024 + col0 + bj * 128;
                    const f32x4 x0 = *(const f32x4*)(X + off) + acc[ai][bj][m][0], x1 = *(const f32x4*)(X + off + 4) + acc[ai][bj][m][1];
                    *(u32x4*)(H1 + off) = (u32x4){pk2(x0.x, x0.y), pk2(x0.z, x0.w), pk2(x1.x, x1.y), pk2(x1.z, x1.w)};
                }
    }
};
struct EpiGateUp {
    static constexpr bool PERM = true;
    bf16_t* ACT; const float* BGU; int a_t0;
    __device__ __forceinline__ void operator()(const AccT& acc, const Unit& u, int wr, int wc, int fr, int fq) const {
        const int e = u.aux, j0 = u.pn * 128 + wc * 32 + 8 * fq;
        const float* bg = BGU + (size_t)e * 2048 + j0;
        const f32x4 bg0 = *(const f32x4*)bg, bg1 = *(const f32x4*)(bg + 4), bl0 = *(const f32x4*)(bg + 1024) + 1.0f, bl1 = *(const f32x4*)(bg + 1028) + 1.0f;
        const size_t row0 = (size_t)(u.pm - a_t0) * 256 + wr * 64 + fr;
        const f32x2 wsc2 = {WSC_INV, WSC_INV}, one2 = {1.0f, 1.0f}, ka2 = {-1.702f * LOG2E, -1.702f * LOG2E};
#pragma unroll
        for (int ai = 0; ai < 2; ++ai)
#pragma unroll
            for (int m = 0; m < 4; ++m) {
                f32x2 r[4];
#pragma unroll
                for (int n = 0; n < 2; ++n) {
                    const f32x4 ga = acc[ai][0][m][n], la = acc[ai][1][m][n], bgv = n ? bg1 : bg0, blv = n ? bl1 : bl0;
#pragma unroll
                    for (int hh = 0; hh < 2; ++hh) {
                        const f32x2 g = (f32x2){ga[2 * hh], ga[2 * hh + 1]} * wsc2 + (f32x2){bgv[2 * hh], bgv[2 * hh + 1]};
                        const f32x2 l = (f32x2){la[2 * hh], la[2 * hh + 1]} * wsc2 + (f32x2){blv[2 * hh], blv[2 * hh + 1]};
                        const f32x2 xg = {fminf(g.x, 7.0f), fminf(g.y, 7.0f)};
                        const f32x2 xl1 = {__builtin_amdgcn_fmed3f(l.x, -6.0f, 8.0f), __builtin_amdgcn_fmed3f(l.y, -6.0f, 8.0f)};
                        const f32x2 ar = xg * ka2;
                        const f32x2 ex = {fast_exp2(ar.x), fast_exp2(ar.y)};
                        const f32x2 dn = ex + one2;
                        const f32x2 rc = {fast_rcp(dn.x), fast_rcp(dn.y)};
                        r[n * 2 + hh] = (xg * xl1) * rc;
                    }
                }
                u32x2 w = {pk4_fp8(r[0].x, r[0].y, r[1].x, r[1].y), pk4_fp8(r[2].x, r[2].y, r[3].x, r[3].y)};
                *(u32x2*)((unsigned char*)ACT + (row0 + ai * 128 + m * 16) * 1024 + j0) = w;
            }
    }
};
struct EpiDown {
    static constexpr bool PERM = true;
    bf16_t* Y; const float* BD; const float* SLOTG;
    __device__ __forceinline__ void operator()(const AccT& acc, const Unit& u, int wr, int wc, int fr, int fq) const {
        const int e = u.aux, col0 = u.pn * 256 + wc * 32 + 8 * fq;
        const size_t row0 = (size_t)u.pm * 256 + wr * 64 + fr;
        f32x4 bv[2][2];
#pragma unroll
        for (int bj = 0; bj < 2; ++bj) { bv[bj][0] = *(const f32x4*)(BD + (size_t)e * 1024 + col0 + bj * 128); bv[bj][1] = *(const f32x4*)(BD + (size_t)e * 1024 + col0 + bj * 128 + 4); }
        float gtv[8];
#pragma unroll
        for (int q = 0; q < 8; ++q) gtv[q] = SLOTG[row0 + (q >> 2) * 128 + (q & 3) * 16];
#pragma unroll
        for (int ai = 0; ai < 2; ++ai)
#pragma unroll
            for (int m = 0; m < 4; ++m) {
                const size_t row = row0 + ai * 128 + m * 16;
                const float gt = gtv[ai * 4 + m];
#pragma unroll
                for (int bj = 0; bj < 2; ++bj) {
                    const f32x4 a = (acc[ai][bj][m][0] * WSC_INV + bv[bj][0]) * gt, c = (acc[ai][bj][m][1] * WSC_INV + bv[bj][1]) * gt;
                    u32x2 w = {pk4_fp8(a[0], a[1], a[2], a[3]), pk4_fp8(c[0], c[1], c[2], c[3])};
                    *(u32x2*)((unsigned char*)Y + row * 1024 + col0 + bj * 128) = w;
                }
            }
    }
};

struct Args { const float* in[24]; float* out; unsigned char* ws; int ph_lo, ph_hi; };
typedef const __attribute__((address_space(4))) Args* ArgsP;
__device__ __forceinline__ ArgsP fresh_args() { ArgsP p = (ArgsP)__builtin_amdgcn_kernarg_segment_ptr(); asm volatile("" : "+s"(p)); return p; }
struct Frame {
    LAS unsigned char* lds;
    int tid, lane, wave, G, bid;
};
extern __shared__ __attribute__((aligned(16))) unsigned char lds_raw[];
__device__ __forceinline__ Frame mkframe() { Frame F; F.lds = (LAS unsigned char*)lds_raw; F.tid = tid_fresh(); F.lane = F.tid & 63; F.wave = __builtin_amdgcn_readfirstlane(F.tid >> 6); F.G = gridDim.x; F.bid = blockIdx.x; return F; }
enum { I_X = 0, I_META, I_NORM_MIX_G, I_W_IN, I_B_FORGET, I_Q_NORM_G, I_W_UQ, I_KV_NORM_G, I_W_UK, I_W_UV, I_W_QIDX, I_KIDX_G, I_KIDX_B, I_W_BA, I_W_BB, I_W_OUT,
       I_NORM_FFN_G, I_W_ROUTER, I_B_ROUTER, I_W_GU, I_B_GU, I_W_DOWN, I_B_DOWN, I_NORM_FINAL_G };

struct TrItem { const float* W; bf16_t* WT; int K, N, dr0, k0, sc, fp8; };
__device__ __forceinline__ void tr_load(const TrItem& t, float (&v)[32], int lane) {
    const float* p = t.W + (size_t)(t.k0 + (lane >> 5)) * t.N + (t.sc >= 0 ? t.sc : 0);
#pragma unroll
    for (int i = 0; i < 32; ++i) v[i] = p[(size_t)(2 * i) * t.N];
}
__device__ __forceinline__ void tr_store(const TrItem& t, const float (&v)[32], LAS float* scr, int lane) {
#pragma unroll
    for (int i = 0; i < 32; ++i) scr[(2 * i + (lane >> 5)) * 33 + (lane & 31)] = t.sc >= 0 ? v[i] : 0.f;
    LDS_WAIT(); asm volatile("" ::: "memory");
    const int c = lane & 7;
#pragma unroll
    for (int j = 0; j < 4; ++j) { const int n = (lane >> 3) + 8 * j; const LAS float* s = scr + (8 * c) * 33 + n;
        if (t.fp8) { u32x2 o8 = {pk4_fp8(s[0 * 33] * WSC, s[1 * 33] * WSC, s[2 * 33] * WSC, s[3 * 33] * WSC), pk4_fp8(s[4 * 33] * WSC, s[5 * 33] * WSC, s[6 * 33] * WSC, s[7 * 33] * WSC)};
            *(u32x2*)((unsigned char*)t.WT + (size_t)(t.dr0 + n) * t.K + t.k0 + 8 * c) = o8; }
        else { u32x4 o; o.x = pk2(s[0 * 33], s[1 * 33]); o.y = pk2(s[2 * 33], s[3 * 33]); o.z = pk2(s[4 * 33], s[5 * 33]); o.w = pk2(s[6 * 33], s[7 * 33]);
            *(u32x4*)(t.WT + (size_t)(t.dr0 + n) * t.K + t.k0 + 8 * c) = o; } }
    LDS_WAIT(); asm volatile("" ::: "memory");
}
template <class Mk>
__device__ __forceinline__ void tr_run(int it0, int stride, int nit, LAS float* scr, int lane, const Mk& mk) {
    float va[32], vb[32];
    int it = it0;
    if (it >= nit) return;
    TrItem ta = mk(it), tb = ta;
    tr_load(ta, va, lane);
    for (;;) {
        const int it2 = it + stride;
        const bool h2 = it2 < nit;
        if (h2) { tb = mk(it2); tr_load(tb, vb, lane); }
        tr_store(ta, va, scr, lane);
        if (!h2) break;
        const int it3 = it2 + stride;
        const bool h3 = it3 < nit;
        if (h3) { ta = mk(it3); tr_load(ta, va, lane); }
        tr_store(tb, vb, scr, lane);
        if (!h3) break;
        it = it3;
    }
}
struct TrItem2 { const float* W; unsigned char* WT; int K, N, dr0, k0, sc0; };
__device__ __forceinline__ void tr2_load(const TrItem2& t, f32x4 (&v)[16], int lane) {
    const float* p = t.W + (size_t)(t.k0 + (lane >> 4)) * t.N + t.sc0 + (lane & 15) * 4;
#pragma unroll
    for (int i = 0; i < 16; ++i) v[i] = *(const f32x4*)(p + (size_t)(4 * i) * t.N);
}
template <class Mk>
__device__ __forceinline__ void tr2_run(int it0, int stride, int nit, LAS float* scr, int lane, const Mk& mk) {
    if (it0 >= nit) return;
    f32x4 v[16];
    TrItem2 cur = mk(it0);
    tr2_load(cur, v, lane);
    for (int it = it0;;) {
#pragma unroll
        for (int i = 0; i < 16; ++i) *(LAS f32x4*)(scr + ((lane >> 4) + 4 * i) * 68 + (lane & 15) * 4) = v[i];
        LDS_WAIT(); asm volatile("" ::: "memory");
        const int itn = it + stride; const bool hn = itn < nit;
        TrItem2 nxt = cur;
        if (hn) { nxt = mk(itn); tr2_load(nxt, v, lane); }
        const int nl = lane >> 2, kq = lane & 3;
#pragma unroll
        for (int p = 0; p < 4; ++p) {
            const int n = 16 * p + nl; const LAS float* sp = scr + (16 * kq) * 68 + n;
            u32x4 o;
            o.x = pk4_fp8(sp[0 * 68] * WSC, sp[1 * 68] * WSC, sp[2 * 68] * WSC, sp[3 * 68] * WSC);
            o.y = pk4_fp8(sp[4 * 68] * WSC, sp[5 * 68] * WSC, sp[6 * 68] * WSC, sp[7 * 68] * WSC);
            o.z = pk4_fp8(sp[8 * 68] * WSC, sp[9 * 68] * WSC, sp[10 * 68] * WSC, sp[11 * 68] * WSC);
            o.w = pk4_fp8(sp[12 * 68] * WSC, sp[13 * 68] * WSC, sp[14 * 68] * WSC, sp[15 * 68] * WSC);
            *(u32x4*)(cur.WT + (size_t)(cur.dr0 + n) * cur.K + cur.k0 + 16 * kq) = o;
        }
        LDS_WAIT(); asm volatile("" ::: "memory");
        if (!hn) break;
        cur = nxt; it = itn;
    }
}
struct MapId { __device__ __forceinline__ int operator()(int n) const { return n; } };
struct MapWin {
    __device__ __forceinline__ int operator()(int n) const {
        if (n < 1536) return n;
        if (n < 1792) return 1544 + (n - 1536);
        if (n < 1920) return 1800 + (n - 1792);
        if (n < 1952) return 1928 + (n - 1920);
        if (n < 2016) return 1960 + (n - 1952);
        if (n < 2024) return 1536 + (n - 2016);
        if (n < 2028) return 2024 + (n - 2024);
        if (n < 2048) return -1;
        if (n < 3072) return 2028 + (n - 2048);
        return 3052 + (n - 3072);
    }
};
struct MapGU { __device__ __forceinline__ int operator()(int n) const { const int pn = n >> 8, j = n & 255; return j < 128 ? pn * 128 + j : 1024 + pn * 128 + (j - 128); } };
__device__ __forceinline__ int meta_src(int c) {
    if (c < 512) return 512 + c;
    if (c < 1024) return 1024 + (c - 512);
    const int t = c - 1024;
    if (t < 128) return 1800 + t;
    if (t < 160) return 1928 + (t - 128);
    if (t < 224) return 1960 + (t - 160);
    if (t < 232) return 1536 + (t - 224);
    if (t < 236) return 2024 + (t - 232);
    return -1;
}
__device__ __forceinline__ void rms_row_to_bf16(const float* xrow, const float* g, bf16_t* orow, int lane) {
    const f32x4* xr = (const f32x4*)xrow + lane; const f32x4* gr = (const f32x4*)g + lane;
    f32x4 v[4]; float s = 0.f;
#pragma unroll
    for (int j = 0; j < 4; ++j) { v[j] = xr[64 * j]; s += (v[j].x * v[j].x + v[j].y * v[j].y) + (v[j].z * v[j].z + v[j].w * v[j].w); }
    const float rstd = 1.0f / sqrtf(wave_sum(s) * (1.f / 1024.f) + EPS);
    u64* o8 = (u64*)orow + lane;
#pragma unroll
    for (int j = 0; j < 4; ++j) { const f32x4 gg = gr[64 * j]; o8[64 * j] = (u64)pk2(v[j].x * rstd * gg.x, v[j].y * rstd * gg.y) | ((u64)pk2(v[j].z * rstd * gg.z, v[j].w * rstd * gg.w) << 32); }
}

__device__ __forceinline__ void p0_prologue(Frame& F) {
    const ArgsP A = fresh_args();
    LAS float* scr = (LAS float*)(F.lds + F.wave * 16384);
    const int gw = F.bid * 8 + F.wave, NGW = F.G * 8, lane = F.lane;
    unsigned char* ws = A->ws;
    {
        constexpr int I_WIN = 16 * 128, I_WA = 8 * 32, I_WOUT = 16 * 32;
        const float* w_in = A->in[I_W_IN]; const float* w_ba = A->in[I_W_BA]; const float* w_out = A->in[I_W_OUT];
        tr_run(gw, NGW, I_WIN + I_WA + I_WOUT, scr, lane, [&](int it) {
            TrItem t; int r = it;
            if (r < I_WIN) { t.W = w_in; t.K = 1024; t.N = D_IN; t.dr0 = (r % 128) * 32; t.k0 = (r / 128) * 64; t.sc = MapWin()(t.dr0 + (lane & 31));
                if (t.dr0 < 2048) { t.fp8 = 0; t.WT = (bf16_t*)(ws + WS_WIN_T); } else { t.fp8 = 1; t.WT = (bf16_t*)(ws + WS_WIN8 - (size_t)2048 * 1024); }
                return t; } r -= I_WIN;
            if (r < I_WA) { t.W = w_ba; t.WT = (bf16_t*)(ws + WS_WA_T); t.fp8 = 0; t.K = 512; t.N = 1024; t.dr0 = (r % 32) * 32; t.k0 = (r / 32) * 64; t.sc = t.dr0 + (lane & 31); return t; } r -= I_WA;
            t.W = w_out; t.WT = (bf16_t*)(ws + WS_WOUT_T); t.fp8 = 0; t.K = 1024; t.N = 1024; t.dr0 = (r % 32) * 32; t.k0 = (r / 32) * 64; t.sc = t.dr0 + (lane & 31); return t; });
    }
    {
        const int gt = F.bid * 512 + F.tid, NGT = F.G * 512;
        const float* w_uq = A->in[I_W_UQ]; const float* w_uk = A->in[I_W_UK]; const float* w_uv = A->in[I_W_UV]; const float* w_qidx = A->in[I_W_QIDX];
        const float* w_bb = A->in[I_W_BB]; const float* qg = A->in[I_Q_NORM_G];
        bf16_t* WQ2 = (bf16_t*)(ws + WS_WQ2_T); bf16_t* WOB = (bf16_t*)(ws + WS_WOB_T);
        for (int o = gt; o < 1536 * 256; o += NGT) {
            const int k = o / 1536, n = o - k * 1536; float v;
            if (n < 1024) { const int h = n >> 7, r = n & 127; float s = 0.f;
#pragma unroll 8
                for (int j = 0; j < 64; ++j) s += w_uq[k * 768 + 96 * h + j] * w_uk[(h * 64 + j) * 128 + r]; v = s; }
            else if (n < 1280) { const int h = (n - 1024) >> 5, j = (n - 1024) & 31; v = w_uq[k * 768 + 96 * h + 64 + j]; }
            else v = w_qidx[k * 256 + (n - 1280)];
            WQ2[n * 256 + k] = (bf16_t)(pk2(v * qg[k], 0.f) & 0xffffu);
        }
        for (int o = gt; o < 256 * 1024; o += NGT) {
            const int k4 = (o >> 10) * 4, n = o & 1023, h = k4 >> 7; float s0 = 0.f, s1 = 0.f, s2 = 0.f, s3 = 0.f;
            const float* uv = w_uv + (size_t)k4 * 64;
#pragma unroll 8
            for (int v = 0; v < 64; ++v) { const float wb = w_bb[(size_t)(h * 64 + v) * 1024 + n]; s0 += uv[v] * wb; s1 += uv[64 + v] * wb; s2 += uv[128 + v] * wb; s3 += uv[192 + v] * wb; }
            *(unsigned*)((unsigned char*)WOB + (size_t)n * 1024 + k4) = pk4_fp8(s0 * WSC, s1 * WSC, s2 * WSC, s3 * WSC);
        }
        float* COS = (float*)(ws + WS_COS); float* SIN = (float*)(ws + WS_SIN);
        for (int o = gt; o < TPB * 16; o += NGT) {
            const int pos = o >> 4, j = o & 15;
            const float inv = exp2f(-(float)j * (13.287712379549449f / 16.0f));
            const float ang = (float)pos * inv;
            const double rev = (double)ang * 0.15915494309189535; const float fr = (float)(rev - floor(rev));
            COS[o] = __builtin_amdgcn_cosf(fr); SIN[o] = __builtin_amdgcn_sinf(fr);
        }
    }
    {
        const float* X = A->in[I_X]; const f32x4* gr = (const f32x4*)A->in[I_NORM_MIX_G] + lane; bf16_t* XN = (bf16_t*)(ws + WS_XN);
        f32x4 v[4], vn[4];
        if (gw < M) {
#pragma unroll
            for (int j = 0; j < 4; ++j) v[j] = ((const f32x4*)(X + (size_t)gw * 1024) + lane)[64 * j];
        }
        for (int m = gw; m < M; m += NGW) {
            const int mn = (m + NGW < M) ? m + NGW : m;
#pragma unroll
            for (int j = 0; j < 4; ++j) vn[j] = ((const f32x4*)(X + (size_t)mn * 1024) + lane)[64 * j];
            float s2 = 0.f;
#pragma unroll
            for (int j = 0; j < 4; ++j) s2 += (v[j].x * v[j].x + v[j].y * v[j].y) + (v[j].z * v[j].z + v[j].w * v[j].w);
            const float rstd = 1.0f / sqrtf(wave_sum(s2) * (1.f / 1024.f) + EPS);
            u64* o8 = (u64*)(XN + (size_t)m * 1024) + lane; unsigned* o4 = (unsigned*)(ws + WS_XN8 + (size_t)m * 1024) + lane;
#pragma unroll
            for (int j = 0; j < 4; ++j) { const f32x4 gg = gr[64 * j]; const float y0 = v[j].x * rstd * gg.x, y1 = v[j].y * rstd * gg.y, y2 = v[j].z * rstd * gg.z, y3 = v[j].w * rstd * gg.w;
                o8[64 * j] = (u64)pk2(y0, y1) | ((u64)pk2(y2, y3) << 32); o4[64 * j] = pk4_fp8(y0, y1, y2, y3); }
#pragma unroll
            for (int j = 0; j < 4; ++j) v[j] = vn[j];
        }
    }
    __syncthreads();
    {
        LAS float* xnm = (LAS float*)F.lds;
        LAS float* red = (LAS float*)(F.lds + 65536);
        for (int un = F.bid; un < 20; un += F.G) {
            for (int p = F.wave; p < 16; p += 8) {
                const float* mr = A->in[I_META] + p * 1024; const float* g = A->in[I_NORM_MIX_G];
                float v[16]; float s = 0.f;
#pragma unroll
                for (int j = 0; j < 16; ++j) { v[j] = mr[lane + 64 * j]; s += v[j] * v[j]; }
                const float rstd = 1.0f / sqrtf(wave_sum(s) * (1.f / 1024.f) + EPS);
#pragma unroll
                for (int j = 0; j < 16; ++j) xnm[p * 1024 + lane + 64 * j] = v[j] * rstd * g[lane + 64 * j];
            }
            __syncthreads();
            const int c = un * 64 + lane, sc = meta_src(c);
            float a[16];
#pragma unroll
            for (int p = 0; p < 16; ++p) a[p] = 0.f;
            const float* W = A->in[I_W_IN];
            for (int k0 = F.wave * 128; k0 < F.wave * 128 + 128; k0 += 16) {
                float w[16];
#pragma unroll
                for (int j = 0; j < 16; ++j) w[j] = sc >= 0 ? W[(size_t)(k0 + j) * D_IN + sc] : 0.f;
#pragma unroll
                for (int j = 0; j < 16; ++j)
#pragma unroll
                    for (int p = 0; p < 16; ++p) a[p] += xnm[p * 1024 + k0 + j] * w[j];
            }
#pragma unroll
            for (int p = 0; p < 16; ++p) red[(F.wave * 16 + p) * 64 + lane] = a[p];
            __syncthreads();
            for (int o = F.tid; o < 1024; o += 512) { const int p = o >> 6, l = o & 63; float s = 0.f;
#pragma unroll
                for (int w = 0; w < 8; ++w) s += red[(w * 16 + p) * 64 + l];
                ((float*)(ws + WS_PROJM))[p * 1280 + un * 64 + l] = s; }
            __syncthreads();
        }
    }
}

__device__ __forceinline__ f32x4 log_sigmoid4(f32x4 z) {
    f32x4 r;
#pragma unroll
    for (int k = 0; k < 4; ++k) { const float x = z[k]; r[k] = fminf(x, 0.f) - log1pf(__expf(-fabsf(x))); }
    return r;
}
__host__ __device__ __forceinline__ int vt8_pos(int kp) { const int sub = kp >> 5, kk = kp & 31, hi = (kk >> 2) & 1, r = (kk & 3) + 4 * (kk >> 3); return 32 * hi + 16 * sub + r; }
struct PostPtrs { const float *kvg, *lg, *lb, *COS, *SIN; };
__device__ __forceinline__ void post_row(const PostPtrs& PP, const f32x4 v, int pos, unsigned char* k8_row, unsigned char* vt8_b, bf16_t* kidx_row, int lane) {
    const float* kvg = PP.kvg; const float* lg = PP.lg; const float* lb = PP.lb;
    const float* COS = PP.COS; const float* SIN = PP.SIN;
    const float ss = (v.x * v.x + v.y * v.y) + (v.z * v.z + v.w * v.w);
    const float s_ckv = wave_sum(lane < 32 ? ss : 0.f);
    const bool isk = (lane >= 40 && lane < 56);
    const float s_k = wave_sum(isk ? (v.x + v.y) + (v.z + v.w) : 0.f);
    const float mean = s_k * (1.f / 64.f);
    const f32x4 dv = v - mean;
    const float q_k = wave_sum(isk ? (dv.x * dv.x + dv.y * dv.y) + (dv.z * dv.z + dv.w * dv.w) : 0.f);
    const float rstd_c = 1.0f / sqrtf(s_ckv * (1.f / 128.f) + EPS);
    const float rstd_k = 1.0f / sqrtf(q_k * (1.f / 64.f) + EPS);
    f32x4 y = v;
    if (isk) { const int c = 4 * (lane - 40); const f32x4 g = *(const f32x4*)(lg + c), bb = *(const f32x4*)(lb + c); y = dv * rstd_k * g + bb; }
    f32x4 pr;
    pr.x = __shfl_xor(y.x, 4); pr.y = __shfl_xor(y.y, 4); pr.z = __shfl_xor(y.z, 4); pr.w = __shfl_xor(y.w, 4);
    if (lane < 32) {
        const f32x4 g = *(const f32x4*)(kvg + 4 * lane); const f32x4 o = v * rstd_c * g;
        const unsigned w = pk4_fp8(o.x, o.y, o.z, o.w);
        *(unsigned*)(k8_row + 4 * lane) = w;
    } else if (lane < 48) {
        const int jj = 4 * (lane & 3);
        const f32x4 cs = *(const f32x4*)(COS + pos * 16 + jj), sn = *(const f32x4*)(SIN + pos * 16 + jj);
        const f32x4 o = (lane & 4) ? (pr * sn + y * cs) : (y * cs - pr * sn);
        u32x2 w = {pk2(o.x, o.y), pk2(o.z, o.w)};
        if (lane < 40) *(unsigned*)(k8_row + 128 + 4 * (lane - 32)) = pk4_fp8(o.x, o.y, o.z, o.w); else *(u32x2*)(kidx_row + 4 * (lane - 40)) = w;
    } else if (lane < 56) {
        u32x2 w = {pk2(y.x, y.y), pk2(y.z, y.w)}; *(u32x2*)(kidx_row + 4 * (lane - 40)) = w;
        *(unsigned*)(k8_row + 160 + 4 * (lane - 48)) = 0u;
    }
}
__device__ __forceinline__ void p2_post(Frame& F) {
    const ArgsP A = fresh_args();
    unsigned char* ws = A->ws; const int lane = F.lane, tid = F.tid;
    const float* T7 = (const float*)(ws + WS_T7); const float* PROJM = (const float*)(ws + WS_PROJM);
    unsigned char* K8 = ws + WS_KVR; unsigned char* VT8 = ws + WS_VT8; bf16_t* KIDX = (bf16_t*)(ws + WS_KIDX); bf16_t* KA = (bf16_t*)(ws + WS_KA); bf16_t* VA = (bf16_t*)(ws + WS_VA);
    float* BIAS = (float*)(ws + WS_BIAS); float* IW = (float*)(ws + WS_IW); float* RSTDQ = (float*)(ws + WS_RSTDQ);
    const bf16_t* CQ = (const bf16_t*)(ws + WS_CQ);
    const float* bfg = A->in[I_B_FORGET];
    const PostPtrs PP{A->in[I_KV_NORM_G], A->in[I_KIDX_G], A->in[I_KIDX_B], (const float*)(ws + WS_COS), (const float*)(ws + WS_SIN)};
    LAS float* lf = (LAS float*)F.lds;
    LAS float* part = (LAS float*)(F.lds + 8192);
    LAS float* offs = (LAS float*)(F.lds + 8192 + 2048);
    LAS float* metaF = (LAS float*)(F.lds + 8192 + 2048 + 64);
    for (int un = F.bid; un < 256; un += F.G) {
        const int b = un >> 3, blk = un & 7;
        f32x4 vnx = *((const f32x4*)(T7 + (size_t)(b * 2048 + blk * 256 + F.wave * 32) * 256) + lane);
        u32x2 cnx = *((const u32x2*)(CQ + (size_t)(b * 2048 + blk * 256 + F.wave * 32) * 256) + lane);
        for (int rr = 0; rr < 32; ++rr) {
            const int i = blk * 256 + F.wave * 32 + rr; const int m = b * 2048 + i; const int mn = rr < 31 ? m + 1 : m;
            const f32x4 v = vnx; const u32x2 c = cnx;
            vnx = *((const f32x4*)(T7 + (size_t)mn * 256) + lane); cnx = *((const u32x2*)(CQ + (size_t)mn * 256) + lane);
            const size_t kr = (size_t)b * TPB + NMETA + i;
            post_row(PP, v, NMETA + i, K8 + kr * 192, VT8 + (size_t)b * NKT * 128 * 64, KIDX + kr * 64, lane);
            if (lane == 56 || lane == 57) { const int h0 = 4 * (lane - 56); const f32x4 z = v + *(const f32x4*)(bfg + h0); *(LAS f32x4*)(lf + (F.wave * 32 + rr) * 8 + h0) = log_sigmoid4(z); }
            if (lane == 58) *(f32x4*)(IW + (size_t)m * 4) = v * 0.0625f;
            { const float a0 = bflo(c.x), a1 = bfhi(c.x), a2 = bflo(c.y), a3 = bfhi(c.y);
              const float s = wave_sum((a0 * a0 + a1 * a1) + (a2 * a2 + a3 * a3)); if (lane == 0) RSTDQ[m] = 1.0f / sqrtf(s * (1.f / 256.f) + EPS); }
        }
        {
            float kmx = 0.f;
            for (int r8 = 0; r8 < 32; r8 += 8) {
                u32x4 w8[8];
#pragma unroll
                for (int rr = 0; rr < 8; ++rr) { const size_t kr = (size_t)b * TPB + NMETA + blk * 256 + F.wave * 32 + r8 + rr; w8[rr] = *((const u32x4*)(KA + kr * 512) + lane); }
#pragma unroll
                for (int rr = 0; rr < 8; ++rr) { const u32x4 w = w8[rr];
                    float s2 = (bflo(w.x) * bflo(w.x) + bfhi(w.x) * bfhi(w.x)) + (bflo(w.y) * bflo(w.y) + bfhi(w.y) * bfhi(w.y)) + (bflo(w.z) * bflo(w.z) + bfhi(w.z) * bfhi(w.z)) + (bflo(w.w) * bflo(w.w) + bfhi(w.w) * bfhi(w.w));
                    s2 += __shfl_xor(s2, 1); s2 += __shfl_xor(s2, 2); s2 += __shfl_xor(s2, 4);
                    kmx = fmaxf(kmx, s2); }
            }
            if (blk == 0) {
                for (int p = 0; p < 16; ++p) { const f32x4 a0 = *((const f32x4*)(PROJM + p * 1280) + 2 * lane), a1 = *((const f32x4*)(PROJM + p * 1280) + 2 * lane + 1);
                    float s2 = (a0.x * a0.x + a0.y * a0.y) + (a0.z * a0.z + a0.w * a0.w) + (a1.x * a1.x + a1.y * a1.y) + (a1.z * a1.z + a1.w * a1.w);
                    s2 += __shfl_xor(s2, 1); s2 += __shfl_xor(s2, 2); s2 += __shfl_xor(s2, 4);
                    kmx = fmaxf(kmx, s2 * 1.02f); }
            }
            if ((lane & 7) == 0) atomicMax((unsigned*)(ws + WS_CTL) + CW_KMAX + b * 8 + (lane >> 3), __float_as_uint(kmx));
        }
        {
            const int h = tid & 7; float s = 0.f;
            float zz[28];
#pragma unroll
            for (int k = 0; k < 28; ++k) { const int r = (tid >> 3) + 64 * k; zz[k] = (r < blk * 256) ? T7[(size_t)(b * 2048 + r) * 256 + 224 + h] : 1.0e30f; }
            const float bh = bfg[h];
#pragma unroll
            for (int k = 0; k < 28; ++k) { const float z = zz[k] + bh; s += fminf(z, 0.f) - log1pf(__expf(-fabsf(z))); }
            part[tid] = s;
            if (tid < 8) { float c = 0.f; for (int p = 0; p < 16; ++p) { const float z = PROJM[p * 1280 + 1248 + tid] + bfg[tid]; c += fminf(z, 0.f) - log1pf(__expf(-fabsf(z))); metaF[p * 8 + tid] = c; } }
        }
        __syncthreads();
        if (tid < 8) { float s = metaF[15 * 8 + tid]; for (int k = 0; k < 64; ++k) s += part[k * 8 + tid]; offs[tid] = s; }
        __syncthreads();
        {
            const int hh = F.wave; float* bo = BIAS + ((size_t)b * 8 + hh) * TPB + NMETA + blk * 256;
            const float a0 = lf[(4 * lane + 0) * 8 + hh], a1 = lf[(4 * lane + 1) * 8 + hh], a2 = lf[(4 * lane + 2) * 8 + hh], a3 = lf[(4 * lane + 3) * 8 + hh];
            const float t4 = (a0 + a1) + (a2 + a3); float inc = t4;
#pragma unroll
            for (int off = 1; off < 64; off <<= 1) { const float v2 = __shfl_up(inc, off); if (lane >= off) inc += v2; }
            const float c0 = offs[hh] + (inc - t4) + a0, c1 = c0 + a1, c2 = c1 + a2, c3 = c2 + a3;
            *(f32x4*)(bo + 4 * lane) = (f32x4){-c0 * LOG2E, -c1 * LOG2E, -c2 * LOG2E, -c3 * LOG2E};
        }
        if (blk == 0) {
            if (tid < 128) { const int p = tid >> 3, h = tid & 7; BIAS[((size_t)b * 8 + h) * TPB + p] = -metaF[p * 8 + h] * LOG2E; }
            if (tid >= 128 && tid < 512) { const int o = tid - 128; if (o < 48 * 8) { const int p = o >> 3, h = o & 7; BIAS[((size_t)b * 8 + h) * TPB + 2064 + p] = 0.f; } }
            for (int p = F.wave; p < 16; p += 8) {
                const float* src = PROJM + p * 1280;
                const size_t kr = (size_t)b * TPB + p;
                const f32x4 v = *((const f32x4*)(src + 1024) + lane);
                post_row(PP, v, p, K8 + kr * 192, VT8 + (size_t)b * NKT * 128 * 64, KIDX + kr * 64, lane);
#pragma unroll
                for (int j = 0; j < 2; ++j) {
                    const f32x4 a = *((const f32x4*)src + lane + 64 * j), c = *((const f32x4*)(src + 512) + lane + 64 * j);
                    u32x2 wa = {pk2(a.x, a.y), pk2(a.z, a.w)}, wc = {pk2(c.x, c.y), pk2(c.z, c.w)};
                    *((u32x2*)(KA + kr * 512) + lane + 64 * j) = wa; *((u32x2*)(VA + kr * 512) + lane + 64 * j) = wc;
                }
            }
            for (int p = F.wave; p < 48; p += 8) {
                const size_t kr = (size_t)b * TPB + 2064 + p; const u32x2 z = {0u, 0u};
                *((u32x2*)(KA + kr * 512) + lane) = z; *((u32x2*)(KA + kr * 512) + lane + 64) = z; *((u32x2*)(VA + kr * 512) + lane) = z; *((u32x2*)(VA + kr * 512) + lane + 64) = z;
                if (lane < 48) *((unsigned*)(K8 + kr * 192) + lane) = 0u;

                if (lane < 16) *((u32x2*)(KIDX + kr * 64) + lane) = z;
            }
        }
        __syncthreads();
    }
}

__device__ __forceinline__ void vt8_build(Frame& F) {
    const ArgsP A = fresh_args(); unsigned char* ws = A->ws; const int tid = F.tid;
    LAS unsigned char* t8 = F.lds;
    for (int un = F.bid; un < NB * NKT; un += F.G) {
        const int b = un / NKT, kt = un % NKT;
        const unsigned char* src = ws + WS_KVR + ((size_t)b * TPB + (size_t)kt * 64) * 192;
        { const int r = tid >> 3, ch = tid & 7; *(LAS u32x4*)(t8 + r * 144 + ch * 16) = *(const u32x4*)(src + (size_t)r * 192 + ch * 16); }
        __syncthreads();
        { const int d = tid >> 2, q4 = tid & 3;
          unsigned w[4];
#pragma unroll
          for (int g = 0; g < 4; ++g) { unsigned acc = 0u;
#pragma unroll
              for (int e = 0; e < 4; ++e) { const int beta = 16 * q4 + 4 * g + e; const int hi2 = beta >> 5, i2 = beta & 31, sub = i2 >> 4, r2 = i2 & 15;
                  const int kp = 32 * sub + (r2 & 3) + 8 * (r2 >> 2) + 4 * hi2; acc |= (unsigned)t8[kp * 144 + d] << (8 * e); }
              w[g] = acc; }
          *(u32x4*)(ws + WS_VT8 + ((size_t)un * 128 + d) * 64 + 16 * q4) = (u32x4){w[0], w[1], w[2], w[3]}; }
        __syncthreads();
    }
}
__device__ __forceinline__ s16x4 vtr(const LAS unsigned char* p) { return __builtin_bit_cast(s16x4, __builtin_amdgcn_ds_read_tr16_b64_v4i16((LAS s16x4*)p)); }
__device__ __forceinline__ float max3f(float a, float b, float c) { float r; asm("v_max3_f32 %0, %1, %2, %3" : "=v"(r) : "v"(a), "v"(b), "v"(c)); return r; }
__device__ __forceinline__ float max32(const f32x16& p, const f32x16& q) {
    float a = max3f(p[0], p[1], p[2]), b = max3f(q[0], q[1], q[2]);
    a = max3f(a, p[3], p[4]); b = max3f(b, q[3], q[4]); a = max3f(a, p[5], p[6]); b = max3f(b, q[5], q[6]);
    a = max3f(a, p[7], p[8]); b = max3f(b, q[7], q[8]); a = max3f(a, p[9], p[10]); b = max3f(b, q[9], q[10]);
    a = max3f(a, p[11], p[12]); b = max3f(b, q[11], q[12]); a = max3f(a, p[13], p[14]); b = max3f(b, q[13], q[14]);
    return max3f(a, b, max3f(p[15], q[15], q[15]));
}
__device__ __forceinline__ float max16(const f32x16& p) {
    float a = fmaxf(fmaxf(p[0], p[1]), fmaxf(p[2], p[3])), b = fmaxf(fmaxf(p[4], p[5]), fmaxf(p[6], p[7]));
    float c = fmaxf(fmaxf(p[8], p[9]), fmaxf(p[10], p[11])), d = fmaxf(fmaxf(p[12], p[13]), fmaxf(p[14], p[15]));
    return fmaxf(fmaxf(a, b), fmaxf(c, d));
}
#define PFRAG(P, s) ((bf16x8)__builtin_bit_cast(bf16x8, (u32x4){pk2(P[8 * (s) + 0], P[8 * (s) + 1]), pk2(P[8 * (s) + 2], P[8 * (s) + 3]), pk2(P[8 * (s) + 4], P[8 * (s) + 5]), pk2(P[8 * (s) + 6], P[8 * (s) + 7])}))

constexpr int FX_KP = 144;
constexpr int FX_TB = 64 * FX_KP;
constexpr int FX_K0 = 0, FX_V0 = 2 * FX_TB, FX_B0 = 4 * FX_TB;
__device__ __forceinline__ void fox_unit(Frame& F, int b, int hd, int qb) {
    const ArgsP A = fresh_args();
    const int tid = F.tid, lane = F.lane, r32 = lane & 31, hi = lane >> 5, wid = F.wave;
    unsigned char* ws = A->ws;
    bf16_t* QA = (bf16_t*)(ws + WS_QA); const bf16_t* KA = (const bf16_t*)(ws + WS_KA); const bf16_t* VA = (const bf16_t*)(ws + WS_VA);
    const float* BIAS = (const float*)(ws + WS_BIAS);
    LAS unsigned char* lds = F.lds;
    const int i0 = 256 * qb + 32 * wid;
    const int qpos = NMETA + i0 + r32;
    const size_t qrow = (size_t)b * 2048 + i0 + r32;
    bf16x8 qf[4];
#pragma unroll
    for (int d = 0; d < 4; ++d) qf[d] = *(const bf16x8*)(QA + qrow * 512 + hd * 64 + d * 16 + hi * 8);
    const int KT = 4 * qb + 5;
    const float* bg = BIAS + ((size_t)b * 8 + hd) * TPB;
    int kt_lo = 0;
    {
        float q2 = 0.f;
#pragma unroll
        for (int d = 0; d < 4; ++d) { const u32x4 w = __builtin_bit_cast(u32x4, qf[d]);
            q2 += (bflo(w.x) * bflo(w.x) + bfhi(w.x) * bfhi(w.x)) + (bflo(w.y) * bflo(w.y) + bfhi(w.y) * bfhi(w.y)) + (bflo(w.z) * bflo(w.z) + bfhi(w.z) * bfhi(w.z)) + (bflo(w.w) * bflo(w.w) + bfhi(w.w) * bfhi(w.w)); }
        q2 += __shfl_xor(q2, 32);
        q2 = wave_max(q2);
        LAS float* wq = (LAS float*)(lds + FX_B0 + 512);
        if (lane == 0) wq[wid] = q2;
        __syncthreads();
        float qm = wq[0];
#pragma unroll
        for (int w2 = 1; w2 < 8; ++w2) qm = fmaxf(qm, wq[w2]);
        const float km = __uint_as_float(ld_agent((const unsigned*)(ws + WS_CTL) + CW_KMAX + b * 8 + hd));
        const float thr = -(2.04f * sqrtf(qm * km) + 50.0f);
        const int ncand = 4 * qb;
        const float b0 = bg[NMETA + 256 * qb];
        const float dk = (lane < ncand) ? bg[64 * lane + 63] - b0 : 0.f;
        const u64 keep = __ballot(lane >= ncand || dk >= thr);
        kt_lo = __builtin_amdgcn_readfirstlane(__builtin_ctzll(keep));
        __syncthreads();
    }
    const int srow = tid >> 3, sch = tid & 7;
    const bf16_t* kg = KA + ((size_t)b * TPB + (size_t)kt_lo * 64 + srow) * 512 + hd * 64 + sch * 8;
    const bf16_t* vg = VA + ((size_t)b * TPB + (size_t)kt_lo * 64 + srow) * 512 + hd * 64 + sch * 8;
    const int sdst = srow * FX_KP + sch * 16;
    u32x4 kreg = *(const u32x4*)kg, vreg = *(const u32x4*)vg; float breg = (tid < 64) ? bg[kt_lo * 64 + tid] : 0.f;
    *(LAS u32x4*)(lds + FX_K0 + sdst) = kreg; *(LAS u32x4*)(lds + FX_V0 + sdst) = vreg; if (tid < 64) *(LAS float*)(lds + FX_B0 + tid * 4) = breg;
    __syncthreads();
    f32x16 o0 = {}, o1 = {}; float mrow = NEGBIG, lrow = 0.f;
    const int vlane = ((lane & 15) >> 2) * FX_KP + (16 * ((lane >> 4) & 1) + 4 * (lane & 3)) * 2 + 4 * hi * FX_KP;
    for (int kt = kt_lo; kt < KT; ++kt) {
        const int cur = (kt - kt_lo) & 1;
        if (kt + 1 < KT) { kreg = *(const u32x4*)(kg + (size_t)(kt + 1 - kt_lo) * 64 * 512); vreg = *(const u32x4*)(vg + (size_t)(kt + 1 - kt_lo) * 64 * 512); if (tid < 64) breg = bg[(kt + 1) * 64 + tid]; }
        if (64 * kt <= NMETA + i0 + 31) {
            const LAS unsigned char* Kb = lds + FX_K0 + cur * FX_TB; const LAS unsigned char* Vb = lds + FX_V0 + cur * FX_TB; const LAS unsigned char* Bb = lds + FX_B0 + cur * 256;
            f32x16 p0, p1;
#pragma unroll
            for (int g = 0; g < 4; ++g) { const f32x4 t0 = *(const LAS f32x4*)(Bb + (8 * g + 4 * hi) * 4), t1 = *(const LAS f32x4*)(Bb + (32 + 8 * g + 4 * hi) * 4);
                p0[4 * g] = t0.x; p0[4 * g + 1] = t0.y; p0[4 * g + 2] = t0.z; p0[4 * g + 3] = t0.w; p1[4 * g] = t1.x; p1[4 * g + 1] = t1.y; p1[4 * g + 2] = t1.z; p1[4 * g + 3] = t1.w; }
#pragma unroll
            for (int d = 0; d < 4; ++d) {
                const bf16x8 k0 = *(const LAS bf16x8*)(Kb + r32 * FX_KP + (d * 16 + hi * 8) * 2), k1 = *(const LAS bf16x8*)(Kb + (32 + r32) * FX_KP + (d * 16 + hi * 8) * 2);
                p0 = __builtin_amdgcn_mfma_f32_32x32x16_bf16(k0, qf[d], p0, 0, 0, 0); p1 = __builtin_amdgcn_mfma_f32_32x32x16_bf16(k1, qf[d], p1, 0, 0, 0);
            }
            asm volatile("s_nop 15\n\ts_nop 7" : "+v"(p0), "+v"(p1));
            if (64 * kt + 63 > NMETA + i0) {
#pragma unroll
                for (int r = 0; r < 16; ++r) { const int kp = 64 * kt + crow(r, hi); if (kp > qpos) p0[r] = NEGBIG; if (kp + 32 > qpos) p1[r] = NEGBIG; }
            }
            float mx = max32(p0, p1); mx = fmaxf(mx, __shfl_xor(mx, 32));
            const float mnew = fmaxf(mrow, mx), alpha = fast_exp2(mrow - mnew); mrow = mnew;
            float sum = 0.f;
#pragma unroll
            for (int r = 0; r < 16; ++r) { p0[r] = fast_exp2(p0[r] - mnew); p1[r] = fast_exp2(p1[r] - mnew); sum += p0[r] + p1[r]; }
            lrow = lrow * alpha + sum;
#pragma unroll
            for (int r = 0; r < 16; ++r) { o0[r] *= alpha; o1[r] *= alpha; }
            const bf16x8 pf0 = PFRAG(p0, 0), pf1 = PFRAG(p0, 1), pf2 = PFRAG(p1, 0), pf3 = PFRAG(p1, 1);
#pragma unroll
            for (int s = 0; s < 4; ++s) {
                const bf16x8 pf = s == 0 ? pf0 : s == 1 ? pf1 : s == 2 ? pf2 : pf3;
#pragma unroll
                for (int db = 0; db < 2; ++db) {
                    const LAS unsigned char* va = Vb + vlane + 16 * s * FX_KP + db * 64;
                    const s16x4 lo = vtr(va), hh = vtr(va + 8 * FX_KP);
                    const bf16x8 vf = {lo[0], lo[1], lo[2], lo[3], hh[0], hh[1], hh[2], hh[3]};
                    if (db == 0) o0 = __builtin_amdgcn_mfma_f32_32x32x16_bf16(vf, pf, o0, 0, 0, 0); else o1 = __builtin_amdgcn_mfma_f32_32x32x16_bf16(vf, pf, o1, 0, 0, 0);
                }
            }
        }
        if (kt + 1 < KT) { const int nb = cur ^ 1; *(LAS u32x4*)(lds + FX_K0 + nb * FX_TB + sdst) = kreg; *(LAS u32x4*)(lds + FX_V0 + nb * FX_TB + sdst) = vreg; if (tid < 64) *(LAS float*)(lds + FX_B0 + nb * 256 + tid * 4) = breg; }
        __syncthreads();
    }
    const float inv = 1.0f / (lrow + __shfl_xor(lrow, 32));
    bf16_t* orow = (bf16_t*)(ws + WS_OA) + qrow * 512 + hd * 64;
#pragma unroll
    for (int g = 0; g < 4; ++g) {
        u32x2 w0 = {pk2(o0[4 * g] * inv, o0[4 * g + 1] * inv), pk2(o0[4 * g + 2] * inv, o0[4 * g + 3] * inv)};
        u32x2 w1 = {pk2(o1[4 * g] * inv, o1[4 * g + 1] * inv), pk2(o1[4 * g + 2] * inv, o1[4 * g + 3] * inv)};
        *(u32x2*)(orow + 8 * g + 4 * hi) = w0; *(u32x2*)(orow + 32 + 8 * g + 4 * hi) = w1;
    }
}

constexpr int IX_NP = 2116;
template <int NS>
__device__ __forceinline__ u64 idx_select(const LAS float* row, int nslots, int lane, LAS u64* mwords) {
    unsigned key[NS];
#pragma unroll
    for (int s = 0; s < NS; ++s) { const unsigned u = __float_as_uint(row[64 * (s < nslots ? s : 0) + lane]); key[s] = (s < nslots) ? ((u & 0x80000000u) ? ~u : (u | 0x80000000u)) : 0u; }
    unsigned T = 0u; int cT = 0x7fffffff;
    for (int bit = 31; bit >= 0; --bit) {
        const unsigned cand = T | (1u << bit); int cnt = 0;
#pragma unroll
        for (int s = 0; s < NS; ++s) cnt += __builtin_popcountll(__ballot(key[s] >= cand));
        if (cnt >= 256) { T = cand; cT = cnt; if (cnt == 256) break; }
    }
    int need = 0;
    if (cT != 256) {
        int cgt = 0;
#pragma unroll
        for (int s = 0; s < NS; ++s) cgt += __builtin_popcountll(__ballot(key[s] > T));
        need = 256 - cgt;
    }
    int run = 0;
#pragma unroll
    for (int s = 0; s < NS; ++s) {
        u64 sel;
        if (cT == 256) sel = __ballot(key[s] >= T);
        else {
            const u64 tb = __ballot(key[s] == T);
            const int rank = run + __builtin_popcountll(tb & ((1ull << lane) - 1ull));
            sel = __ballot(key[s] > T || (key[s] == T && rank < need));
            run += __builtin_popcountll(tb);
        }
        if (lane == 0) mwords[s] = sel;
    }
    LDS_WAIT();
    return mwords[lane < NS ? lane : 0];
}
template <int CTRL, int RM> __device__ __forceinline__ unsigned dpp_add(unsigned v) { return v + (unsigned)__builtin_amdgcn_update_dpp(0, (int)v, CTRL, RM, 0xf, false); }
__device__ __forceinline__ unsigned wave_incl_scan(unsigned v) {
    v = dpp_add<0x111, 0xf>(v); v = dpp_add<0x112, 0xf>(v); v = dpp_add<0x114, 0xf>(v); v = dpp_add<0x118, 0xf>(v);
    v = dpp_add<0x142, 0xa>(v); v = dpp_add<0x143, 0xc>(v);
    return v;
}
template <int NS>
__device__ __forceinline__ u64 idx_select_hist(const LAS float* row, int nslots, int lane, LAS u64* mwords, LAS unsigned* hist) {
    unsigned key[NS];
#pragma unroll
    for (int s = 0; s < NS; ++s) { const unsigned u = __float_as_uint(row[64 * (s < nslots ? s : 0) + lane]); key[s] = (s < nslots) ? (u ^ ((unsigned)((int)u >> 31) | 0x80000000u)) : 0u; }
    unsigned prefix = 0u, Tge = 0u; int need = 256, pass = 0; bool simple = false;
#if SELP0
    {
        unsigned km = 0u;
#pragma unroll
        for (int s = 0; s < NS; ++s) km = km > key[s] ? km : key[s];
#pragma unroll
        for (int o = 1; o < 64; o <<= 1) { const unsigned v = (unsigned)__shfl_xor((int)km, o); km = km > v ? km : v; }
        const unsigned dmax = (unsigned)__builtin_amdgcn_readfirstlane((int)(km >> 24));
        if (dmax >= 4u) {
            const unsigned th0 = dmax << 24, th1 = (dmax - 1u) << 24;
            int c0 = 0, c1 = 0;
#pragma unroll
            for (int s = 0; s < NS; ++s) { c0 += __builtin_popcountll(__ballot(key[s] >= th0)); c1 += __builtin_popcountll(__ballot(key[s] >= th1)); }
            int above = -1, cb = 0; unsigned digit = 0u;
            if (c0 >= 256) { digit = dmax; above = 0; cb = c0; } else if (c1 >= 256) { digit = dmax - 1u; above = c0; cb = c1 - c0; }
            else {
                const unsigned th2 = (dmax - 2u) << 24, th3 = (dmax - 3u) << 24;
                int c2 = 0, c3 = 0;
#pragma unroll
                for (int s = 0; s < NS; ++s) { c2 += __builtin_popcountll(__ballot(key[s] >= th2)); c3 += __builtin_popcountll(__ballot(key[s] >= th3)); }
                if (c2 >= 256) { digit = dmax - 2u; above = c1; cb = c2 - c1; } else if (c3 >= 256) { digit = dmax - 3u; above = c2; cb = c3 - c2; }
            }
            if (above >= 0) {
                prefix = digit; need = 256 - above; pass = 1;
                if (cb == need) { Tge = prefix << 24; simple = true; }
            }
        }
    }
#endif
    if (!simple) {
#pragma unroll 1
        for (; pass < 4; ++pass) {
            const int sh = 24 - 8 * pass;
            *(LAS u32x4*)(hist + 4 * lane) = (u32x4){0u, 0u, 0u, 0u};
            LDS_WAIT();
#pragma unroll
            for (int s = 0; s < NS; ++s) {
                const unsigned k = key[s];
                const bool match = (s < nslots) && (pass == 0 || (k >> (sh + 8)) == prefix);
                if (match) __hip_atomic_fetch_add(hist + ((k >> sh) & 255u), 1u, __ATOMIC_RELAXED, __HIP_MEMORY_SCOPE_WORKGROUP);
            }
            LDS_WAIT();
            const u32x4 h = *(const LAS u32x4*)(hist + 4 * (63 - lane));
            const unsigned tl = (h.x + h.y) + (h.z + h.w);
            const unsigned incl = wave_incl_scan(tl);
            const unsigned excl = incl - tl, nd = (unsigned)need;
            const bool mine = (excl < nd) && (nd <= incl);
            const int L = __builtin_ctzll(__ballot(mine));
            unsigned c = excl, bin, above, cbin;
            if (nd <= c + h.w) { bin = 3u; above = c; cbin = h.w; } else { c += h.w;
            if (nd <= c + h.z) { bin = 2u; above = c; cbin = h.z; } else { c += h.z;
            if (nd <= c + h.y) { bin = 1u; above = c; cbin = h.y; } else { c += h.y; bin = 0u; above = c; cbin = h.x; } } }
            const unsigned digit = (unsigned)__builtin_amdgcn_readlane((int)(4u * (unsigned)(63 - lane) + bin), L);
            const unsigned abv = (unsigned)__builtin_amdgcn_readlane((int)above, L);
            const unsigned cb = (unsigned)__builtin_amdgcn_readlane((int)cbin, L);
            prefix = (prefix << 8) | digit; need -= (int)abv;
            if ((int)cb == need) { Tge = prefix << sh; simple = true; break; }
        }
    }
    if (simple) {
        unsigned lo = 0u, hi = 0u;
#pragma unroll
        for (int s = 0; s < NS; ++s) {
            const u64 sel = __ballot(key[s] >= Tge);
            asm("s_nop 1\n\tv_writelane_b32 %0, %2, %4\n\tv_writelane_b32 %1, %3, %4" : "+v"(lo), "+v"(hi) : "s"((unsigned)sel), "s"((unsigned)(sel >> 32)), "n"(s));
        }
        return ((u64)hi << 32) | lo;
    }
    const unsigned T = prefix; int run = 0;
#pragma unroll 1
    for (int s = 0; s < NS; ++s) {
        const unsigned k = __float_as_uint(row[64 * (s < nslots ? s : 0) + lane]); const unsigned ks = (s < nslots) ? (k ^ ((unsigned)((int)k >> 31) | 0x80000000u)) : 0u;
        const u64 tb = __ballot(ks == T);
        const int rank = run + __builtin_popcountll(tb & ((1ull << lane) - 1ull));
        const u64 sel = __ballot(ks > T || (ks == T && rank < need));
        run += __builtin_popcountll(tb);
        if (lane == 0) mwords[s] = sel;
    }
    LDS_WAIT();
    return mwords[lane < NS ? lane : 0];
}
__device__ __forceinline__ void idx_unit(Frame& F, int b, int c, int g16) {
    const ArgsP A = fresh_args();
    const int lane = F.lane, wid = F.wave;
    unsigned char* ws = A->ws;
    const bf16_t* QIDX = (const bf16_t*)(ws + WS_QIDX); const bf16_t* KIDX = (const bf16_t*)(ws + WS_KIDX); const float* IW = (const float*)(ws + WS_IW);
    u64* MASKW = (u64*)(ws + WS_MASKW);
    LAS float* sc = (LAS float*)F.lds;
    LAS u64* mwl = (LAS u64*)(F.lds + 16 * IX_NP * 4) + wid * 40;
    LAS unsigned* hst = (LAS unsigned*)(F.lds + 138240) + wid * 256;
    const int nslots = c + 2, nadm = 80 + 64 * c;
    const int q0 = 64 * c + 16 * g16;
    if (nadm > 256) {
        const int fr = lane & 15, fq = lane >> 4;
        const size_t qrow = (size_t)b * 2048 + q0 + fr;
        bf16x8 qf[4][2];
#pragma unroll
        for (int h = 0; h < 4; ++h)
#pragma unroll
            for (int s = 0; s < 2; ++s) qf[h][s] = *(const bf16x8*)(QIDX + qrow * 256 + h * 64 + s * 32 + fq * 8);
        const f32x4 wq = *(const f32x4*)(IW + qrow * 4);
        const bf16_t* kb = KIDX + ((size_t)b * TPB + fr) * 64 + fq * 8;
        const int nt16 = 4 * nslots;
        int nrs = (IDXREP & 1) ? 2 : 1; asm volatile("" : "+s"(nrs));
        for (int rs = 0; rs < nrs; ++rs)
        for (int t0 = wid; t0 < nt16; t0 += 32) {
            bf16x8 k0[4], k1[4];
#pragma unroll
            for (int j = 0; j < 4; ++j) { const int t = (t0 + 8 * j < nt16) ? t0 + 8 * j : t0; k0[j] = *(const bf16x8*)(kb + (size_t)t * 16 * 64); k1[j] = *(const bf16x8*)(kb + (size_t)t * 16 * 64 + 32); }
#pragma unroll
            for (int j = 0; j < 4; ++j) {
                const int t = t0 + 8 * j;
                if (t < nt16) {
                    f32x4 acc = {0.f, 0.f, 0.f, 0.f};
#pragma unroll
                    for (int h = 0; h < 4; ++h) {
                        f32x4 a = {0.f, 0.f, 0.f, 0.f};
                        a = __builtin_amdgcn_mfma_f32_16x16x32_bf16(k0[j], qf[h][0], a, 0, 0, 0);
                        a = __builtin_amdgcn_mfma_f32_16x16x32_bf16(k1[j], qf[h][1], a, 0, 0, 0);
                        const float w = wq[h];
                        acc.x += w * fmaxf(a.x, 0.f); acc.y += w * fmaxf(a.y, 0.f); acc.z += w * fmaxf(a.z, 0.f); acc.w += w * fmaxf(a.w, 0.f);
                    }
                    const int kp = 16 * t + 4 * fq;
                    if (kp + 0 >= nadm) acc.x = NEGBIG; if (kp + 1 >= nadm) acc.y = NEGBIG; if (kp + 2 >= nadm) acc.z = NEGBIG; if (kp + 3 >= nadm) acc.w = NEGBIG;
                    *(LAS f32x4*)(sc + fr * IX_NP + kp) = acc;
                }
            }
        }
    }
    __syncthreads();
    int nrq = (IDXREP & 2) ? 4 : 2; asm volatile("" : "+s"(nrq));
    for (int qq = 0; qq < nrq; ++qq) {
        const int ql = 2 * wid + (qq & 1);
        const size_t qrow = (size_t)b * 2048 + q0 + ql;
        u64 myword = 0ull;
        if (nadm <= 256) {
#pragma unroll
            for (int s = 0; s < 5; ++s) { const u64 bl = __ballot(64 * s + lane < nadm); if (lane == s) myword = bl; }
        } else if (nslots <= 8) myword = SELHIST ? idx_select_hist<8>(sc + ql * IX_NP, nslots, lane, mwl, hst) : idx_select<8>(sc + ql * IX_NP, nslots, lane, mwl);
        else if (nslots <= 12) myword = SELHIST ? idx_select_hist<12>(sc + ql * IX_NP, nslots, lane, mwl, hst) : idx_select<12>(sc + ql * IX_NP, nslots, lane, mwl);
        else if (nslots <= 16) myword = SELHIST ? idx_select_hist<16>(sc + ql * IX_NP, nslots, lane, mwl, hst) : idx_select<16>(sc + ql * IX_NP, nslots, lane, mwl);
        else if (nslots <= 20) myword = SELHIST ? idx_select_hist<20>(sc + ql * IX_NP, nslots, lane, mwl, hst) : idx_select<20>(sc + ql * IX_NP, nslots, lane, mwl);
        else if (nslots <= 24) myword = SELHIST ? idx_select_hist<24>(sc + ql * IX_NP, nslots, lane, mwl, hst) : idx_select<24>(sc + ql * IX_NP, nslots, lane, mwl);
        else if (nslots <= 28) myword = SELHIST ? idx_select_hist<28>(sc + ql * IX_NP, nslots, lane, mwl, hst) : idx_select<28>(sc + ql * IX_NP, nslots, lane, mwl);
        else myword = SELHIST ? idx_select_hist<NKT>(sc + ql * IX_NP, nslots, lane, mwl, hst) : idx_select<NKT>(sc + ql * IX_NP, nslots, lane, mwl);
        if (lane < nslots) MASKW[qrow * NKT + lane] = myword;
#if SELCHECK
        if (wid == 0 && qq == 0 && g16 == 0) {
            const LAS float* row = sc + ql * IX_NP; bool bad = false;
            for (int s0 = 0; s0 < nslots; ++s0) {
                const int i = 64 * s0 + lane; const bool adm = i < nadm;
                bool sel;
                if (nadm <= 256) sel = adm;
                else {
                    const float xi = row[i]; int rank = 0;
                    for (int j2 = 0; j2 < nadm; ++j2) { const float xj = row[j2]; rank += (xj > xi || (xj == xi && j2 < i)) ? 1 : 0; }
                    sel = adm && rank < 256;
                }
                const u64 wmask = __shfl(myword, s0);
                const bool got = (wmask >> lane) & 1ull;
                if (got != sel) bad = true;
            }
            if (__any(bad) && lane == 0) atomicOr((unsigned*)(ws + WS_CTL) + CW_ERR, 1u);
        }
#endif
    }
    __syncthreads();
}

constexpr int D8_KP = 208, D8_KT = 64 * D8_KP;
constexpr int D8_VP = 80, D8_VT = 128 * D8_VP;
constexpr int D8_K0 = 0, D8_V0 = 2 * D8_KT;
__device__ __forceinline__ v8i_t ld32(const LAS unsigned char* p) { return __builtin_shufflevector(*(const LAS v4i_t*)p, *(const LAS v4i_t*)(p + 16), 0, 1, 2, 3, 4, 5, 6, 7); }
#define MFMA8(acc, a, b) asm volatile("s_nop 1\n\tv_mfma_scale_f32_32x32x64_f8f6f4 %0, %1, %2, %0, %3, %3 op_sel_hi:[0,0,0]" : "+v"(acc) : "v"(a), "v"(b), "v"(sc1))
__device__ __forceinline__ void dsa_unit(Frame& F, int b, int c, int half) {
    const ArgsP A = fresh_args();
    const int tid = F.tid, lane = F.lane, r32 = lane & 31, hi = lane >> 5, wid = F.wave;
    unsigned char* ws = A->ws;
    const unsigned char* QL8 = ws + WS_QL; const unsigned char* K8 = ws + WS_KVR + (size_t)b * TPB * 192; const unsigned char* VT8 = ws + WS_VT8 + (size_t)b * NKT * 128 * 64;
    const u64* MASKW = (const u64*)(ws + WS_MASKW);
    LAS unsigned char* lds = F.lds;
    const int i0 = 64 * c + 32 * half;
    const size_t qrow = (size_t)b * 2048 + i0 + r32;
    int sc1 = 0x7f7f7f7f; asm volatile("" : "+v"(sc1));
    v8i_t qf[3];
#pragma unroll
    for (int s3 = 0; s3 < 3; ++s3) { const unsigned char* qp = QL8 + qrow * 1536 + wid * 192 + 64 * s3 + 32 * hi;
        qf[s3] = __builtin_shufflevector(*(const v4i_t*)qp, *(const v4i_t*)(qp + 16), 0, 1, 2, 3, 4, 5, 6, 7); }
    const int KT = c + 2;
    const int kc1 = tid + 512; const bool k1ok = kc1 < 768;
    const int kr0 = tid / 12, kq0 = tid % 12, kr1 = k1ok ? kc1 / 12 : 0, kq1 = k1ok ? kc1 % 12 : 0;
    const int vd = tid >> 2, vq = tid & 3;
    u32x4 sk0, sk1, sv;
    sk0 = *(const u32x4*)(K8 + (size_t)kr0 * 192 + kq0 * 16); sk1 = *(const u32x4*)(K8 + (size_t)kr1 * 192 + kq1 * 16); sv = *(const u32x4*)(VT8 + (size_t)vd * 64 + vq * 16);
    *(LAS u32x4*)(lds + D8_K0 + kr0 * D8_KP + kq0 * 16) = sk0; if (k1ok) *(LAS u32x4*)(lds + D8_K0 + kr1 * D8_KP + kq1 * 16) = sk1; *(LAS u32x4*)(lds + D8_V0 + vd * D8_VP + vq * 16) = sv;
    u64 mw = MASKW[qrow * NKT + 0], mwn = 0ull;
    __syncthreads();
    f32x16 o[4]; o[0] = f32x16{}; o[1] = f32x16{}; o[2] = f32x16{}; o[3] = f32x16{};
    float mrow = NEGBIG, lrow = 0.f;
    for (int kt = 0; kt < KT; ++kt) {
        const int cur = kt & 1;
        if (kt + 1 < KT) {
            const unsigned char* kn = K8 + (size_t)(kt + 1) * 64 * 192; const unsigned char* vn = VT8 + (size_t)(kt + 1) * 128 * 64;
            sk0 = *(const u32x4*)(kn + (size_t)kr0 * 192 + kq0 * 16); sk1 = *(const u32x4*)(kn + (size_t)kr1 * 192 + kq1 * 16); sv = *(const u32x4*)(vn + (size_t)vd * 64 + vq * 16);
            mwn = MASKW[qrow * NKT + kt + 1];
        }
        {
            const LAS unsigned char* Kb = lds + D8_K0 + cur * D8_KT + r32 * D8_KP + 32 * hi;
            const LAS unsigned char* Vb = lds + D8_V0 + cur * D8_VT + r32 * D8_VP + 32 * hi;
            v8i_t ka[3];
            f32x16 p0 = {}, p1 = {};
#pragma unroll
            for (int s3 = 0; s3 < 3; ++s3) ka[s3] = ld32(Kb + 64 * s3);
#pragma unroll
            for (int s3 = 0; s3 < 3; ++s3) MFMA8(p0, ka[s3], qf[s3]);
            __builtin_amdgcn_sched_barrier(0);
#pragma unroll
            for (int s3 = 0; s3 < 3; ++s3) ka[s3] = ld32(Kb + 32 * D8_KP + 64 * s3);
#pragma unroll
            for (int s3 = 0; s3 < 3; ++s3) MFMA8(p1, ka[s3], qf[s3]);
            __builtin_amdgcn_sched_barrier(0);
            v8i_t vf[4];
#pragma unroll
            for (int db = 0; db < 4; ++db) vf[db] = ld32(Vb + 32 * db * D8_VP);
            asm volatile("s_nop 15\n\ts_nop 7" : "+v"(p0), "+v"(p1));
            const unsigned m0 = (unsigned)mw, m1 = (unsigned)(mw >> 32);
            constexpr float IQ = 1.0f / QSC;
#pragma unroll
            for (int r = 0; r < 16; ++r) { const int kbit = crow(r, hi);
                const int t0 = __builtin_amdgcn_sbfe((int)m0, kbit, 1), t1 = __builtin_amdgcn_sbfe((int)m1, kbit, 1);
                p0[r] = __uint_as_float((__float_as_uint(p0[r]) & (unsigned)t0) | (0xf149f2cau & ~(unsigned)t0));
                p1[r] = __uint_as_float((__float_as_uint(p1[r]) & (unsigned)t1) | (0xf149f2cau & ~(unsigned)t1)); }
            float mx = max32(p0, p1); mx = fmaxf(mx, __shfl_xor(mx, 32)) * IQ;
            const float mnew = fmaxf(mrow, mx), alpha = fast_exp2(mrow - mnew); mrow = mnew;
            const float mofs = 7.0f - mnew;
            float sum = 0.f;
#pragma unroll
            for (int r = 0; r < 16; ++r) { p0[r] = fast_exp2(fmaf(p0[r], IQ, mofs)); p1[r] = fast_exp2(fmaf(p1[r], IQ, mofs)); sum += p0[r] + p1[r]; }
            lrow = lrow * alpha + sum;
#pragma unroll
            for (int db = 0; db < 4; ++db)
#pragma unroll
                for (int r = 0; r < 16; ++r) o[db][r] *= alpha;
            v8i_t pb;
#pragma unroll
            for (int g = 0; g < 4; ++g) { pb[g] = (int)pk4_fp8(p0[4 * g], p0[4 * g + 1], p0[4 * g + 2], p0[4 * g + 3]);
                                         pb[4 + g] = (int)pk4_fp8(p1[4 * g], p1[4 * g + 1], p1[4 * g + 2], p1[4 * g + 3]); }
#pragma unroll
            for (int db = 0; db < 4; ++db) MFMA8(o[db], vf[db], pb);
            asm volatile("s_nop 15\n\ts_nop 7" : "+v"(o[0]), "+v"(o[1]), "+v"(o[2]), "+v"(o[3]));
        }
        if (kt + 1 < KT) {
            const int nb = cur ^ 1;
            *(LAS u32x4*)(lds + D8_K0 + nb * D8_KT + kr0 * D8_KP + kq0 * 16) = sk0; if (k1ok) *(LAS u32x4*)(lds + D8_K0 + nb * D8_KT + kr1 * D8_KP + kq1 * 16) = sk1;
            *(LAS u32x4*)(lds + D8_V0 + nb * D8_VT + vd * D8_VP + vq * 16) = sv;
            mw = mwn;
        }
        __syncthreads();
    }
    const float inv = 1.0f / (lrow + __shfl_xor(lrow, 32));
    unsigned char* orow = ws + WS_OLAT + qrow * 1024 + wid * 128;
    const float isc = inv * OLSC;
#pragma unroll
    for (int db = 0; db < 4; ++db)
#pragma unroll
        for (int g = 0; g < 4; ++g)
            *(unsigned*)(orow + 32 * db + 8 * g + 4 * hi) = pk4_fp8(o[db][4 * g] * isc, o[db][4 * g + 1] * isc, o[db][4 * g + 2] * isc, o[db][4 * g + 3] * isc);
}
#undef MFMA8

__device__ __forceinline__ void p8_router(Frame& F) {
    const ArgsP A = fresh_args();
    unsigned char* ws = A->ws; const int lane = F.lane, tid = F.tid;
    const bf16_t* H1 = (const bf16_t*)(ws + WS_H1B); const float* g = A->in[I_NORM_FFN_G]; const float* WR = A->in[I_W_ROUTER]; const float* BR = A->in[I_B_ROUTER];
    int* TOPE = (int*)(ws + WS_TOPE); float* TOPG = (float*)(ws + WS_TOPG); int* LR = (int*)(ws + WS_LR); int* BC = (int*)(ws + WS_BC);
    LAS unsigned char* wf = F.lds;
    LAS int* te = (LAS int*)(F.lds + 131072);
    for (int o0 = tid; o0 < 32 * 1024; o0 += 512 * 8) {
        float wv[8], gv[8];
#pragma unroll
        for (int q = 0; q < 8; ++q) { const int o = o0 + 512 * q; wv[q] = WR[o]; gv[q] = g[o >> 5]; }
#pragma unroll
        for (int q = 0; q < 8; ++q) {
            const int o = o0 + 512 * q; const int k = o >> 5, e = o & 31;
            const float w = wv[q] * gv[q];
            const unsigned hb = pk2(w, 0.f) & 0xffffu; const unsigned lb = pk2(w - bflo(hb), 0.f) & 0xffffu;
            const int st = ((k >> 5) << 1) | ((k >> 3) & 1), ln = e + 32 * ((k >> 4) & 1), j = k & 7;
            *(LAS bf16_t*)(wf + ((st * 2 + 0) * 64 + ln) * 16 + j * 2) = (bf16_t)hb;
            *(LAS bf16_t*)(wf + ((st * 2 + 1) * 64 + ln) * 16 + j * 2) = (bf16_t)lb;
        }
    }
    __syncthreads();
    const int tk = lane & 31, h = lane >> 5;
    for (int un = F.bid; un < 256; un += F.G) {
        const int rl = F.wave * 32 + tk; const int m = un * 256 + rl;
        const u32x4* xr = (const u32x4*)(H1 + (size_t)m * 1024 + 16 * h);
        f32x16 ahh, alh;
#pragma unroll
        for (int r = 0; r < 16; ++r) { ahh[r] = 0.f; alh[r] = 0.f; }
        float ss = 0.f;
        u32x4 bA[8], bB[8];
#define RT_LOAD(buf, c) { _Pragma("unroll") for (int i = 0; i < 8; ++i) buf[i] = xr[(c) * 16 + (i >> 1) * 4 + (i & 1)]; }
#define RT_PROC(buf, c) { _Pragma("unroll") for (int q = 0; q < 8; ++q) { \
            const u32x4 xp = buf[q]; \
            { const float e0 = bflo(xp.x), e1 = bfhi(xp.x), e2 = bflo(xp.y), e3 = bfhi(xp.y), e4 = bflo(xp.z), e5 = bfhi(xp.z), e6 = bflo(xp.w), e7 = bfhi(xp.w); \
              ss += (e0 * e0 + e1 * e1) + (e2 * e2 + e3 * e3) + (e4 * e4 + e5 * e5) + (e6 * e6 + e7 * e7); } \
            const LAS unsigned char* wp = wf + (size_t)((c) * 8 + q) * 2048 + lane * 16; \
            const bf16x8 wh = *(const LAS bf16x8*)wp, wl = *(const LAS bf16x8*)(wp + 1024); \
            const bf16x8 xh = __builtin_bit_cast(bf16x8, xp); \
            ahh = __builtin_amdgcn_mfma_f32_32x32x16_bf16(wh, xh, ahh, 0, 0, 0); \
            alh = __builtin_amdgcn_mfma_f32_32x32x16_bf16(wl, xh, alh, 0, 0, 0); } }
        RT_LOAD(bA, 0)
#pragma unroll 1
        for (int c = 0; c < 8; c += 2) {
            RT_LOAD(bB, c + 1)
            RT_PROC(bA, c)
            { const int cn = c + 2 < 8 ? c + 2 : 7; RT_LOAD(bA, cn) }
            RT_PROC(bB, c + 1)
        }
#undef RT_LOAD
#undef RT_PROC
        ss += __shfl_xor(ss, 32);
        const float rstd = 1.0f / sqrtf(ss * (1.f / 1024.f) + EPS);
        float t0 = -INFINITY, t1 = -INFINITY, t2 = -INFINITY, t3 = -INFINITY; int i0 = 99, i1 = 99, i2 = 99, i3 = 99;
#define RT_GT(v, id, tv, ti) ((v) > (tv) || ((v) == (tv) && (id) < (ti)))
#define RT_INS(v, id) { const bool c0 = RT_GT(v, id, t0, i0), c1 = RT_GT(v, id, t1, i1), c2 = RT_GT(v, id, t2, i2), c3 = RT_GT(v, id, t3, i3); \
            t3 = c2 ? t2 : (c3 ? (v) : t3); i3 = c2 ? i2 : (c3 ? (id) : i3); t2 = c1 ? t1 : (c2 ? (v) : t2); i2 = c1 ? i1 : (c2 ? (id) : i2); \
            t1 = c0 ? t0 : (c1 ? (v) : t1); i1 = c0 ? i0 : (c1 ? (id) : i1); t0 = c0 ? (v) : t0; i0 = c0 ? (id) : i0; }
#pragma unroll
        for (int r = 0; r < 16; ++r) { const int id = crow(r, 0) + 4 * h; const float v = (ahh[r] + alh[r]) * rstd + BR[id]; RT_INS(v, id) }
        { const float p0 = __shfl_xor(t0, 32), p1 = __shfl_xor(t1, 32), p2 = __shfl_xor(t2, 32), p3 = __shfl_xor(t3, 32);
          const int j0 = __shfl_xor(i0, 32), j1 = __shfl_xor(i1, 32), j2 = __shfl_xor(i2, 32), j3 = __shfl_xor(i3, 32);
          RT_INS(p0, j0) RT_INS(p1, j1) RT_INS(p2, j2) RT_INS(p3, j3) }
#undef RT_INS
#undef RT_GT
        const float e1 = __expf(t1 - t0), e2 = __expf(t2 - t0), e3 = __expf(t3 - t0);
        const float inv = 1.0f / (1.0f + e1 + e2 + e3);
        if (h == 0) {
            *(int4*)(TOPE + (size_t)m * 4) = make_int4(i0, i1, i2, i3);
            *(f32x4*)(TOPG + (size_t)m * 4) = (f32x4){inv, e1 * inv, e2 * inv, e3 * inv};
            *(LAS v4i_t*)(te + rl * 4) = (v4i_t){i0, i1, i2, i3};
        }
        __syncthreads();
        for (int e = F.wave * 4; e < F.wave * 4 + 4; ++e) {
            int run = 0;
            for (int r4 = 0; r4 < 4; ++r4) {
                const int rl = r4 * 64 + lane;
                const int a0 = te[rl * 4], a1 = te[rl * 4 + 1], a2 = te[rl * 4 + 2], a3 = te[rl * 4 + 3];
                const int kk = (a0 == e) ? 0 : (a1 == e) ? 1 : (a2 == e) ? 2 : (a3 == e) ? 3 : -1;
                const u64 bl = __ballot(kk >= 0);
                if (kk >= 0) LR[(size_t)(un * 256 + rl) * 4 + kk] = run + __builtin_popcountll(bl & ((1ull << lane) - 1ull));
                run += __builtin_popcountll(bl);
            }
            if (lane == 0) BC[un * 32 + e] = run;
        }
        __syncthreads();
    }
}

__device__ __forceinline__ void p9_slots(Frame& F) {
    const ArgsP A = fresh_args();
    unsigned char* ws = A->ws; const int lane = F.lane, tid = F.tid;
    const bf16_t* H1 = (const bf16_t*)(ws + WS_H1B); const float* g = A->in[I_NORM_FFN_G];
    const int* TOPE = (const int*)(ws + WS_TOPE); const float* TOPG = (const float*)(ws + WS_TOPG); const int* LR = (const int*)(ws + WS_LR); const int* BC = (const int*)(ws + WS_BC);
    int* TOKSLOT = (int*)(ws + WS_TOKSLOT); float* SLOTG = (float*)(ws + WS_SLOTG); int* TILEE = (int*)(ws + WS_TILEE); int* GRP = (int*)(ws + WS_GRP);
    bf16_t* XBY = (bf16_t*)(ws + WS_XBY);
    LAS int* tot = (LAS int*)F.lds;
    LAS int* pst = tot + 32;
    LAS int* base = pst + 40;
    for (int un = F.bid; un < 256; un += F.G) {
        if (tid < 32) { tot[tid] = 0; base[tid] = 0; }
        __syncthreads();
        { const int e = tid & 31, part = tid >> 5; int c[16];
#pragma unroll
          for (int j = 0; j < 16; ++j) c[j] = ld_agent_i(BC + (part * 16 + j) * 32 + e);
          int t = 0, bs = 0;
#pragma unroll
          for (int j = 0; j < 16; ++j) { t += c[j]; if (part * 16 + j < un) bs += c[j]; }
          __hip_atomic_fetch_add(tot + e, t, __ATOMIC_RELAXED, __HIP_MEMORY_SCOPE_WORKGROUP); __hip_atomic_fetch_add(base + e, bs, __ATOMIC_RELAXED, __HIP_MEMORY_SCOPE_WORKGROUP); }
        __syncthreads();
        if (tid == 0) { int s = 0; for (int e = 0; e < 32; ++e) { pst[e] = s; s += ((tot[e] + 255) >> 8) << 8; } pst[32] = s; }
        __syncthreads();
        if (un == 0 && tid >= 64 && tid < 96) { const int e = tid - 64; const int t0 = pst[e] >> 8, t1 = pst[e + 1] >> 8; for (int t = t0; t < t1; ++t) TILEE[t] = e; }
        if (un == 0 && tid == 0) {
            int ng = 0, gl = 0; int* gt = GRP + 4;
            for (int e = 0; e < 32; ++e) {
                const int t0 = pst[e] >> 8, t1 = pst[e + 1] >> 8;
                if (t1 - gl > ACT_CAP_TILES) { gt[ng] = gl; gt[MAXG + ng] = t0; ++ng; gl = t0; }
            }
            gt[ng] = gl; gt[MAXG + ng] = pst[32] >> 8; ++ng;
            GRP[0] = ng; GRP[1] = pst[32] >> 8;
        }
        f32x4 v[4], vn[4];
#pragma unroll
        for (int j = 0; j < 4; ++j) v[j] = ld4bf(H1 + (size_t)(un * 256 + F.wave * 32) * 1024 + 4 * lane + 256 * j);
        int4 te = *(const int4*)(TOPE + (size_t)(un * 256 + F.wave * 32) * 4), lr = *(const int4*)(LR + (size_t)(un * 256 + F.wave * 32) * 4); f32x4 tg = *(const f32x4*)(TOPG + (size_t)(un * 256 + F.wave * 32) * 4);
        for (int rr = 0; rr < 32; ++rr) {
            const int m = un * 256 + F.wave * 32 + rr; const int mn = rr < 31 ? m + 1 : m;
            const f32x4* gr = (const f32x4*)g + lane;
#pragma unroll
            for (int j = 0; j < 4; ++j) vn[j] = ld4bf(H1 + (size_t)mn * 1024 + 4 * lane + 256 * j);
            const int4 ten = *(const int4*)(TOPE + (size_t)mn * 4), lrn = *(const int4*)(LR + (size_t)mn * 4); const f32x4 tgn = *(const f32x4*)(TOPG + (size_t)mn * 4);
            float s = 0.f;
#pragma unroll
            for (int j = 0; j < 4; ++j) s += (v[j].x * v[j].x + v[j].y * v[j].y) + (v[j].z * v[j].z + v[j].w * v[j].w);
            const float rstd = 1.0f / sqrtf(wave_sum(s) * (1.f / 1024.f) + EPS);
            unsigned pk[4];
#pragma unroll
            for (int j = 0; j < 4; ++j) { const f32x4 gg = gr[64 * j]; pk[j] = pk4_fp8(v[j].x * rstd * gg.x, v[j].y * rstd * gg.y, v[j].z * rstd * gg.z, v[j].w * rstd * gg.w); }
            int sl[4];
            sl[0] = pst[te.x] + base[te.x] + lr.x; sl[1] = pst[te.y] + base[te.y] + lr.y; sl[2] = pst[te.z] + base[te.z] + lr.z; sl[3] = pst[te.w] + base[te.w] + lr.w;
#pragma unroll
            for (int k = 0; k < 4; ++k) { unsigned* o4 = (unsigned*)((unsigned char*)XBY + (size_t)sl[k] * 1024) + lane;
#pragma unroll
                for (int j = 0; j < 4; ++j) o4[64 * j] = pk[j]; }
            if (lane == 0) { *(int4*)(TOKSLOT + (size_t)m * 4) = make_int4(sl[0], sl[1], sl[2], sl[3]); SLOTG[sl[0]] = tg.x; SLOTG[sl[1]] = tg.y; SLOTG[sl[2]] = tg.z; SLOTG[sl[3]] = tg.w; }
#pragma unroll
            for (int j = 0; j < 4; ++j) v[j] = vn[j];
            te = ten; lr = lrn; tg = tgn;
        }
        __syncthreads();
    }
}

template <bool WITH_MOE>
__device__ __forceinline__ void p_final(Frame& F) {
    const ArgsP A = fresh_args();
    unsigned char* ws = A->ws; const int lane = F.lane;
    float* OUT = A->out; const bf16_t* H1 = (const bf16_t*)(ws + WS_H1B); const float* g = A->in[I_NORM_FINAL_G];
    const int* TOKSLOT = (const int*)(ws + WS_TOKSLOT); const bf16_t* Y = (const bf16_t*)(ws + WS_Y);
    const int gw = F.bid * 8 + F.wave, NGW = F.G * 8;
    const f32x4* gr = (const f32x4*)g + lane;
    f32x4 v[4], vn[4]; unsigned y[4][4], yn[4][4]; int4 sl = make_int4(0, 0, 0, 0), sln = sl;
    if (gw < M) {
        if (WITH_MOE) sl = *(const int4*)(TOKSLOT + (size_t)gw * 4);
#pragma unroll
        for (int j = 0; j < 4; ++j) v[j] = ld4bf(H1 + (size_t)gw * 1024 + 4 * lane + 256 * j);
        if (WITH_MOE) {
            const int sls[4] = {sl.x, sl.y, sl.z, sl.w};
#pragma unroll
            for (int k = 0; k < 4; ++k)
#pragma unroll
                for (int j = 0; j < 4; ++j) y[k][j] = ((const unsigned*)((const unsigned char*)Y + (size_t)sls[k] * 1024) + lane)[64 * j];
            const int m1 = (gw + NGW < M) ? gw + NGW : gw;
            sln = *(const int4*)(TOKSLOT + (size_t)m1 * 4);
        }
    }
    for (int m = gw; m < M; m += NGW) {
        const int m1 = (m + NGW < M) ? m + NGW : m, m2 = (m + 2 * NGW < M) ? m + 2 * NGW : m;
#pragma unroll
        for (int j = 0; j < 4; ++j) vn[j] = ld4bf(H1 + (size_t)m1 * 1024 + 4 * lane + 256 * j);
        int4 sl2 = sln;
        if (WITH_MOE) {
            const int sls[4] = {sln.x, sln.y, sln.z, sln.w};
#pragma unroll
            for (int k = 0; k < 4; ++k)
#pragma unroll
                for (int j = 0; j < 4; ++j) yn[k][j] = ((const unsigned*)((const unsigned char*)Y + (size_t)sls[k] * 1024) + lane)[64 * j];
            sl2 = *(const int4*)(TOKSLOT + (size_t)m2 * 4);
        }
        if (WITH_MOE) {
#pragma unroll
            for (int k = 0; k < 4; ++k)
#pragma unroll
                for (int j = 0; j < 4; ++j) { const int w = (int)y[k][j]; const f32x2 lo = __builtin_amdgcn_cvt_pk_f32_fp8(w, false), hi2 = __builtin_amdgcn_cvt_pk_f32_fp8(w, true); v[j].x += lo.x; v[j].y += lo.y; v[j].z += hi2.x; v[j].w += hi2.y; }
        }
        float s2 = 0.f;
#pragma unroll
        for (int j = 0; j < 4; ++j) s2 += (v[j].x * v[j].x + v[j].y * v[j].y) + (v[j].z * v[j].z + v[j].w * v[j].w);
        const float rstd = 1.0f / sqrtf(wave_sum(s2) * (1.f / 1024.f) + EPS);
        f32x4* xr = (f32x4*)(OUT + (size_t)m * 1024) + lane;
#pragma unroll
        for (int j = 0; j < 4; ++j) xr[64 * j] = v[j] * rstd * gr[64 * j];
#pragma unroll
        for (int j = 0; j < 4; ++j) v[j] = vn[j];
        if (WITH_MOE) {
#pragma unroll
            for (int k = 0; k < 4; ++k)
#pragma unroll
                for (int j = 0; j < 4; ++j) y[k][j] = yn[k][j];
            sln = sl2;
        }
    }
}

#if DSACHECK
__device__ __forceinline__ float fp8_byte_to_f32(unsigned b) { const f32x2 r = __builtin_amdgcn_cvt_pk_f32_fp8((int)b, false); return r.x; }
__device__ __forceinline__ void dsa_check(Frame& F) {
    const ArgsP A = fresh_args(); unsigned char* ws = A->ws; const int lane = F.lane;
    const unsigned char* QL8 = ws + WS_QL; const unsigned char* K8 = ws + WS_KVR; const u64* MASKW = (const u64*)(ws + WS_MASKW);
    const unsigned char* OL8 = ws + WS_OLAT;
    for (int rep = 0; rep < 2; ++rep) {
        const int b = F.bid & 31, i = (F.bid * 613 + rep * 977 + 5) & 2047, h = F.wave;
        const size_t m = (size_t)b * 2048 + i; const int c = i >> 6, nadm = 80 + 64 * c;
        const unsigned char* q = QL8 + m * 1536 + h * 192;
        const float q0 = fp8_byte_to_f32(q[lane]) * (1.0f / QSC), q1 = fp8_byte_to_f32(q[lane + 64]) * (1.0f / QSC), q2 = (lane < 32) ? fp8_byte_to_f32(q[lane + 128]) * (1.0f / QSC) : 0.f;
        const unsigned char* kvb = K8 + (size_t)b * TPB * 192;
        float mx = -3.0e38f;
        for (int pos = 0; pos < nadm; ++pos) {
            const u64 w = MASKW[m * NKT + (pos >> 6)];
            if (!((w >> (pos & 63)) & 1ull)) continue;
            const unsigned char* kr = kvb + (size_t)pos * 192;
            float sdot = q0 * fp8_byte_to_f32(kr[lane]) + q1 * fp8_byte_to_f32(kr[lane + 64]) + ((lane < 32) ? q2 * fp8_byte_to_f32(kr[lane + 128]) : 0.f);
            sdot = wave_sum(sdot); mx = fmaxf(mx, sdot);
        }
        float l = 0.f, o0 = 0.f, o1 = 0.f;
        for (int pos = 0; pos < nadm; ++pos) {
            const u64 w = MASKW[m * NKT + (pos >> 6)];
            if (!((w >> (pos & 63)) & 1ull)) continue;
            const unsigned char* kr = kvb + (size_t)pos * 192;
            const float k0 = fp8_byte_to_f32(kr[lane]), k1 = fp8_byte_to_f32(kr[lane + 64]);
            float sdot = q0 * k0 + q1 * k1 + ((lane < 32) ? q2 * fp8_byte_to_f32(kr[lane + 128]) : 0.f);
            sdot = wave_sum(sdot);
            const float p = exp2f(sdot - mx); l += p; o0 += p * k0; o1 += p * k1;
        }
        o0 /= l; o1 /= l;
        const unsigned char* orow = OL8 + m * 1024 + h * 128;
        const float g0 = fp8_byte_to_f32(orow[lane]) * (1.0f / OLSC), g1 = fp8_byte_to_f32(orow[lane + 64]) * (1.0f / OLSC);
        const float num = wave_sum((g0 - o0) * (g0 - o0) + (g1 - o1) * (g1 - o1)), den = wave_sum(o0 * o0 + o1 * o1);
        if (!(num <= 0.02f * den) && lane == 0) atomicOr((unsigned*)(ws + WS_CTL) + CW_ERR, 2u);
    }
}
#endif
__global__ void __launch_bounds__(512, 2) fwd_kernel(Args args) {
    volatile LAS unsigned* MISC = (volatile LAS unsigned*)((LAS unsigned char*)lds_raw + MISC_OFF);
    for (int u = threadIdx.x; u < 128; u += 512) MISC[u] = 0u;
    __syncthreads();
    XcdBarrier bar = xcd_barrier_post((unsigned*)(fresh_args()->ws + WS_CTL) + CW_BAR, MISC + 8);
    const int G = gridDim.x, bid = blockIdx.x;
#define GRID_BAR() xcd_barrier(bar)

#if DBG_STAGE == 1
    { Frame F = mkframe(); const ArgsP A = fresh_args(); const int gw = bid * 8 + F.wave, NGW = G * 8;
      for (int m = gw; m < M; m += NGW) { const f32x4* xr = (const f32x4*)(A->in[I_X] + (size_t)m * 1024) + F.lane; f32x4* orow = (f32x4*)(A->out + (size_t)m * 1024) + F.lane;
#pragma unroll
          for (int j = 0; j < 4; ++j) orow[64 * j] = xr[64 * j]; } }
    GRID_BAR();
    { Frame F = mkframe(); p_final<false>(F); }
#else
    PH(0) REPBEG(0) { Frame F = mkframe(); p0_prologue(F); } REPEND(0)
    GRID_BAR();
    PH(1) REPBEG(1) {
        Frame F = mkframe(); const ArgsP A = fresh_args(); unsigned char* const ws = A->ws;
        const bool gates_first = ((bid >> 3) & 1) != 0;
#pragma unroll 1
        for (int hf = 0; hf < 2; ++hf) {
            if ((hf == 0) != gates_first) {
                pg8::DenseSched S; S.init(ws + WS_XN, ws + WS_WIN_T, M, 2048, 1024, G, bid);
                EpiProj E{(bf16_t*)(ws + WS_QA), (bf16_t*)(ws + WS_KA), (bf16_t*)(ws + WS_VA), (bf16_t*)(ws + WS_CQ), (bf16_t*)(ws + WS_SGA), (bf16_t*)(ws + WS_SGB), (float*)(ws + WS_T7)};
                pg8::gemm_phase<EpiProj, pg8::DenseSched, true, true>(F.lds, 1024, S, E);
            } else {
                pg8::DenseSched S; S.init(ws + WS_XN8, ws + WS_WIN8, M, 2048, 512, G, bid);
                EpiGate E{(bf16_t*)(ws + WS_SGA), (bf16_t*)(ws + WS_SGB)};
                int k8 = 512; asm volatile("" : "+s"(k8));
                pg8::gemm_phase<EpiGate, pg8::DenseSched, true, true, true>(F.lds, k8, S, E);
            }
        }
    } REPEND(1)
    GRID_BAR();
    PH(2) REPBEG(2) { Frame F = mkframe(); p2_post(F); } REPEND(2)
    GRID_BAR();
    PH(3) REPBEG(3) {
        Frame F = mkframe(); const ArgsP A = fresh_args(); unsigned char* const ws = A->ws;
        pg8::DenseSched S; S.init(ws + WS_CQ, ws + WS_WQ2_T, M, 1536, 256, G, bid);
        EpiQ E{(bf16_t*)(ws + WS_QL), (bf16_t*)(ws + WS_QIDX), (const float*)(ws + WS_RSTDQ), (const float*)(ws + WS_COS), (const float*)(ws + WS_SIN)};
        int kq = 256; asm volatile("" : "+s"(kq));
        pg8::gemm_phase<EpiQ, pg8::DenseSched, true, true>(F.lds, kq, S, E);
        vt8_build(F);
    } REPEND(3)
    GRID_BAR();
    PH(4) REPBEG(4) { Frame F = mkframe(); for (int p = bid; p < 1024; p += G) {
        const int bh = p >> 2, s = p & 3;
        fox_unit(F, bh >> 3, bh & 7, s);
        fox_unit(F, bh >> 3, bh & 7, 7 - s);
    } } REPEND(4)
    PH(5) REPBEG(5) { Frame F = mkframe(); for (int p = bid; p < 2048; p += G) {
        const int g16 = p & 3, cc = (p >> 2) & 15, b = p >> 6;
        idx_unit(F, b, cc, g16);
        idx_unit(F, b, 31 - cc, g16);
    } } REPEND(5)
    GRID_BAR();
    PH(6) REPBEG(6) { Frame F = mkframe(); for (int p = bid; p < 1024; p += G) {
        int half = p & 1, cc = (p >> 1) & 15, b = p >> 5;
        if (G == 256) { const int r = bid >> 3, k2 = p >> 8; b = (bid & 7) + 8 * k2; cc = r >> 1; half = r & 1; }
        dsa_unit(F, b, cc, half);
        dsa_unit(F, b, 31 - cc, half);
    } } REPEND(6)
    GRID_BAR();
#if DSACHECK
    { Frame F = mkframe(); dsa_check(F); }
#endif
    PH(7) {
        Frame F = mkframe(); const ArgsP A = fresh_args(); unsigned char* const ws = A->ws;
        pg8::DenseSched S; S.init(ws + WS_OA, ws + WS_WA_T, M, 1024, 512, G, bid);
        EpiBranch<false> E{(bf16_t*)(ws + WS_SGA), nullptr, 1.0f};
        pg8::gemm_phase<EpiBranch<false>, pg8::DenseSched, true, true>(F.lds, 512, S, E);
    }
    PH(8) {
        Frame F = mkframe(); const ArgsP A = fresh_args(); unsigned char* const ws = A->ws;
        pg8::DenseSched S; S.init(ws + WS_OLAT, ws + WS_WOB_T, M, 1024, 512, G, bid);
        EpiBranch<true> E{(bf16_t*)(ws + WS_SGA), (const bf16_t*)(ws + WS_SGB), 1.0f / (WSC * OLSC)};
        int k8 = 512; asm volatile("" : "+s"(k8));
        pg8::gemm_phase<EpiBranch<true>, pg8::DenseSched, true, true, true>(F.lds, k8, S, E);
    }
    GRID_BAR();
    PH(9) REPBEG(9) {
        Frame F = mkframe(); const ArgsP A = fresh_args(); unsigned char* const ws = A->ws;
        pg8::DenseSched S; S.init(ws + WS_SGA, ws + WS_WOUT_T, M, 1024, 1024, G, bid);
        EpiOut E{A->in[I_X], (bf16_t*)(A->ws + WS_H1B)};
        pg8::gemm_phase<EpiOut, pg8::DenseSched, true, true>(F.lds, 1024, S, E);
    } REPEND(9)
    GRID_BAR();
#if DBG_STAGE == 2
    { Frame F = mkframe(); p_final<false>(F); }
#else
    PH(10) REPBEG(10) {
        Frame F = mkframe(); const ArgsP A = fresh_args(); unsigned char* const ws = A->ws;
        LAS float* scr = (LAS float*)(F.lds + F.wave * 16384);
        const int gw = bid * 8 + F.wave, NGW = G * 8;
        constexpr int I_GU = 16 * 32, I_D = 16 * 16;
        const float* w_gu = A->in[I_W_GU]; const float* w_dn = A->in[I_W_DOWN]; const int lane = F.lane;
        LAS float* scr2 = (LAS float*)(F.lds + F.wave * 17408);
        int ncv = (P8REP & 1) ? 2 : 1; asm volatile("" : "+s"(ncv));
        for (int rcv = 0; rcv < ncv; ++rcv)
        tr2_run(gw, NGW, 32 * (I_GU + I_D), scr2, lane, [&](int it) {
            TrItem2 t; const int e = it / (I_GU + I_D); int r = it % (I_GU + I_D);
            if (r < I_GU) { t.W = w_gu + (size_t)e * 1024 * 2048; t.WT = ws + WS_WGU_T + (size_t)e * 2048 * 1024; t.K = 1024; t.N = 2048; t.dr0 = (r % 32) * 64; t.k0 = (r / 32) * 64; t.sc0 = MapGU()(t.dr0); return t; }
            r -= I_GU; t.W = w_dn + (size_t)e * 1024 * 1024; t.WT = ws + WS_WD_T + (size_t)e * 1024 * 1024; t.K = 1024; t.N = 1024; t.dr0 = (r % 16) * 64; t.k0 = (r / 16) * 64; t.sc0 = t.dr0; return t; });
        __syncthreads();
        { int nrt = (P8REP & 2) ? 2 : 1; asm volatile("" : "+s"(nrt)); for (int rrt = 0; rrt < nrt; ++rrt) { p8_router(F); __syncthreads(); } }
    } REPEND(10)
    GRID_BAR();
    PH(11) REPBEG(11) { Frame F = mkframe(); p9_slots(F); } REPEND(11)
    GRID_BAR();
    PH(12) {
        Frame F = mkframe(); const ArgsP A = fresh_args(); unsigned char* const ws = A->ws;
        const int* GRP = (const int*)(ws + WS_GRP);
        const int ng = __builtin_amdgcn_readfirstlane(ld_agent_i(GRP));
        LAS int* te_lds = (LAS int*)(F.lds + 131072);
        { const int ntl = __builtin_amdgcn_readfirstlane(ld_agent_i(GRP + 1));
          for (int i2 = F.tid; i2 < ntl; i2 += 512) te_lds[i2] = ld_agent_i((const int*)(ws + WS_TILEE) + i2);
          __syncthreads(); }
        for (int gi = 0; gi < ng; ++gi) {
            const int t_lo = __builtin_amdgcn_readfirstlane(ld_agent_i(GRP + 4 + gi)), t_hi = __builtin_amdgcn_readfirstlane(ld_agent_i(GRP + 4 + MAXG + gi));
            {
                pg8::GroupSched<8, 1024> S; S.A = (const char*)(ws + WS_XBY); S.Bt = (const char*)(ws + WS_WGU_T);
                S.tile_e = te_lds; S.t_lo = t_lo; S.a_t0 = 0; S.nun = (t_hi - t_lo) * 8; S.G = G; S.c = bid;
                EpiGateUp E{(bf16_t*)(ws + WS_ACT), A->in[I_B_GU], t_lo};
                int nr_ = NREP(14); asm volatile("" : "+s"(nr_));
                int k8 = 512; asm volatile("" : "+s"(k8));
                for (int rp = 0; rp < nr_; ++rp) { pg8::gemm_phase<EpiGateUp, pg8::GroupSched<8, 1024>, true, true, true>(F.lds, 512, S, E); if (rp + 1 < nr_) GRID_BAR(); }
            }
            GRID_BAR();
            {
                pg8::GroupSched<4, 1024> S; S.A = (const char*)(ws + WS_ACT); S.Bt = (const char*)(ws + WS_WD_T);
                S.tile_e = te_lds; S.t_lo = t_lo; S.a_t0 = t_lo; S.nun = (t_hi - t_lo) * 4; S.G = G; S.c = bid;
                EpiDown E{(bf16_t*)(ws + WS_Y), A->in[I_B_DOWN], (const float*)(ws + WS_SLOTG)};
                int nr_ = NREP(15); asm volatile("" : "+s"(nr_));
                int k8 = 512; asm volatile("" : "+s"(k8));
                for (int rp = 0; rp < nr_; ++rp) { pg8::gemm_phase<EpiDown, pg8::GroupSched<4, 1024>, true, true, true>(F.lds, 512, S, E); if (rp + 1 < nr_) GRID_BAR(); }
            }
            GRID_BAR();
        }
    }
    PH(13) { Frame F = mkframe(); p_final<true>(F); }
#if SELCHECK || DSACHECK
    GRID_BAR();
    { const ArgsP A = fresh_args(); if (ld_agent((const unsigned*)(A->ws + WS_CTL) + CW_ERR) != 0u) { for (size_t i2 = (size_t)blockIdx.x * 512 + threadIdx.x; i2 < (size_t)M * 1024; i2 += (size_t)gridDim.x * 512) A->out[i2] = 1.0e30f; } }
#endif
#endif
#endif
}

extern "C" void kernel_launch(void* const* d_in, const int* in_sizes, int n_in, void* d_out, int out_size, void* d_ws, size_t ws_size, hipStream_t stream) {
    static int grid = 0;
    if (grid == 0) {
        if (n_in != 24 || out_size != M * DM || ws_size < WS_END) { fprintf(stderr, "kernel_launch: unexpected shapes: n_in %d out %d ws %zu\n", n_in, out_size, ws_size); grid = -1; return; }
        int dev = 0, cus = 0, per_cu = 0;
        if (hipGetDevice(&dev) != hipSuccess || hipDeviceGetAttribute(&cus, hipDeviceAttributeMultiprocessorCount, dev) != hipSuccess) { grid = -1; return; }
        if (hipFuncSetAttribute((const void*)fwd_kernel, hipFuncAttributeMaxDynamicSharedMemorySize, LDS_BYTES) != hipSuccess) { fprintf(stderr, "kernel_launch: hipFuncSetAttribute failed\n"); grid = -1; return; }
        if (hipOccupancyMaxActiveBlocksPerMultiprocessor(&per_cu, (const void*)fwd_kernel, 512, LDS_BYTES) != hipSuccess || per_cu < 1) { fprintf(stderr, "kernel_launch: occupancy query says %d\n", per_cu); }
        (void)hipGetLastError();
        grid = cus;
    }
    if (grid < 0) return;
    (void)hipMemsetAsync((char*)d_ws + WS_CTL, 0, CTL_ZERO_BYTES, stream);
    Args a{};
    for (int i = 0; i < 24; ++i) a.in[i] = (const float*)d_in[i];
    a.out = (float*)d_out; a.ws = (unsigned char*)d_ws; a.ph_lo = 0; a.ph_hi = 0;
    hipLaunchKernelGGL(fwd_kernel, dim3(grid), dim3(512), LDS_BYTES, stream, a);
}
```

```cpp
#include <hip/hip_runtime.h>
#include <cstdio>
#include <cstdint>

#ifndef PHM
#define PHM 0xFFFFF
#endif
#define PH(k) if ((PHM >> (k)) & 1)
#ifndef REPM
#define REPM 0
#endif
#ifndef IDXREP
#define IDXREP 0
#endif
#ifndef SELHIST
#define SELP0 1
#define SELHIST 1
#endif
#ifndef P8REP
#define P8REP 0
#endif
#ifndef DSABL
#define DSABL 0
#endif
#ifndef DSACHECK
#define DSACHECK 0
#endif
#ifndef SELCHECK
#define SELCHECK 0
#endif
#define NREP(k) (((REPM >> (k)) & 1) ? 2 : 1)
#if REPM
#define REPBEG(k) { int nrep_ = NREP(k); asm volatile("" : "+s"(nrep_)); _Pragma("unroll 1") for (int rep_ = 0; rep_ < nrep_; ++rep_) {
#define REPEND(k) if (rep_ + 1 < nrep_) GRID_BAR(); } }
#else
#define REPBEG(k) {
#define REPEND(k) }
#endif
#ifndef DBG_STAGE
#define DBG_STAGE 3
#endif

#define GAS __attribute__((address_space(1)))
#define LAS __attribute__((address_space(3)))
typedef unsigned short bf16_t;
typedef short bf16x8 __attribute__((ext_vector_type(8)));
typedef short s16x4 __attribute__((ext_vector_type(4)));
typedef float f32x4 __attribute__((ext_vector_type(4)));
typedef float f32x2 __attribute__((ext_vector_type(2)));
typedef float f32x16 __attribute__((ext_vector_type(16)));
typedef unsigned u32x4 __attribute__((ext_vector_type(4)));
typedef unsigned u32x2 __attribute__((ext_vector_type(2)));
typedef __bf16 bf16x2_t __attribute__((ext_vector_type(2)));
typedef unsigned long long u64;

constexpr int NB = 32, SEQ = 2048, DM = 1024, NMETA = 16;
constexpr int M = NB * SEQ;
constexpr int TPB = 2112;
constexpr int NKT = 33;
constexpr int D_IN = 4076;
constexpr int NEXP = 32;
constexpr float EPS = 1e-6f;
constexpr float LOG2E = 1.4426950408889634f;
constexpr float FOX_C = 0.125f * LOG2E;
constexpr float DSA_C = 0.10206207261596575f * LOG2E;
constexpr float NEGBIG = -1.0e30f;

constexpr size_t MiB = 1u << 20;
constexpr size_t WS_CTL = 0, CTL_ZERO_BYTES = 1 * MiB;
constexpr size_t WS_TOPE = 1 * MiB, WS_TOPG = 2 * MiB, WS_LR = 3 * MiB, WS_TOKSLOT = 4 * MiB, WS_SLOTG = 5 * MiB;
constexpr size_t WS_BC = 6 * MiB + 512 * 1024, WS_TILEE = 6 * MiB + 768 * 1024, WS_GRP = 7 * MiB;
constexpr size_t WS_WIN_T = 16 * MiB, WS_WQ2_T = 24 * MiB, WS_WA_T = 25 * MiB, WS_WOB_T = 26 * MiB, WS_WOUT_T = 28 * MiB;
constexpr size_t WS_COS = 30 * MiB, WS_SIN = 30 * MiB + 256 * 1024, WS_PROJM = 30 * MiB + 512 * 1024, WS_RSTDQ = 30 * MiB + 768 * 1024;
constexpr size_t WS_IW = 31 * MiB, WS_BIAS = 32 * MiB, WS_MASKW = 35 * MiB;
constexpr size_t WS_OA = 408 * MiB;
constexpr size_t WS_XN = 52 * MiB, WS_OLAT = 52 * MiB, WS_QA = 180 * MiB, WS_KA = 244 * MiB, WS_VA = 310 * MiB, WS_CQ = 376 * MiB, WS_T7 = 408 * MiB;
constexpr size_t WS_XN8 = 950 * MiB, WS_WIN8 = 1014 * MiB;
constexpr size_t WS_VT8 = 888 * MiB;
constexpr size_t WS_SGA = 472 * MiB, WS_SGB = 600 * MiB, WS_KVR = 728 * MiB, WS_KIDX = 749 * MiB, WS_QIDX = 758 * MiB, WS_QL = 790 * MiB;
constexpr size_t WS_WGU_T = 16 * MiB, WS_WD_T = 80 * MiB, WS_XBY = 112 * MiB, WS_Y = WS_XBY  , WS_H1B = 600 * MiB  , WS_ACT = 728 * MiB, WS_END = 1024 * MiB;
constexpr float WSC = 32.0f, WSC_INV = 1.0f / 32.0f;
constexpr float QSC = 16.0f;
constexpr float PSC = 128.0f;
constexpr float OLSC = 16.0f;
constexpr int MAX_TILES = 1064;
constexpr int ACT_CAP_TILES = (int)((WS_END - WS_ACT) / (256 * 1024));
constexpr int MAXG = 8;
static_assert(WS_XBY + (size_t)MAX_TILES * 256 * 1024 <= WS_H1B && WS_H1B + (size_t)M * 2048 <= WS_ACT && WS_ACT + (size_t)MAX_TILES * 256 * 1024 <= WS_END && ACT_CAP_TILES >= MAX_TILES, "XBY/H1B/ACT");
static_assert(WS_MASKW + (size_t)M * NKT * 8 <= WS_XN, "maskw");
static_assert(WS_QL + (size_t)M * 1536 <= WS_VT8 && WS_VT8 + (size_t)NB * NKT * 128 * 64 <= WS_XN8 && WS_KVR + (size_t)NB * TPB * 192 <= WS_KIDX, "ql8 / vt8 / k8");

constexpr int CW_BAR = 4096;
constexpr int CW_KMAX = 1024;
constexpr int CW_ERR = 64;

constexpr int LDS_BYTES = 147456;
constexpr int MISC_OFF = LDS_BYTES - 512;

__device__ __forceinline__ unsigned pk2(float lo, float hi) { f32x2 v = {lo, hi}; bf16x2_t b = __builtin_convertvector(v, bf16x2_t); return __builtin_bit_cast(unsigned, b); }
__device__ __forceinline__ unsigned pk4_fp8(float a, float b, float c, float d) { int w = __builtin_amdgcn_cvt_pk_fp8_f32(a, b, 0, false); w = __builtin_amdgcn_cvt_pk_fp8_f32(c, d, w, true); return (unsigned)w; }
__device__ __forceinline__ float bf2f(unsigned short x) { return __uint_as_float((unsigned)x << 16); }
__device__ __forceinline__ float bflo(unsigned w) { return __uint_as_float(w << 16); }
__device__ __forceinline__ float bfhi(unsigned w) { return __uint_as_float(w & 0xffff0000u); }
__device__ __forceinline__ f32x4 ld4bf(const bf16_t* p) { const u32x2 w = *(const u32x2*)p; return (f32x4){bflo(w.x), bfhi(w.x), bflo(w.y), bfhi(w.y)}; }
template <int CTRL, int RM> __device__ __forceinline__ float dpp_addf(float v) { return v + __int_as_float(__builtin_amdgcn_update_dpp(0, __float_as_int(v), CTRL, RM, 0xf, false)); }
__device__ __forceinline__ float wave_sum(float v) {
    v = dpp_addf<0x111, 0xf>(v); v = dpp_addf<0x112, 0xf>(v); v = dpp_addf<0x114, 0xf>(v); v = dpp_addf<0x118, 0xf>(v);
    v = dpp_addf<0x142, 0xa>(v); v = dpp_addf<0x143, 0xc>(v);
    return __int_as_float(__builtin_amdgcn_readlane(__float_as_int(v), 63));
}
__device__ __forceinline__ float wave_max(float v) {
#pragma unroll
    for (int o = 1; o < 64; o <<= 1) v = fmaxf(v, __shfl_xor(v, o));
    return v;
}
__device__ __forceinline__ float fast_exp2(float x) { return __builtin_amdgcn_exp2f(x); }
__device__ __forceinline__ float fast_rcp(float x) { return __builtin_amdgcn_rcpf(x); }
__device__ __forceinline__ float sigmoidf_(float x) { return fast_rcp(1.0f + fast_exp2(-x * LOG2E)); }
__device__ __forceinline__ int crow(int r, int hi) { return (r & 3) + 8 * (r >> 2) + 4 * hi; }
__device__ __forceinline__ unsigned ld_agent(const unsigned* p) { return __hip_atomic_load(p, __ATOMIC_RELAXED, __HIP_MEMORY_SCOPE_AGENT); }
__device__ __forceinline__ int ld_agent_i(const int* p) { return (int)__hip_atomic_load((const unsigned*)p, __ATOMIC_RELAXED, __HIP_MEMORY_SCOPE_AGENT); }
#define LDS_WAIT() asm volatile("s_waitcnt lgkmcnt(0)" ::: "memory")

#define XB_TMO      128
#define XB_XCNT(j)  (256  + 64 * (j))
#define XB_XSUB(j)  (1280 + 64 * (j))
#define XB_XGEN(j)  (2304 + 64 * (j))
#define XB_TOP      3328
#define XB_TOPGEN   3392
#define XCD_BAR_WORDS 3456
#define XB_SPIN_CAP (1u << 24)
__device__ __forceinline__ unsigned xb_ld(unsigned* p)              { return __hip_atomic_load(p, __ATOMIC_RELAXED, __HIP_MEMORY_SCOPE_AGENT); }
__device__ __forceinline__ unsigned xb_add(unsigned* p, unsigned v) { return __hip_atomic_fetch_add(p, v, __ATOMIC_RELAXED, __HIP_MEMORY_SCOPE_AGENT); }
__device__ __forceinline__ unsigned xb_xcc_id() { return (unsigned)__builtin_amdgcn_s_getreg((3 << 11) | 20) & 0xFu; }
#define XB_SPIN(cond, bar) do { unsigned _sp = 0; while (cond) { __builtin_amdgcn_s_sleep(1); \
    if ((++_sp & 255u) == 0u) { if (xb_ld(&(bar)[XB_TMO])) break; if (_sp > XB_SPIN_CAP) { atomicAdd(&(bar)[XB_TMO], 1u); break; } } } } while (0)
struct XcdBarrier { unsigned* bar; unsigned x; volatile LAS unsigned* st; };
__device__ __forceinline__ XcdBarrier xcd_barrier_post(unsigned* bar, volatile LAS unsigned* st) {
    XcdBarrier b; b.bar = bar; b.x = xb_xcc_id(); b.st = st;
    if (threadIdx.x == 0) (void)xb_add(&bar[XB_XCNT(b.x)], 1u);
    return b;
}
__device__ __forceinline__ void xcd_barrier_complete(unsigned* bar, unsigned x, unsigned& nloc, unsigned& nx) {
    const unsigned G = gridDim.x * gridDim.y * gridDim.z;
    unsigned sum, cnt, mine, sp = 0u;
    for (;;) {
        sum = 0u; cnt = 0u; mine = 0u;
#pragma unroll 1
        for (unsigned j = 0; j < 16; ++j) { const unsigned c = xb_ld(&bar[XB_XCNT(j)]); sum += c; cnt += (c > 0u) ? 1u : 0u; mine = (j == x) ? c : mine; }
        if (sum == G) break;
        __builtin_amdgcn_s_sleep(1);
        if ((++sp & 255u) == 0u) { if (xb_ld(&bar[XB_TMO])) break; if (sp > XB_SPIN_CAP) { atomicAdd(&bar[XB_TMO], 1u); break; } }
    }
    nloc = mine > 0u ? mine : 1u; nx = cnt > 0u ? cnt : 1u;
}
__device__ __forceinline__ void xcd_barrier(const XcdBarrier& b) {
    asm volatile("s_waitcnt vmcnt(0)" ::: "memory");
    __syncthreads();
    if (threadIdx.x == 0) {
        unsigned* bar = b.bar;
        __builtin_amdgcn_s_waitcnt(0);
        unsigned nloc = b.st[0], nx = b.st[1];
        if (nloc == 0u) { xcd_barrier_complete(bar, b.x, nloc, nx); b.st[0] = nloc; b.st[1] = nx; }
        const unsigned old = xb_add(&bar[XB_XSUB(b.x)], 1u);
        const unsigned gen = old / nloc;
        if (old + 1u == (gen + 1u) * nloc) {
            __builtin_amdgcn_fence(__ATOMIC_RELEASE, "agent");
            asm volatile("s_waitcnt vmcnt(0)" ::: "memory");
            const unsigned og = xb_add(&bar[XB_TOP], 1u);
            const unsigned tg = og / nx;
            if (og + 1u == (tg + 1u) * nx) xb_add(&bar[XB_TOPGEN], 1u);
            else XB_SPIN(xb_ld(&bar[XB_TOPGEN]) == tg, bar);
            __builtin_amdgcn_fence(__ATOMIC_ACQUIRE, "agent");
            xb_add(&bar[XB_XGEN(b.x)], 1u);
            asm volatile("s_waitcnt vmcnt(0)" ::: "memory");
        } else {
            XB_SPIN(xb_ld(&bar[XB_XGEN(b.x)]) == gen, bar);
            __builtin_amdgcn_fence(__ATOMIC_ACQUIRE, "agent");
            asm volatile("s_waitcnt vmcnt(0)" ::: "memory");
        }
    }
    __syncthreads();
}

__device__ __forceinline__ int tid_fresh() { int t = threadIdx.x; asm volatile("" : "+v"(t)); return t; }
namespace pg8 {
constexpr int BM = 256, BK = 64, HALF = 128, HTB = HALF * BK * 2, STAGE_BYTES = 8 * HTB, NXCD = 8, WGM = 8;
__host__ __device__ __forceinline__ int lds_byte(int r, int c) { const int st = (r >> 4) * 2 + (c >> 5), rr = r & 15, cc = c & 31, ob = rr * 64 + cc * 2; return st * 1024 + (ob ^ (((ob >> 9) & 1) << 5)); }
__host__ __device__ __forceinline__ void stage_rc(int b, int& R, int& C) { const int st = b / 1024, sb = b % 1024, swz = sb ^ (((sb >> 9) & 1) << 5); R = (st >> 1) * 16 + swz / 64; C = (st & 1) * 32 + (swz % 64) / 2; }
__host__ __device__ __forceinline__ int perm32(int rho) { const int n = rho >> 4, i = rho & 15; return 8 * (i >> 2) + 4 * n + (i & 3); }
struct Unit { int pm, pn, aux; };

struct DenseSched {
    const char* A; const char* Bt; size_t tstep; int nM, nN, nwg, G, c;
    __device__ __forceinline__ void init(const void* A_, const void* Bt_, int Mrows, int N, int K, int G_, int c_) { A = (const char*)A_; Bt = (const char*)Bt_; tstep = (size_t)BM * K * 2; nM = Mrows / BM; nN = N / BM; nwg = nM * nN; G = G_; c = c_; }
    __device__ __forceinline__ bool next(int i, Unit& u) const {
        const long L = (long)i * G + c; if (L >= nwg) return false;
        int wgid = (int)L; { const int q = nwg / NXCD, r = nwg % NXCD, xcd = wgid % NXCD, off = wgid / NXCD; wgid = (xcd < r ? xcd * (q + 1) : r * (q + 1) + (xcd - r) * q) + off; }
        const int nig = WGM * nN, gid = wgid / nig, fm = gid * WGM, gsz = (nM - fm) < WGM ? (nM - fm) : WGM;
        u.pm = fm + ((wgid % nig) % gsz); u.pn = (wgid % nig) / gsz; u.aux = 0; return true;
    }
    __device__ __forceinline__ const char* a_ptr(const Unit& u) const { return A + (size_t)u.pm * tstep; }
    __device__ __forceinline__ const char* b_ptr(const Unit& u) const { return Bt + (size_t)u.pn * tstep; }
};
template <int nN, int ROWB> struct GroupSched {
    static constexpr size_t tstep = (size_t)256 * ROWB, estride = (size_t)nN * tstep;
    const char* A; const char* Bt; const LAS int* tile_e; int t_lo, a_t0, nun, G, c;
    __device__ __forceinline__ bool next(int i, Unit& u) const {
        int t, pn;
        if ((G & 7) == 0) {
            const int x = c & 7, r = c >> 3, W = G >> 3;
            const int q = i * W + r; t = x + 8 * (q / nN); pn = q % nN;
            if (t * nN >= nun) return false;
        } else {
            const long L = (long)i * G + c; if (L >= nun) return false;
            t = (int)(L / nN); pn = (int)(L % nN);
        }
        u.pm = t_lo + t; u.pn = pn;
        u.aux = __builtin_amdgcn_readfirstlane(tile_e[u.pm]); return true;
    }
    __device__ __forceinline__ const char* a_ptr(const Unit& u) const { return A + (size_t)(u.pm - a_t0) * tstep; }
    __device__ __forceinline__ const char* b_ptr(const Unit& u) const { return Bt + (size_t)u.aux * estride + (size_t)u.pn * tstep; }
};

typedef int v8i_t __attribute__((ext_vector_type(8)));
typedef int v4i_t __attribute__((ext_vector_type(4)));
template <class Epi, class Sched, bool ALIGN_EPI, bool SP2, bool FP8 = false>
__device__ __forceinline__ void gemm_phase(LAS unsigned char* lds, const int K, const Sched& S, const Epi& E) {
    const int tid = tid_fresh(), wid = __builtin_amdgcn_readfirstlane(tid >> 6), lane = tid & 63, wr = wid >> 2, wc = wid & 3, fr = lane & 15, fq = lane >> 4;
    const int nt = K / BK;
    unsigned voffA[2], voffB[2];
#pragma unroll
    for (int i = 0; i < 2; ++i) { int R, C; stage_rc(tid * 16 + i * 8192, R, C); const int Rb = Epi::PERM ? ((R & ~31) + perm32(R & 31)) : R;
        voffA[i] = (unsigned)(R * K + C) * 2u; voffB[i] = (unsigned)(Rb * K + C) * 2u; }
    const size_t kstep = (size_t)(BK * 2);
    const size_t hstep = (size_t)HALF * K * 2;
    const unsigned ldsw = (unsigned)wid * 1024u;
    const int aoff = lds_byte(wr * 64 + fr, fq * 8), boff = lds_byte(wc * 32 + fr, fq * 8);
#define PG8_SA(b, h) (((b) * 2 + (h)) * HTB)
#define PG8_SB(b, h) ((4 + (b) * 2 + (h)) * HTB)
#define PG8_STAGE(bufoff, gbase, voff) do { _Pragma("unroll") for (int _i = 0; _i < 2; ++_i) \
        __builtin_amdgcn_global_load_lds((const unsigned*)((const char*)(gbase) + (voff)[_i]), (LAS unsigned*)(lds + (bufoff) + ldsw + _i * 8192), 16, 0, 0); } while (0)
#define PG8_LD8(p) __builtin_shufflevector(*(const LAS v4i_t*)(p), *(const LAS v4i_t*)((p) + 1024), 0, 1, 2, 3, 4, 5, 6, 7)
#define PG8_LDA(dst, b, h) do { if constexpr (FP8) { _Pragma("unroll") for (int m = 0; m < 4; ++m) dst##8[m] = PG8_LD8(lds + PG8_SA(b, h) + aoff + m * 2048); } \
        else { _Pragma("unroll") for (int m = 0; m < 4; ++m) _Pragma("unroll") for (int k = 0; k < 2; ++k) dst[m][k] = *(const LAS bf16x8*)(lds + PG8_SA(b, h) + aoff + m * 2048 + k * 1024); } } while (0)
#define PG8_LDB(dst, b, h) do { if constexpr (FP8) { _Pragma("unroll") for (int n = 0; n < 2; ++n) dst##8[n] = PG8_LD8(lds + PG8_SB(b, h) + boff + n * 2048); } \
        else { _Pragma("unroll") for (int n = 0; n < 2; ++n) _Pragma("unroll") for (int k = 0; k < 2; ++k) dst[n][k] = *(const LAS bf16x8*)(lds + PG8_SB(b, h) + boff + n * 2048 + k * 1024); } } while (0)
#define PG8_CAT(x) __builtin_shufflevector(__builtin_bit_cast(v4i_t, (x)[0]), __builtin_bit_cast(v4i_t, (x)[1]), 0, 1, 2, 3, 4, 5, 6, 7)
#define PG8_MMA(ai, bj, At, Bt) do { __builtin_amdgcn_s_setprio(1); \
        if constexpr (FP8) { _Pragma("unroll") for (int m = 0; m < 4; ++m) _Pragma("unroll") for (int n = 0; n < 2; ++n) \
            asm volatile("v_mfma_scale_f32_16x16x128_f8f6f4 %0, %1, %2, %0, %3, %3 op_sel_hi:[0,0,0]" : "+v"(acc[ai][bj][m][n]) : "v"(Bt##8[n]), "v"(At##8[m]), "v"(sc1)); } \
        else { _Pragma("unroll") for (int m = 0; m < 4; ++m) _Pragma("unroll") for (int n = 0; n < 2; ++n) _Pragma("unroll") for (int k = 0; k < 2; ++k) \
            acc[ai][bj][m][n] = __builtin_amdgcn_mfma_f32_16x16x32_bf16(Bt[n][k], At[m][k], acc[ai][bj][m][n], 0, 0, 0); } \
        __builtin_amdgcn_s_setprio(0); } while (0)
#define PG8_WAIT_V(n) asm volatile("s_waitcnt vmcnt(" #n ")" ::: "memory")
#define PG8_WAIT_L(n) asm volatile("s_waitcnt lgkmcnt(" #n ")" ::: "memory")
#define PG8_BAR __builtin_amdgcn_s_barrier()
#define PG8_SCHED __builtin_amdgcn_sched_barrier(0)
    Unit cur, nxt; int ui = 0;
    if (!S.next(0, cur)) return;
    typename Epi::Pre pre;
    f32x4 acc[2][2][4][2];
#pragma unroll
    for (int a = 0; a < 2; ++a)
#pragma unroll
        for (int b = 0; b < 2; ++b)
#pragma unroll
            for (int m = 0; m < 4; ++m)
#pragma unroll
                for (int n = 0; n < 2; ++n) acc[a][b][m][n] = (f32x4){0.f, 0.f, 0.f, 0.f};
    bf16x8 At[4][2], B0[2][2], B1[2][2]; v8i_t At8[4], B08[2], B18[2];
    int sc1 = 0x7f7f7f7f; asm volatile("" : "+v"(sc1));
    const char* cA = S.a_ptr(cur); const char* cB = S.b_ptr(cur);
    if constexpr (SP2) {
        PG8_STAGE(PG8_SB(0, 0), cB, voffB); PG8_STAGE(PG8_SB(0, 1), cB + hstep, voffB); PG8_STAGE(PG8_SA(0, 0), cA, voffA); PG8_STAGE(PG8_SA(0, 1), cA + hstep, voffA);
        if (wr == 1) PG8_BAR;
        PG8_WAIT_V(2); PG8_BAR;
        PG8_STAGE(PG8_SB(1, 0), cB + kstep, voffB); PG8_STAGE(PG8_SA(1, 0), cA + kstep, voffA); PG8_STAGE(PG8_SB(1, 1), cB + hstep + kstep, voffB);
        PG8_WAIT_V(6); PG8_BAR;
    } else {
        PG8_STAGE(PG8_SB(0, 0), cB, voffB); PG8_STAGE(PG8_SA(0, 0), cA, voffA); PG8_STAGE(PG8_SB(0, 1), cB + hstep, voffB); PG8_STAGE(PG8_SA(0, 1), cA + hstep, voffA);
        if (wr == 1) PG8_BAR;
        PG8_WAIT_V(4); PG8_BAR;
        PG8_STAGE(PG8_SB(1, 0), cB + kstep, voffB); PG8_STAGE(PG8_SA(1, 0), cA + kstep, voffA); PG8_STAGE(PG8_SB(1, 1), cB + hstep + kstep, voffB);
        PG8_WAIT_V(6); PG8_BAR;
    }
    for (;;) {
        const bool has_next = S.next(ui + 1, nxt);
        const char* nA = has_next ? S.a_ptr(nxt) : cA; const char* nB = has_next ? S.b_ptr(nxt) : cB;
#pragma unroll 1
        for (int t = 0; t < nt; t += 2) {
            const bool last = (t == nt - 2);
            if (last) E.preload(cur, wr, wc, fr, fq, pre);
            const char* a1 = cA + (size_t)(t + 1) * kstep;
            const char* a2 = last ? nA : cA + (size_t)(t + 2) * kstep; const char* b2 = last ? nB : cB + (size_t)(t + 2) * kstep;
            const char* a3 = a2 + kstep; const char* b3 = b2 + kstep;
            if constexpr (SP2) {
            PG8_LDB(B0, 0, 0); PG8_LDB(B1, 0, 1); PG8_SCHED; PG8_LDA(At, 0, 0); PG8_STAGE(PG8_SA(1, 1), a1 + hstep, voffA);
            PG8_WAIT_V(8); PG8_WAIT_L(0); PG8_BAR; PG8_MMA(0, 0, At, B0); PG8_MMA(0, 1, At, B1); PG8_BAR; PG8_SCHED;
            PG8_LDA(At, 0, 1); PG8_STAGE(PG8_SB(0, 0), b2, voffB); PG8_STAGE(PG8_SB(0, 1), b2 + hstep, voffB); PG8_STAGE(PG8_SA(0, 0), a2, voffA);
            PG8_WAIT_V(8); PG8_WAIT_L(0); PG8_BAR; PG8_MMA(1, 0, At, B0); PG8_MMA(1, 1, At, B1); PG8_BAR; PG8_SCHED;
            PG8_LDB(B0, 1, 0); PG8_LDB(B1, 1, 1); PG8_SCHED; PG8_LDA(At, 1, 0); PG8_STAGE(PG8_SA(0, 1), a2 + hstep, voffA);
            PG8_WAIT_V(8); PG8_WAIT_L(0); PG8_BAR; PG8_MMA(0, 0, At, B0); PG8_MMA(0, 1, At, B1); PG8_BAR; PG8_SCHED;
            PG8_LDA(At, 1, 1); PG8_STAGE(PG8_SB(1, 0), b3, voffB); PG8_STAGE(PG8_SB(1, 1), b3 + hstep, voffB); PG8_STAGE(PG8_SA(1, 0), a3, voffA);
            PG8_WAIT_V(8); PG8_WAIT_L(0); PG8_BAR; PG8_MMA(1, 0, At, B0); PG8_MMA(1, 1, At, B1); PG8_BAR; PG8_SCHED;
            } else {
            PG8_LDB(B0, 0, 0); PG8_SCHED; PG8_LDA(At, 0, 0); PG8_STAGE(PG8_SA(1, 1), a1 + hstep, voffA);
            PG8_WAIT_L(8); PG8_BAR; PG8_WAIT_L(0); PG8_MMA(0, 0, At, B0); PG8_BAR; PG8_SCHED;
            PG8_LDB(B1, 0, 1); PG8_STAGE(PG8_SB(0, 0), b2, voffB);
            PG8_BAR; PG8_WAIT_L(0); PG8_MMA(0, 1, At, B1); PG8_BAR;
            PG8_LDA(At, 0, 1); PG8_STAGE(PG8_SA(0, 0), a2, voffA);
            PG8_BAR; PG8_WAIT_L(0); PG8_MMA(1, 0, At, B0); PG8_BAR; PG8_SCHED;
            PG8_STAGE(PG8_SB(0, 1), b2 + hstep, voffB);
            PG8_WAIT_V(6); PG8_BAR; PG8_MMA(1, 1, At, B1); PG8_BAR;
            PG8_LDB(B0, 1, 0); PG8_SCHED; PG8_LDA(At, 1, 0); PG8_STAGE(PG8_SA(0, 1), a2 + hstep, voffA);
            PG8_WAIT_L(8); PG8_BAR; PG8_WAIT_L(0); PG8_MMA(0, 0, At, B0); PG8_BAR; PG8_SCHED;
            PG8_LDB(B1, 1, 1); PG8_STAGE(PG8_SB(1, 0), b3, voffB);
            PG8_BAR; PG8_WAIT_L(0); PG8_MMA(0, 1, At, B1); PG8_BAR;
            PG8_LDA(At, 1, 1); PG8_STAGE(PG8_SA(1, 0), a3, voffA);
            PG8_BAR; PG8_WAIT_L(0); PG8_MMA(1, 0, At, B0); PG8_BAR; PG8_SCHED;
            PG8_STAGE(PG8_SB(1, 1), b3 + hstep, voffB);
            PG8_WAIT_V(6); PG8_BAR; PG8_MMA(1, 1, At, B1); PG8_BAR;
            }
        }
        if constexpr (ALIGN_EPI) { if (wr == 0) PG8_BAR; }
        if constexpr (FP8) asm volatile("s_nop 15\n\ts_nop 7" ::: "memory");
        E(acc, cur, wr, wc, fr, fq, pre);
        if (!has_next) break;
#pragma unroll
        for (int a = 0; a < 2; ++a)
#pragma unroll
            for (int b = 0; b < 2; ++b)
#pragma unroll
                for (int m = 0; m < 4; ++m)
#pragma unroll
                    for (int n = 0; n < 2; ++n) acc[a][b][m][n] = (f32x4){0.f, 0.f, 0.f, 0.f};
        cur = nxt; cA = nA; cB = nB; ++ui;
        if constexpr (ALIGN_EPI) { if (wr == 1) PG8_BAR; }
    }
    PG8_WAIT_V(0);
    if constexpr (!ALIGN_EPI) { if (wr == 0) PG8_BAR; }
    PG8_BAR;
#undef PG8_SA
#undef PG8_SB
#undef PG8_STAGE
#undef PG8_LDA
#undef PG8_LD8
#undef PG8_LDB
#undef PG8_MMA
#undef PG8_CAT
#undef PG8_WAIT_V
#undef PG8_WAIT_L
#undef PG8_BAR
#undef PG8_SCHED
}
}
using pg8::Unit; using pg8::v8i_t; using pg8::v4i_t;

typedef f32x4 AccT[2][2][4][2];
struct EpiProj {
    static constexpr bool PERM = true;
    struct Pre {}; __device__ __forceinline__ void preload(const Unit&, int, int, int, int, Pre&) const {}
    bf16_t *QA, *KA, *VA, *CQ, *SGA, *SGB; float* T7;
    __device__ __forceinline__ void operator()(const AccT& acc, const Unit& u, int wr, int wc, int fr, int fq, const Pre& P) const {
        const int pn = u.pn;
        const int row0 = u.pm * 256 + wr * 64 + fr;
        const int colw = wc * 32 + 8 * fq;
#pragma unroll
        for (int ai = 0; ai < 2; ++ai)
#pragma unroll
            for (int m = 0; m < 4; ++m) {
                const int row = row0 + ai * 128 + m * 16;
                const int b = row >> 11, i = row & 2047;
                const size_t krow = (size_t)b * TPB + NMETA + i;
#pragma unroll
                for (int bj = 0; bj < 2; ++bj) {
                    const f32x4 v0 = acc[ai][bj][m][0], v1 = acc[ai][bj][m][1];
                    const int ct = bj * 128 + colw;
                    if (pn == 7) {
                        float* d = T7 + (size_t)row * 256 + ct; *(f32x4*)d = v0; *(f32x4*)(d + 4) = v1;
                    } else {
                        f32x4 a = v0, c = v1; bf16_t* d;
                        if (pn < 2)       { a = a * FOX_C; c = c * FOX_C; d = QA + (size_t)row * 512 + pn * 256 + ct; }
                        else if (pn < 4)  { d = KA + krow * 512 + (pn - 2) * 256 + ct; }
                        else if (pn < 6)  { d = VA + krow * 512 + (pn - 4) * 256 + ct; }
                        else if (pn == 6) { d = CQ + (size_t)row * 256 + ct; }
                        else {
                            a = (f32x4){sigmoidf_(a[0]), sigmoidf_(a[1]), sigmoidf_(a[2]), sigmoidf_(a[3])};
                            c = (f32x4){sigmoidf_(c[0]), sigmoidf_(c[1]), sigmoidf_(c[2]), sigmoidf_(c[3])};
                            d = (pn < 12) ? SGA + (size_t)row * 1024 + (pn - 8) * 256 + ct : SGB + (size_t)row * 1024 + (pn - 12) * 256 + ct;
                        }
                        u32x4 w; w.x = pk2(a[0], a[1]); w.y = pk2(a[2], a[3]); w.z = pk2(c[0], c[1]); w.w = pk2(c[2], c[3]);
                        *(u32x4*)d = w;
                    }
                }
            }
    }
};
struct EpiGate {
    static constexpr bool PERM = true;
    struct Pre {}; __device__ __forceinline__ void preload(const Unit&, int, int, int, int, Pre&) const {}
    bf16_t *SGA, *SGB;
    __device__ __forceinline__ void operator()(const AccT& acc, const Unit& u, int wr, int wc, int fr, int fq, const Pre& P) const {
        const int pn = u.pn;
        const int row0 = u.pm * 256 + wr * 64 + fr, col0 = (pn & 3) * 256 + wc * 32 + 8 * fq;
        bf16_t* base = (pn < 4) ? SGA : SGB;
#pragma unroll
        for (int ai = 0; ai < 2; ++ai)
#pragma unroll
            for (int m = 0; m < 4; ++m)
#pragma unroll
                for (int bj = 0; bj < 2; ++bj) {
                    const f32x4 a = acc[ai][bj][m][0] * WSC_INV, c = acc[ai][bj][m][1] * WSC_INV;
                    u32x4 w; w.x = pk2(sigmoidf_(a[0]), sigmoidf_(a[1])); w.y = pk2(sigmoidf_(a[2]), sigmoidf_(a[3])); w.z = pk2(sigmoidf_(c[0]), sigmoidf_(c[1])); w.w = pk2(sigmoidf_(c[2]), sigmoidf_(c[3]));
                    *(u32x4*)(base + (size_t)(row0 + ai * 128 + m * 16) * 1024 + col0 + bj * 128) = w;
                }
    }
};
struct EpiQ {
    static constexpr bool PERM = false;
    struct Pre {}; __device__ __forceinline__ void preload(const Unit&, int, int, int, int, Pre&) const {}
    bf16_t *QL, *QIDX; const float *RSTD, *COS, *SIN;
    __device__ __forceinline__ void operator()(const AccT& acc, const Unit& u, int wr, int wc, int fr, int fq, const Pre& P) const {
        const int pn = u.pn;
        const unsigned row0 = (unsigned)(u.pm * 256 + wr * 64 + fr);
        float rsv[8];
#pragma unroll
        for (int q = 0; q < 8; ++q) rsv[q] = RSTD[row0 + (q >> 2) * 128 + (q & 3) * 16];
        if (pn < 4) {
            unsigned char* base = (unsigned char*)QL;
#pragma unroll
            for (int ai = 0; ai < 2; ++ai)
#pragma unroll
                for (int m = 0; m < 4; ++m) {
                    const unsigned row = row0 + ai * 128 + m * 16;
                    const float rs = rsv[ai * 4 + m] * (DSA_C * QSC);
#pragma unroll
                    for (int bj = 0; bj < 2; ++bj) {
                        const f32x4 x1 = acc[ai][bj][m][0] * rs, x2 = acc[ai][bj][m][1] * rs;
                        const int cc = pn * 256 + (bj * 4 + wc) * 32;
                        const unsigned off = row * 1536u + (unsigned)((cc >> 7) * 192 + (cc & 127) + 4 * fq);
                        *(unsigned*)(base + off) = pk4_fp8(x1[0], x1[1], x1[2], x1[3]); *(unsigned*)(base + off + 16) = pk4_fp8(x2[0], x2[1], x2[2], x2[3]);
                    }
                    asm volatile("" ::: "memory");
                }
        } else {
            unsigned char* base = (pn == 4) ? (unsigned char*)QL : (unsigned char*)QIDX;
            const float sc = (pn == 4) ? DSA_C * QSC : 1.0f;
#pragma unroll
            for (int ai = 0; ai < 2; ++ai)
#pragma unroll
                for (int m = 0; m < 4; ++m) {
                    const unsigned row = row0 + ai * 128 + m * 16;
                    const float rs = rsv[ai * 4 + m] * sc;
                    const unsigned pos = NMETA + (row & 2047u);
                    const f32x4 cs = *(const f32x4*)(COS + pos * 16 + 4 * fq), sn = *(const f32x4*)(SIN + pos * 16 + 4 * fq);
#pragma unroll
                    for (int bj = 0; bj < 2; ++bj) {
                        const f32x4 x1 = acc[ai][bj][m][0] * rs, x2 = acc[ai][bj][m][1] * rs;
                        const int g = bj * 4 + wc;
                        const bool rope = (pn == 4) || ((g & 1) == 0);
                        const f32x4 o1 = rope ? (x1 * cs - x2 * sn) : x1, o2 = rope ? (x1 * sn + x2 * cs) : x2;
                        if (pn == 4) {
                            const unsigned off = row * 1536u + (unsigned)(g * 192 + 128 + 4 * fq);
                            *(unsigned*)(base + off) = pk4_fp8(o1[0], o1[1], o1[2], o1[3]); *(unsigned*)(base + off + 16) = pk4_fp8(o2[0], o2[1], o2[2], o2[3]);
                            *(unsigned*)(base + off + 32) = 0u; *(unsigned*)(base + off + 48) = 0u;
                        } else {
                            const unsigned off = (row * 256u + (unsigned)(g * 32 + 4 * fq)) * 2u;
                            u32x2 w0 = {pk2(o1[0], o1[1]), pk2(o1[2], o1[3])}, w1 = {pk2(o2[0], o2[1]), pk2(o2[2], o2[3])};
                            *(u32x2*)(base + off) = w0; *(u32x2*)(base + off + 32) = w1;
                        }
                    }
                    asm volatile("" ::: "memory");
                }
        }
    }
};
template <bool SECOND> struct EpiBranch {
    static constexpr bool PERM = true;
    struct Pre {}; __device__ __forceinline__ void preload(const Unit&, int, int, int, int, Pre&) const {}
    bf16_t* T; const bf16_t* SG2; float asc;
    __device__ __forceinline__ void operator()(const AccT& acc, const Unit& u, int wr, int wc, int fr, int fq, const Pre& P) const {
        const int row0 = u.pm * 256 + wr * 64 + fr, col0 = u.pn * 256 + wc * 32 + 8 * fq;
#pragma unroll
        for (int ai = 0; ai < 2; ++ai)
#pragma unroll
            for (int mp = 0; mp < 4; mp += 2) {
                u32x4 tq[4], sq[4];
#pragma unroll
                for (int q = 0; q < 4; ++q) { const size_t off = (size_t)(row0 + ai * 128 + (mp + (q >> 1)) * 16) * 1024 + col0 + (q & 1) * 128;
                    tq[q] = *(const u32x4*)(T + off); if (SECOND) sq[q] = *(const u32x4*)(SG2 + off); }
#pragma unroll
                for (int q = 0; q < 4; ++q) {
                    const int m = mp + (q >> 1), bj = q & 1;
                    const size_t off = (size_t)(row0 + ai * 128 + m * 16) * 1024 + col0 + bj * 128;
                    const f32x4 v0 = acc[ai][bj][m][0] * asc, v1 = acc[ai][bj][m][1] * asc;
                    const u32x4 t = tq[q];
                    float r[8];
                    if (!SECOND) {
                        r[0] = bflo(t.x) * v0[0]; r[1] = bfhi(t.x) * v0[1]; r[2] = bflo(t.y) * v0[2]; r[3] = bfhi(t.y) * v0[3];
                        r[4] = bflo(t.z) * v1[0]; r[5] = bfhi(t.z) * v1[1]; r[6] = bflo(t.w) * v1[2]; r[7] = bfhi(t.w) * v1[3];
                    } else {
                        const u32x4 s = sq[q];
                        r[0] = bflo(t.x) + bflo(s.x) * v0[0]; r[1] = bfhi(t.x) + bfhi(s.x) * v0[1]; r[2] = bflo(t.y) + bflo(s.y) * v0[2]; r[3] = bfhi(t.y) + bfhi(s.y) * v0[3];
                        r[4] = bflo(t.z) + bflo(s.z) * v1[0]; r[5] = bfhi(t.z) + bfhi(s.z) * v1[1]; r[6] = bflo(t.w) + bflo(s.w) * v1[2]; r[7] = bfhi(t.w) + bfhi(s.w) * v1[3];
                    }
                    u32x4 w; w.x = pk2(r[0], r[1]); w.y = pk2(r[2], r[3]); w.z = pk2(r[4], r[5]); w.w = pk2(r[6], r[7]);
                    *(u32x4*)(T + off) = w;
                }
            }
    }
};
struct EpiOut {
    static constexpr bool PERM = true;
    struct Pre {}; __device__ __forceinline__ void preload(const Unit&, int, int, int, int, Pre&) const {}
    const float* X; bf16_t* H1;
    __device__ __forceinline__ void operator()(const AccT& acc, const Unit& u, int wr, int wc, int fr, int fq, const Pre& P) const {
        const int row0 = u.pm * 256 + wr * 64 + fr, col0 = u.pn * 256 + wc * 32 + 8 * fq;
#pragma unroll
        for (int ai = 0; ai < 2; ++ai)
#pragma unroll
            for (int m = 0; m < 4; ++m)
#pragma unroll
                for (int bj = 0; bj < 2; ++bj) {
                    const size_t off = (size_t)(row0 + ai * 128 + m * 16) * 1024 + col0 + bj * 128;
                    const f32x4 x0 = *(const f32x4*)(X + off) + acc[ai][bj][m][0], x1 = *(const f32x4*)(X + off + 4) + acc[ai][bj][m][1];
                    *(u32x4*)(H1 + off) = (u32x4){pk2(x0.x, x0.y), pk2(x0.z, x0.w), pk2(x1.x, x1.y), pk2(x1.z, x1.w)};
                }
    }
};
struct EpiGateUp {
    static constexpr bool PERM = true;
    struct Pre { f32x4 bg0, bg1, bl0, bl1; };
    bf16_t* ACT; const float* BGU; int a_t0;
    __device__ __forceinline__ void preload(const Unit& u, int wr, int wc, int fr, int fq, Pre& P) const {
        const float* bg = BGU + (size_t)u.aux * 2048 + u.pn * 128 + wc * 32 + 8 * fq;
        P.bg0 = *(const f32x4*)bg; P.bg1 = *(const f32x4*)(bg + 4); P.bl0 = *(const f32x4*)(bg + 1024); P.bl1 = *(const f32x4*)(bg + 1028);
    }
    __device__ __forceinline__ void operator()(const AccT& acc, const Unit& u, int wr, int wc, int fr, int fq, const Pre& P) const {
        const int j0 = u.pn * 128 + wc * 32 + 8 * fq;
        const f32x4 bg0 = P.bg0, bg1 = P.bg1, bl0 = P.bl0 + 1.0f, bl1 = P.bl1 + 1.0f;
        const size_t row0 = (size_t)(u.pm - a_t0) * 256 + wr * 64 + fr;
        const f32x2 wsc2 = {WSC_INV, WSC_INV}, one2 = {1.0f, 1.0f}, ka2 = {-1.702f * LOG2E, -1.702f * LOG2E};
#pragma unroll
        for (int ai = 0; ai < 2; ++ai)
#pragma unroll
            for (int m = 0; m < 4; ++m) {
                f32x2 r[4];
#pragma unroll
                for (int n = 0; n < 2; ++n) {
                    const f32x4 ga = acc[ai][0][m][n], la = acc[ai][1][m][n], bgv = n ? bg1 : bg0, blv = n ? bl1 : bl0;
#pragma unroll
                    for (int hh = 0; hh < 2; ++hh) {
                        const f32x2 g = (f32x2){ga[2 * hh], ga[2 * hh + 1]} * wsc2 + (f32x2){bgv[2 * hh], bgv[2 * hh + 1]};
                        const f32x2 l = (f32x2){la[2 * hh], la[2 * hh + 1]} * wsc2 + (f32x2){blv[2 * hh], blv[2 * hh + 1]};
                        const f32x2 xg = {fminf(g.x, 7.0f), fminf(g.y, 7.0f)};
                        const f32x2 xl1 = {__builtin_amdgcn_fmed3f(l.x, -6.0f, 8.0f), __builtin_amdgcn_fmed3f(l.y, -6.0f, 8.0f)};
                        const f32x2 ar = xg * ka2;
                        const f32x2 ex = {fast_exp2(ar.x), fast_exp2(ar.y)};
                        const f32x2 dn = ex + one2;
                        const f32x2 rc = {fast_rcp(dn.x), fast_rcp(dn.y)};
                        r[n * 2 + hh] = (xg * xl1) * rc;
                    }
                }
                u32x2 w = {pk4_fp8(r[0].x, r[0].y, r[1].x, r[1].y), pk4_fp8(r[2].x, r[2].y, r[3].x, r[3].y)};
                *(u32x2*)((unsigned char*)ACT + (row0 + ai * 128 + m * 16) * 1024 + j0) = w;
            }
    }
};
struct EpiDown {
    static constexpr bool PERM = true;
    struct Pre { float gtv[8]; };
    bf16_t* Y; const float* BD; const float* SLOTG;
    __device__ __forceinline__ void preload(const Unit& u, int wr, int wc, int fr, int fq, Pre& P) const {
        const size_t row0 = (size_t)u.pm * 256 + wr * 64 + fr;
#pragma unroll
        for (int q = 0; q < 8; ++q) P.gtv[q] = SLOTG[row0 + (q >> 2) * 128 + (q & 3) * 16];
    }
    __device__ __forceinline__ void operator()(const AccT& acc, const Unit& u, int wr, int wc, int fr, int fq, const Pre& P) const {
        const int e = u.aux, col0 = u.pn * 256 + wc * 32 + 8 * fq;
        const size_t row0 = (size_t)u.pm * 256 + wr * 64 + fr;
        f32x4 bv[2][2]; float gtv[8];
#pragma unroll
        for (int bj = 0; bj < 2; ++bj) { bv[bj][0] = *(const f32x4*)(BD + (size_t)e * 1024 + col0 + bj * 128); bv[bj][1] = *(const f32x4*)(BD + (size_t)e * 1024 + col0 + bj * 128 + 4); }
#pragma unroll
        for (int q = 0; q < 8; ++q) gtv[q] = P.gtv[q];
#pragma unroll
        for (int ai = 0; ai < 2; ++ai)
#pragma unroll
            for (int m = 0; m < 4; ++m) {
                const size_t row = row0 + ai * 128 + m * 16;
                const float gt = gtv[ai * 4 + m];
#pragma unroll
                for (int bj = 0; bj < 2; ++bj) {
                    const f32x4 a = (acc[ai][bj][m][0] * WSC_INV + bv[bj][0]) * gt, c = (acc[ai][bj][m][1] * WSC_INV + bv[bj][1]) * gt;
                    u32x2 w = {pk4_fp8(a[0], a[1], a[2], a[3]), pk4_fp8(c[0], c[1], c[2], c[3])};
                    *(u32x2*)((unsigned char*)Y + row * 1024 + col0 + bj * 128) = w;
                }
            }
    }
};

struct Args { const float* in[24]; float* out; unsigned char* ws; int ph_lo, ph_hi; };
typedef const __attribute__((address_space(4))) Args* ArgsP;
__device__ __forceinline__ ArgsP fresh_args() { ArgsP p = (ArgsP)__builtin_amdgcn_kernarg_segment_ptr(); asm volatile("" : "+s"(p)); return p; }
struct Frame {
    LAS unsigned char* lds;
    int tid, lane, wave, G, bid;
};
extern __shared__ __attribute__((aligned(16))) unsigned char lds_raw[];
__device__ __forceinline__ Frame mkframe() { Frame F; F.lds = (LAS unsigned char*)lds_raw; F.tid = tid_fresh(); F.lane = F.tid & 63; F.wave = __builtin_amdgcn_readfirstlane(F.tid >> 6); F.G = gridDim.x; F.bid = blockIdx.x; return F; }
enum { I_X = 0, I_META, I_NORM_MIX_G, I_W_IN, I_B_FORGET, I_Q_NORM_G, I_W_UQ, I_KV_NORM_G, I_W_UK, I_W_UV, I_W_QIDX, I_KIDX_G, I_KIDX_B, I_W_BA, I_W_BB, I_W_OUT,
       I_NORM_FFN_G, I_W_ROUTER, I_B_ROUTER, I_W_GU, I_B_GU, I_W_DOWN, I_B_DOWN, I_NORM_FINAL_G };

struct TrItem { const float* W; bf16_t* WT; int K, N, dr0, k0, sc, fp8; };
__device__ __forceinline__ void tr_load(const TrItem& t, float (&v)[32], int lane) {
    const float* p = t.W + (size_t)(t.k0 + (lane >> 5)) * t.N + (t.sc >= 0 ? t.sc : 0);
#pragma unroll
    for (int i = 0; i < 32; ++i) v[i] = p[(size_t)(2 * i) * t.N];
}
__device__ __forceinline__ void tr_store(const TrItem& t, const float (&v)[32], LAS float* scr, int lane) {
#pragma unroll
    for (int i = 0; i < 32; ++i) scr[(2 * i + (lane >> 5)) * 33 + (lane & 31)] = t.sc >= 0 ? v[i] : 0.f;
    LDS_WAIT(); asm volatile("" ::: "memory");
    const int c = lane & 7;
#pragma unroll
    for (int j = 0; j < 4; ++j) { const int n = (lane >> 3) + 8 * j; const LAS float* s = scr + (8 * c) * 33 + n;
        if (t.fp8) { u32x2 o8 = {pk4_fp8(s[0 * 33] * WSC, s[1 * 33] * WSC, s[2 * 33] * WSC, s[3 * 33] * WSC), pk4_fp8(s[4 * 33] * WSC, s[5 * 33] * WSC, s[6 * 33] * WSC, s[7 * 33] * WSC)};
            *(u32x2*)((unsigned char*)t.WT + (size_t)(t.dr0 + n) * t.K + t.k0 + 8 * c) = o8; }
        else { u32x4 o; o.x = pk2(s[0 * 33], s[1 * 33]); o.y = pk2(s[2 * 33], s[3 * 33]); o.z = pk2(s[4 * 33], s[5 * 33]); o.w = pk2(s[6 * 33], s[7 * 33]);
            *(u32x4*)(t.WT + (size_t)(t.dr0 + n) * t.K + t.k0 + 8 * c) = o; } }
    LDS_WAIT(); asm volatile("" ::: "memory");
}
template <class Mk>
__device__ __forceinline__ void tr_run(int it0, int stride, int nit, LAS float* scr, int lane, const Mk& mk) {
    float va[32], vb[32];
    int it = it0;
    if (it >= nit) return;
    TrItem ta = mk(it), tb = ta;
    tr_load(ta, va, lane);
    for (;;) {
        const int it2 = it + stride;
        const bool h2 = it2 < nit;
        if (h2) { tb = mk(it2); tr_load(tb, vb, lane); }
        tr_store(ta, va, scr, lane);
        if (!h2) break;
        const int it3 = it2 + stride;
        const bool h3 = it3 < nit;
        if (h3) { ta = mk(it3); tr_load(ta, va, lane); }
        tr_store(tb, vb, scr, lane);
        if (!h3) break;
        it = it3;
    }
}
struct TrItem2 { const float* W; unsigned char* WT; int K, N, dr0, k0, sc0; };
__device__ __forceinline__ void tr2_load(const TrItem2& t, f32x4 (&v)[16], int lane) {
    const float* p = t.W + (size_t)(t.k0 + (lane >> 4)) * t.N + t.sc0 + (lane & 15) * 4;
#pragma unroll
    for (int i = 0; i < 16; ++i) v[i] = *(const f32x4*)(p + (size_t)(4 * i) * t.N);
}
template <class Mk>
__device__ __forceinline__ void tr2_run(int it0, int stride, int nit, LAS float* scr, int lane, const Mk& mk) {
    if (it0 >= nit) return;
    f32x4 v[16];
    TrItem2 cur = mk(it0);
    tr2_load(cur, v, lane);
    for (int it = it0;;) {
#pragma unroll
        for (int i = 0; i < 16; ++i) *(LAS f32x4*)(scr + ((lane >> 4) + 4 * i) * 68 + (lane & 15) * 4) = v[i];
        LDS_WAIT(); asm volatile("" ::: "memory");
        const int itn = it + stride; const bool hn = itn < nit;
        TrItem2 nxt = cur;
        if (hn) { nxt = mk(itn); tr2_load(nxt, v, lane); }
        const int nl = lane >> 2, kq = lane & 3;
#pragma unroll
        for (int p = 0; p < 4; ++p) {
            const int n = 16 * p + nl; const LAS float* sp = scr + (16 * kq) * 68 + n;
            u32x4 o;
            o.x = pk4_fp8(sp[0 * 68] * WSC, sp[1 * 68] * WSC, sp[2 * 68] * WSC, sp[3 * 68] * WSC);
            o.y = pk4_fp8(sp[4 * 68] * WSC, sp[5 * 68] * WSC, sp[6 * 68] * WSC, sp[7 * 68] * WSC);
            o.z = pk4_fp8(sp[8 * 68] * WSC, sp[9 * 68] * WSC, sp[10 * 68] * WSC, sp[11 * 68] * WSC);
            o.w = pk4_fp8(sp[12 * 68] * WSC, sp[13 * 68] * WSC, sp[14 * 68] * WSC, sp[15 * 68] * WSC);
            *(u32x4*)(cur.WT + (size_t)(cur.dr0 + n) * cur.K + cur.k0 + 16 * kq) = o;
        }
        LDS_WAIT(); asm volatile("" ::: "memory");
        if (!hn) break;
        cur = nxt; it = itn;
    }
}
struct MapId { __device__ __forceinline__ int operator()(int n) const { return n; } };
struct MapWin {
    __device__ __forceinline__ int operator()(int n) const {
        if (n < 1536) return n;
        if (n < 1792) return 1544 + (n - 1536);
        if (n < 1920) return 1800 + (n - 1792);
        if (n < 1952) return 1928 + (n - 1920);
        if (n < 2016) return 1960 + (n - 1952);
        if (n < 2024) return 1536 + (n - 2016);
        if (n < 2028) return 2024 + (n - 2024);
        if (n < 2048) return -1;
        if (n < 3072) return 2028 + (n - 2048);
        return 3052 + (n - 3072);
    }
};
struct MapGU { __device__ __forceinline__ int operator()(int n) const { const int pn = n >> 8, j = n & 255; return j < 128 ? pn * 128 + j : 1024 + pn * 128 + (j - 128); } };
__device__ __forceinline__ int meta_src(int c) {
    if (c < 512) return 512 + c;
    if (c < 1024) return 1024 + (c - 512);
    const int t = c - 1024;
    if (t < 128) return 1800 + t;
    if (t < 160) return 1928 + (t - 128);
    if (t < 224) return 1960 + (t - 160);
    if (t < 232) return 1536 + (t - 224);
    if (t < 236) return 2024 + (t - 232);
    return -1;
}
__device__ __forceinline__ void rms_row_to_bf16(const float* xrow, const float* g, bf16_t* orow, int lane) {
    const f32x4* xr = (const f32x4*)xrow + lane; const f32x4* gr = (const f32x4*)g + lane;
    f32x4 v[4]; float s = 0.f;
#pragma unroll
    for (int j = 0; j < 4; ++j) { v[j] = xr[64 * j]; s += (v[j].x * v[j].x + v[j].y * v[j].y) + (v[j].z * v[j].z + v[j].w * v[j].w); }
    const float rstd = 1.0f / sqrtf(wave_sum(s) * (1.f / 1024.f) + EPS);
    u64* o8 = (u64*)orow + lane;
#pragma unroll
    for (int j = 0; j < 4; ++j) { const f32x4 gg = gr[64 * j]; o8[64 * j] = (u64)pk2(v[j].x * rstd * gg.x, v[j].y * rstd * gg.y) | ((u64)pk2(v[j].z * rstd * gg.z, v[j].w * rstd * gg.w) << 32); }
}

__device__ __forceinline__ void p0_prologue(Frame& F) {
    const ArgsP A = fresh_args();
    LAS float* scr = (LAS float*)(F.lds + F.wave * 16384);
    const int gw = F.bid * 8 + F.wave, NGW = F.G * 8, lane = F.lane;
    unsigned char* ws = A->ws;
    {
        constexpr int I_WIN = 16 * 128, I_WA = 8 * 32, I_WOUT = 16 * 32;
        const float* w_in = A->in[I_W_IN]; const float* w_ba = A->in[I_W_BA]; const float* w_out = A->in[I_W_OUT];
        tr_run(gw, NGW, I_WIN + I_WA + I_WOUT, scr, lane, [&](int it) {
            TrItem t; int r = it;
            if (r < I_WIN) { t.W = w_in; t.K = 1024; t.N = D_IN; t.dr0 = (r % 128) * 32; t.k0 = (r / 128) * 64; t.sc = MapWin()(t.dr0 + (lane & 31));
                if (t.dr0 < 2048) { t.fp8 = 0; t.WT = (bf16_t*)(ws + WS_WIN_T); } else { t.fp8 = 1; t.WT = (bf16_t*)(ws + WS_WIN8 - (size_t)2048 * 1024); }
                return t; } r -= I_WIN;
            if (r < I_WA) { t.W = w_ba; t.WT = (bf16_t*)(ws + WS_WA_T); t.fp8 = 0; t.K = 512; t.N = 1024; t.dr0 = (r % 32) * 32; t.k0 = (r / 32) * 64; t.sc = t.dr0 + (lane & 31); return t; } r -= I_WA;
            t.W = w_out; t.WT = (bf16_t*)(ws + WS_WOUT_T); t.fp8 = 0; t.K = 1024; t.N = 1024; t.dr0 = (r % 32) * 32; t.k0 = (r / 32) * 64; t.sc = t.dr0 + (lane & 31); return t; });
    }
    {
        const int gt = F.bid * 512 + F.tid, NGT = F.G * 512;
        const float* w_uq = A->in[I_W_UQ]; const float* w_uk = A->in[I_W_UK]; const float* w_uv = A->in[I_W_UV]; const float* w_qidx = A->in[I_W_QIDX];
        const float* w_bb = A->in[I_W_BB]; const float* qg = A->in[I_Q_NORM_G];
        bf16_t* WQ2 = (bf16_t*)(ws + WS_WQ2_T); bf16_t* WOB = (bf16_t*)(ws + WS_WOB_T);
        for (int o = gt; o < 1536 * 256; o += NGT) {
            const int k = o / 1536, n = o - k * 1536; float v;
            if (n < 1024) { const int h = n >> 7, r = n & 127; float s = 0.f;
#pragma unroll 8
                for (int j = 0; j < 64; ++j) s += w_uq[k * 768 + 96 * h + j] * w_uk[(h * 64 + j) * 128 + r]; v = s; }
            else if (n < 1280) { const int h = (n - 1024) >> 5, j = (n - 1024) & 31; v = w_uq[k * 768 + 96 * h + 64 + j]; }
            else v = w_qidx[k * 256 + (n - 1280)];
            WQ2[n * 256 + k] = (bf16_t)(pk2(v * qg[k], 0.f) & 0xffffu);
        }
        for (int o = gt; o < 256 * 1024; o += NGT) {
            const int k4 = (o >> 10) * 4, n = o & 1023, h = k4 >> 7; float s0 = 0.f, s1 = 0.f, s2 = 0.f, s3 = 0.f;
            const float* uv = w_uv + (size_t)k4 * 64;
#pragma unroll 8
            for (int v = 0; v < 64; ++v) { const float wb = w_bb[(size_t)(h * 64 + v) * 1024 + n]; s0 += uv[v] * wb; s1 += uv[64 + v] * wb; s2 += uv[128 + v] * wb; s3 += uv[192 + v] * wb; }
            *(unsigned*)((unsigned char*)WOB + (size_t)n * 1024 + k4) = pk4_fp8(s0 * WSC, s1 * WSC, s2 * WSC, s3 * WSC);
        }
        float* COS = (float*)(ws + WS_COS); float* SIN = (float*)(ws + WS_SIN);
        for (int o = gt; o < TPB * 16; o += NGT) {
            const int pos = o >> 4, j = o & 15;
            const float inv = exp2f(-(float)j * (13.287712379549449f / 16.0f));
            const float ang = (float)pos * inv;
            const double rev = (double)ang * 0.15915494309189535; const float fr = (float)(rev - floor(rev));
            COS[o] = __builtin_amdgcn_cosf(fr); SIN[o] = __builtin_amdgcn_sinf(fr);
        }
    }
    {
        const float* X = A->in[I_X]; const f32x4* gr = (const f32x4*)A->in[I_NORM_MIX_G] + lane; bf16_t* XN = (bf16_t*)(ws + WS_XN);
        f32x4 v[4], vn[4];
        if (gw < M) {
#pragma unroll
            for (int j = 0; j < 4; ++j) v[j] = ((const f32x4*)(X + (size_t)gw * 1024) + lane)[64 * j];
        }
        for (int m = gw; m < M; m += NGW) {
            const int mn = (m + NGW < M) ? m + NGW : m;
#pragma unroll
            for (int j = 0; j < 4; ++j) vn[j] = ((const f32x4*)(X + (size_t)mn * 1024) + lane)[64 * j];
            float s2 = 0.f;
#pragma unroll
            for (int j = 0; j < 4; ++j) s2 += (v[j].x * v[j].x + v[j].y * v[j].y) + (v[j].z * v[j].z + v[j].w * v[j].w);
            const float rstd = 1.0f / sqrtf(wave_sum(s2) * (1.f / 1024.f) + EPS);
            u64* o8 = (u64*)(XN + (size_t)m * 1024) + lane; unsigned* o4 = (unsigned*)(ws + WS_XN8 + (size_t)m * 1024) + lane;
#pragma unroll
            for (int j = 0; j < 4; ++j) { const f32x4 gg = gr[64 * j]; const float y0 = v[j].x * rstd * gg.x, y1 = v[j].y * rstd * gg.y, y2 = v[j].z * rstd * gg.z, y3 = v[j].w * rstd * gg.w;
                o8[64 * j] = (u64)pk2(y0, y1) | ((u64)pk2(y2, y3) << 32); o4[64 * j] = pk4_fp8(y0, y1, y2, y3); }
#pragma unroll
            for (int j = 0; j < 4; ++j) v[j] = vn[j];
        }
    }
    __syncthreads();
    {
        LAS float* xnm = (LAS float*)F.lds;
        LAS float* red = (LAS float*)(F.lds + 65536);
        for (int un = F.bid; un < 20; un += F.G) {
            for (int p = F.wave; p < 16; p += 8) {
                const float* mr = A->in[I_META] + p * 1024; const float* g = A->in[I_NORM_MIX_G];
                float v[16]; float s = 0.f;
#pragma unroll
                for (int j = 0; j < 16; ++j) { v[j] = mr[lane + 64 * j]; s += v[j] * v[j]; }
                const float rstd = 1.0f / sqrtf(wave_sum(s) * (1.f / 1024.f) + EPS);
#pragma unroll
                for (int j = 0; j < 16; ++j) xnm[p * 1024 + lane + 64 * j] = v[j] * rstd * g[lane + 64 * j];
            }
            __syncthreads();
            const int c = un * 64 + lane, sc = meta_src(c);
            float a[16];
#pragma unroll
            for (int p = 0; p < 16; ++p) a[p] = 0.f;
            const float* W = A->in[I_W_IN];
            for (int k0 = F.wave * 128; k0 < F.wave * 128 + 128; k0 += 16) {
                float w[16];
#pragma unroll
                for (int j = 0; j < 16; ++j) w[j] = sc >= 0 ? W[(size_t)(k0 + j) * D_IN + sc] : 0.f;
#pragma unroll
                for (int j = 0; j < 16; ++j)
#pragma unroll
                    for (int p = 0; p < 16; ++p) a[p] += xnm[p * 1024 + k0 + j] * w[j];
            }
#pragma unroll
            for (int p = 0; p < 16; ++p) red[(F.wave * 16 + p) * 64 + lane] = a[p];
            __syncthreads();
            for (int o = F.tid; o < 1024; o += 512) { const int p = o >> 6, l = o & 63; float s = 0.f;
#pragma unroll
                for (int w = 0; w < 8; ++w) s += red[(w * 16 + p) * 64 + l];
                ((float*)(ws + WS_PROJM))[p * 1280 + un * 64 + l] = s; }
            __syncthreads();
        }
    }
}

__device__ __forceinline__ f32x4 log_sigmoid4(f32x4 z) {
    f32x4 r;
#pragma unroll
    for (int k = 0; k < 4; ++k) { const float x = z[k]; r[k] = fminf(x, 0.f) - log1pf(__expf(-fabsf(x))); }
    return r;
}
__host__ __device__ __forceinline__ int vt8_pos(int kp) { const int sub = kp >> 5, kk = kp & 31, hi = (kk >> 2) & 1, r = (kk & 3) + 4 * (kk >> 3); return 32 * hi + 16 * sub + r; }
struct PostPtrs { const float *kvg, *lg, *lb, *COS, *SIN; };
__device__ __forceinline__ void post_row(const PostPtrs& PP, const f32x4 v, int pos, unsigned char* k8_row, unsigned char* vt8_b, bf16_t* kidx_row, int lane) {
    const float* kvg = PP.kvg; const float* lg = PP.lg; const float* lb = PP.lb;
    const float* COS = PP.COS; const float* SIN = PP.SIN;
    const float ss = (v.x * v.x + v.y * v.y) + (v.z * v.z + v.w * v.w);
    const float s_ckv = wave_sum(lane < 32 ? ss : 0.f);
    const bool isk = (lane >= 40 && lane < 56);
    const float s_k = wave_sum(isk ? (v.x + v.y) + (v.z + v.w) : 0.f);
    const float mean = s_k * (1.f / 64.f);
    const f32x4 dv = v - mean;
    const float q_k = wave_sum(isk ? (dv.x * dv.x + dv.y * dv.y) + (dv.z * dv.z + dv.w * dv.w) : 0.f);
    const float rstd_c = 1.0f / sqrtf(s_ckv * (1.f / 128.f) + EPS);
    const float rstd_k = 1.0f / sqrtf(q_k * (1.f / 64.f) + EPS);
    f32x4 y = v;
    if (isk) { const int c = 4 * (lane - 40); const f32x4 g = *(const f32x4*)(lg + c), bb = *(const f32x4*)(lb + c); y = dv * rstd_k * g + bb; }
    f32x4 pr;
    pr.x = __shfl_xor(y.x, 4); pr.y = __shfl_xor(y.y, 4); pr.z = __shfl_xor(y.z, 4); pr.w = __shfl_xor(y.w, 4);
    if (lane < 32) {
        const f32x4 g = *(const f32x4*)(kvg + 4 * lane); const f32x4 o = v * rstd_c * g;
        const unsigned w = pk4_fp8(o.x, o.y, o.z, o.w);
        *(unsigned*)(k8_row + 4 * lane) = w;
    } else if (lane < 48) {
        const int jj = 4 * (lane & 3);
        const f32x4 cs = *(const f32x4*)(COS + pos * 16 + jj), sn = *(const f32x4*)(SIN + pos * 16 + jj);
        const f32x4 o = (lane & 4) ? (pr * sn + y * cs) : (y * cs - pr * sn);
        u32x2 w = {pk2(o.x, o.y), pk2(o.z, o.w)};
        if (lane < 40) *(unsigned*)(k8_row + 128 + 4 * (lane - 32)) = pk4_fp8(o.x, o.y, o.z, o.w); else *(u32x2*)(kidx_row + 4 * (lane - 40)) = w;
    } else if (lane < 56) {
        u32x2 w = {pk2(y.x, y.y), pk2(y.z, y.w)}; *(u32x2*)(kidx_row + 4 * (lane - 40)) = w;
        *(unsigned*)(k8_row + 160 + 4 * (lane - 48)) = 0u;
    }
}
__device__ __forceinline__ void p2_post(Frame& F) {
    const ArgsP A = fresh_args();
    unsigned char* ws = A->ws; const int lane = F.lane, tid = F.tid;
    const float* T7 = (const float*)(ws + WS_T7); const float* PROJM = (const float*)(ws + WS_PROJM);
    unsigned char* K8 = ws + WS_KVR; unsigned char* VT8 = ws + WS_VT8; bf16_t* KIDX = (bf16_t*)(ws + WS_KIDX); bf16_t* KA = (bf16_t*)(ws + WS_KA); bf16_t* VA = (bf16_t*)(ws + WS_VA);
    float* BIAS = (float*)(ws + WS_BIAS); float* IW = (float*)(ws + WS_IW); float* RSTDQ = (float*)(ws + WS_RSTDQ);
    const bf16_t* CQ = (const bf16_t*)(ws + WS_CQ);
    const float* bfg = A->in[I_B_FORGET];
    const PostPtrs PP{A->in[I_KV_NORM_G], A->in[I_KIDX_G], A->in[I_KIDX_B], (const float*)(ws + WS_COS), (const float*)(ws + WS_SIN)};
    LAS float* lf = (LAS float*)F.lds;
    LAS float* part = (LAS float*)(F.lds + 8192);
    LAS float* offs = (LAS float*)(F.lds + 8192 + 2048);
    LAS float* metaF = (LAS float*)(F.lds + 8192 + 2048 + 64);
    for (int un = F.bid; un < 256; un += F.G) {
        const int b = un >> 3, blk = un & 7;
        f32x4 vnx = *((const f32x4*)(T7 + (size_t)(b * 2048 + blk * 256 + F.wave * 32) * 256) + lane);
        u32x2 cnx = *((const u32x2*)(CQ + (size_t)(b * 2048 + blk * 256 + F.wave * 32) * 256) + lane);
        for (int rr = 0; rr < 32; ++rr) {
            const int i = blk * 256 + F.wave * 32 + rr; const int m = b * 2048 + i; const int mn = rr < 31 ? m + 1 : m;
            const f32x4 v = vnx; const u32x2 c = cnx;
            vnx = *((const f32x4*)(T7 + (size_t)mn * 256) + lane); cnx = *((const u32x2*)(CQ + (size_t)mn * 256) + lane);
            const size_t kr = (size_t)b * TPB + NMETA + i;
            post_row(PP, v, NMETA + i, K8 + kr * 192, VT8 + (size_t)b * NKT * 128 * 64, KIDX + kr * 64, lane);
            if (lane == 56 || lane == 57) { const int h0 = 4 * (lane - 56); const f32x4 z = v + *(const f32x4*)(bfg + h0); *(LAS f32x4*)(lf + (F.wave * 32 + rr) * 8 + h0) = log_sigmoid4(z); }
            if (lane == 58) *(f32x4*)(IW + (size_t)m * 4) = v * 0.0625f;
            { const float a0 = bflo(c.x), a1 = bfhi(c.x), a2 = bflo(c.y), a3 = bfhi(c.y);
              const float s = wave_sum((a0 * a0 + a1 * a1) + (a2 * a2 + a3 * a3)); if (lane == 0) RSTDQ[m] = 1.0f / sqrtf(s * (1.f / 256.f) + EPS); }
        }
        {
            float kmx = 0.f;
            for (int r8 = 0; r8 < 32; r8 += 8) {
                u32x4 w8[8];
#pragma unroll
                for (int rr = 0; rr < 8; ++rr) { const size_t kr = (size_t)b * TPB + NMETA + blk * 256 + F.wave * 32 + r8 + rr; w8[rr] = *((const u32x4*)(KA + kr * 512) + lane); }
#pragma unroll
                for (int rr = 0; rr < 8; ++rr) { const u32x4 w = w8[rr];
                    float s2 = (bflo(w.x) * bflo(w.x) + bfhi(w.x) * bfhi(w.x)) + (bflo(w.y) * bflo(w.y) + bfhi(w.y) * bfhi(w.y)) + (bflo(w.z) * bflo(w.z) + bfhi(w.z) * bfhi(w.z)) + (bflo(w.w) * bflo(w.w) + bfhi(w.w) * bfhi(w.w));
                    s2 += __shfl_xor(s2, 1); s2 += __shfl_xor(s2, 2); s2 += __shfl_xor(s2, 4);
                    kmx = fmaxf(kmx, s2); }
            }
            if (blk == 0) {
                for (int p = 0; p < 16; ++p) { const f32x4 a0 = *((const f32x4*)(PROJM + p * 1280) + 2 * lane), a1 = *((const f32x4*)(PROJM + p * 1280) + 2 * lane + 1);
                    float s2 = (a0.x * a0.x + a0.y * a0.y) + (a0.z * a0.z + a0.w * a0.w) + (a1.x * a1.x + a1.y * a1.y) + (a1.z * a1.z + a1.w * a1.w);
                    s2 += __shfl_xor(s2, 1); s2 += __shfl_xor(s2, 2); s2 += __shfl_xor(s2, 4);
                    kmx = fmaxf(kmx, s2 * 1.02f); }
            }
            if ((lane & 7) == 0) atomicMax((unsigned*)(ws + WS_CTL) + CW_KMAX + b * 8 + (lane >> 3), __float_as_uint(kmx));
        }
        {
            const int h = tid & 7; float s = 0.f;
            float zz[28];
#pragma unroll
            for (int k = 0; k < 28; ++k) { const int r = (tid >> 3) + 64 * k; zz[k] = (r < blk * 256) ? T7[(size_t)(b * 2048 + r) * 256 + 224 + h] : 1.0e30f; }
            const float bh = bfg[h];
#pragma unroll
            for (int k = 0; k < 28; ++k) { const float z = zz[k] + bh; s += fminf(z, 0.f) - log1pf(__expf(-fabsf(z))); }
            part[tid] = s;
            if (tid < 8) { float c = 0.f; for (int p = 0; p < 16; ++p) { const float z = PROJM[p * 1280 + 1248 + tid] + bfg[tid]; c += fminf(z, 0.f) - log1pf(__expf(-fabsf(z))); metaF[p * 8 + tid] = c; } }
        }
        __syncthreads();
        if (tid < 8) { float s = metaF[15 * 8 + tid]; for (int k = 0; k < 64; ++k) s += part[k * 8 + tid]; offs[tid] = s; }
        __syncthreads();
        {
            const int hh = F.wave; float* bo = BIAS + ((size_t)b * 8 + hh) * TPB + NMETA + blk * 256;
            const float a0 = lf[(4 * lane + 0) * 8 + hh], a1 = lf[(4 * lane + 1) * 8 + hh], a2 = lf[(4 * lane + 2) * 8 + hh], a3 = lf[(4 * lane + 3) * 8 + hh];
            const float t4 = (a0 + a1) + (a2 + a3); float inc = t4;
#pragma unroll
            for (int off = 1; off < 64; off <<= 1) { const float v2 = __shfl_up(inc, off); if (lane >= off) inc += v2; }
            const float c0 = offs[hh] + (inc - t4) + a0, c1 = c0 + a1, c2 = c1 + a2, c3 = c2 + a3;
            *(f32x4*)(bo + 4 * lane) = (f32x4){-c0 * LOG2E, -c1 * LOG2E, -c2 * LOG2E, -c3 * LOG2E};
        }
        if (blk == 0) {
            if (tid < 128) { const int p = tid >> 3, h = tid & 7; BIAS[((size_t)b * 8 + h) * TPB + p] = -metaF[p * 8 + h] * LOG2E; }
            if (tid >= 128 && tid < 512) { const int o = tid - 128; if (o < 48 * 8) { const int p = o >> 3, h = o & 7; BIAS[((size_t)b * 8 + h) * TPB + 2064 + p] = 0.f; } }
            for (int p = F.wave; p < 16; p += 8) {
                const float* src = PROJM + p * 1280;
                const size_t kr = (size_t)b * TPB + p;
                const f32x4 v = *((const f32x4*)(src + 1024) + lane);
                post_row(PP, v, p, K8 + kr * 192, VT8 + (size_t)b * NKT * 128 * 64, KIDX + kr * 64, lane);
#pragma unroll
                for (int j = 0; j < 2; ++j) {
                    const f32x4 a = *((const f32x4*)src + lane + 64 * j), c = *((const f32x4*)(src + 512) + lane + 64 * j);
                    u32x2 wa = {pk2(a.x, a.y), pk2(a.z, a.w)}, wc = {pk2(c.x, c.y), pk2(c.z, c.w)};
                    *((u32x2*)(KA + kr * 512) + lane + 64 * j) = wa; *((u32x2*)(VA + kr * 512) + lane + 64 * j) = wc;
                }
            }
            for (int p = F.wave; p < 48; p += 8) {
                const size_t kr = (size_t)b * TPB + 2064 + p; const u32x2 z = {0u, 0u};
                *((u32x2*)(KA + kr * 512) + lane) = z; *((u32x2*)(KA + kr * 512) + lane + 64) = z; *((u32x2*)(VA + kr * 512) + lane) = z; *((u32x2*)(VA + kr * 512) + lane + 64) = z;
                if (lane < 48) *((unsigned*)(K8 + kr * 192) + lane) = 0u;

                if (lane < 16) *((u32x2*)(KIDX + kr * 64) + lane) = z;
            }
        }
        __syncthreads();
    }
}

__device__ __forceinline__ void vt8_build(Frame& F) {
    const ArgsP A = fresh_args(); unsigned char* ws = A->ws; const int tid = F.tid;
    LAS unsigned char* t8 = F.lds;
    for (int un = F.bid; un < NB * NKT; un += F.G) {
        const int b = un / NKT, kt = un % NKT;
        const unsigned char* src = ws + WS_KVR + ((size_t)b * TPB + (size_t)kt * 64) * 192;
        { const int r = tid >> 3, ch = tid & 7; *(LAS u32x4*)(t8 + r * 144 + ch * 16) = *(const u32x4*)(src + (size_t)r * 192 + ch * 16); }
        __syncthreads();
        { const int d = tid >> 2, q4 = tid & 3;
          unsigned w[4];
#pragma unroll
          for (int g = 0; g < 4; ++g) { unsigned acc = 0u;
#pragma unroll
              for (int e = 0; e < 4; ++e) { const int beta = 16 * q4 + 4 * g + e; const int hi2 = beta >> 5, i2 = beta & 31, sub = i2 >> 4, r2 = i2 & 15;
                  const int kp = 32 * sub + (r2 & 3) + 8 * (r2 >> 2) + 4 * hi2; acc |= (unsigned)t8[kp * 144 + d] << (8 * e); }
              w[g] = acc; }
          *(u32x4*)(ws + WS_VT8 + ((size_t)un * 128 + d) * 64 + 16 * q4) = (u32x4){w[0], w[1], w[2], w[3]}; }
        __syncthreads();
    }
}
__device__ __forceinline__ s16x4 vtr(const LAS unsigned char* p) { return __builtin_bit_cast(s16x4, __builtin_amdgcn_ds_read_tr16_b64_v4i16((LAS s16x4*)p)); }
__device__ __forceinline__ float max3f(float a, float b, float c) { float r; asm("v_max3_f32 %0, %1, %2, %3" : "=v"(r) : "v"(a), "v"(b), "v"(c)); return r; }
__device__ __forceinline__ float max32(const f32x16& p, const f32x16& q) {
    float a = max3f(p[0], p[1], p[2]), b = max3f(q[0], q[1], q[2]);
    a = max3f(a, p[3], p[4]); b = max3f(b, q[3], q[4]); a = max3f(a, p[5], p[6]); b = max3f(b, q[5], q[6]);
    a = max3f(a, p[7], p[8]); b = max3f(b, q[7], q[8]); a = max3f(a, p[9], p[10]); b = max3f(b, q[9], q[10]);
    a = max3f(a, p[11], p[12]); b = max3f(b, q[11], q[12]); a = max3f(a, p[13], p[14]); b = max3f(b, q[13], q[14]);
    return max3f(a, b, max3f(p[15], q[15], q[15]));
}
__device__ __forceinline__ float max16(const f32x16& p) {
    float a = fmaxf(fmaxf(p[0], p[1]), fmaxf(p[2], p[3])), b = fmaxf(fmaxf(p[4], p[5]), fmaxf(p[6], p[7]));
    float c = fmaxf(fmaxf(p[8], p[9]), fmaxf(p[10], p[11])), d = fmaxf(fmaxf(p[12], p[13]), fmaxf(p[14], p[15]));
    return fmaxf(fmaxf(a, b), fmaxf(c, d));
}
#define PFRAG(P, s) ((bf16x8)__builtin_bit_cast(bf16x8, (u32x4){pk2(P[8 * (s) + 0], P[8 * (s) + 1]), pk2(P[8 * (s) + 2], P[8 * (s) + 3]), pk2(P[8 * (s) + 4], P[8 * (s) + 5]), pk2(P[8 * (s) + 6], P[8 * (s) + 7])}))

constexpr int FX_KP = 144;
constexpr int FX_TB = 64 * FX_KP;
constexpr int FX_K0 = 0, FX_V0 = 2 * FX_TB, FX_B0 = 4 * FX_TB;
__device__ __forceinline__ void fox_unit(Frame& F, int b, int hd, int qb) {
    const ArgsP A = fresh_args();
    const int tid = F.tid, lane = F.lane, r32 = lane & 31, hi = lane >> 5, wid = F.wave;
    unsigned char* ws = A->ws;
    bf16_t* QA = (bf16_t*)(ws + WS_QA); const bf16_t* KA = (const bf16_t*)(ws + WS_KA); const bf16_t* VA = (const bf16_t*)(ws + WS_VA);
    const float* BIAS = (const float*)(ws + WS_BIAS);
    LAS unsigned char* lds = F.lds;
    const int i0 = 256 * qb + 32 * wid;
    const int qpos = NMETA + i0 + r32;
    const size_t qrow = (size_t)b * 2048 + i0 + r32;
    bf16x8 qf[4];
#pragma unroll
    for (int d = 0; d < 4; ++d) qf[d] = *(const bf16x8*)(QA + qrow * 512 + hd * 64 + d * 16 + hi * 8);
    const int KT = 4 * qb + 5;
    const float* bg = BIAS + ((size_t)b * 8 + hd) * TPB;
    int kt_lo = 0;
    {
        float q2 = 0.f;
#pragma unroll
        for (int d = 0; d < 4; ++d) { const u32x4 w = __builtin_bit_cast(u32x4, qf[d]);
            q2 += (bflo(w.x) * bflo(w.x) + bfhi(w.x) * bfhi(w.x)) + (bflo(w.y) * bflo(w.y) + bfhi(w.y) * bfhi(w.y)) + (bflo(w.z) * bflo(w.z) + bfhi(w.z) * bfhi(w.z)) + (bflo(w.w) * bflo(w.w) + bfhi(w.w) * bfhi(w.w)); }
        q2 += __shfl_xor(q2, 32);
        q2 = wave_max(q2);
        LAS float* wq = (LAS float*)(lds + FX_B0 + 512);
        if (lane == 0) wq[wid] = q2;
        __syncthreads();
        float qm = wq[0];
#pragma unroll
        for (int w2 = 1; w2 < 8; ++w2) qm = fmaxf(qm, wq[w2]);
        const float km = __uint_as_float(ld_agent((const unsigned*)(ws + WS_CTL) + CW_KMAX + b * 8 + hd));
        const float thr = -(2.04f * sqrtf(qm * km) + 50.0f);
        const int ncand = 4 * qb;
        const float b0 = bg[NMETA + 256 * qb];
        const float dk = (lane < ncand) ? bg[64 * lane + 63] - b0 : 0.f;
        const u64 keep = __ballot(lane >= ncand || dk >= thr);
        kt_lo = __builtin_amdgcn_readfirstlane(__builtin_ctzll(keep));
        __syncthreads();
    }
    const int srow = tid >> 3, sch = tid & 7;
    const bf16_t* kg = KA + ((size_t)b * TPB + (size_t)kt_lo * 64 + srow) * 512 + hd * 64 + sch * 8;
    const bf16_t* vg = VA + ((size_t)b * TPB + (size_t)kt_lo * 64 + srow) * 512 + hd * 64 + sch * 8;
    const int sdst = srow * FX_KP + sch * 16;
    u32x4 kreg = *(const u32x4*)kg, vreg = *(const u32x4*)vg; float breg = (tid < 64) ? bg[kt_lo * 64 + tid] : 0.f;
    *(LAS u32x4*)(lds + FX_K0 + sdst) = kreg; *(LAS u32x4*)(lds + FX_V0 + sdst) = vreg; if (tid < 64) *(LAS float*)(lds + FX_B0 + tid * 4) = breg;
    __syncthreads();
    f32x16 o0 = {}, o1 = {}; float mrow = NEGBIG, lrow = 0.f;
    const int vlane = ((lane & 15) >> 2) * FX_KP + (16 * ((lane >> 4) & 1) + 4 * (lane & 3)) * 2 + 4 * hi * FX_KP;
    for (int kt = kt_lo; kt < KT; ++kt) {
        const int cur = (kt - kt_lo) & 1;
        if (kt + 1 < KT) { kreg = *(const u32x4*)(kg + (size_t)(kt + 1 - kt_lo) * 64 * 512); vreg = *(const u32x4*)(vg + (size_t)(kt + 1 - kt_lo) * 64 * 512); if (tid < 64) breg = bg[(kt + 1) * 64 + tid]; }
        if (64 * kt <= NMETA + i0 + 31) {
            const LAS unsigned char* Kb = lds + FX_K0 + cur * FX_TB; const LAS unsigned char* Vb = lds + FX_V0 + cur * FX_TB; const LAS unsigned char* Bb = lds + FX_B0 + cur * 256;
            f32x16 p0, p1;
#pragma unroll
            for (int g = 0; g < 4; ++g) { const f32x4 t0 = *(const LAS f32x4*)(Bb + (8 * g + 4 * hi) * 4), t1 = *(const LAS f32x4*)(Bb + (32 + 8 * g + 4 * hi) * 4);
                p0[4 * g] = t0.x; p0[4 * g + 1] = t0.y; p0[4 * g + 2] = t0.z; p0[4 * g + 3] = t0.w; p1[4 * g] = t1.x; p1[4 * g + 1] = t1.y; p1[4 * g + 2] = t1.z; p1[4 * g + 3] = t1.w; }
#pragma unroll
            for (int d = 0; d < 4; ++d) {
                const bf16x8 k0 = *(const LAS bf16x8*)(Kb + r32 * FX_KP + (d * 16 + hi * 8) * 2), k1 = *(const LAS bf16x8*)(Kb + (32 + r32) * FX_KP + (d * 16 + hi * 8) * 2);
                p0 = __builtin_amdgcn_mfma_f32_32x32x16_bf16(k0, qf[d], p0, 0, 0, 0); p1 = __builtin_amdgcn_mfma_f32_32x32x16_bf16(k1, qf[d], p1, 0, 0, 0);
            }
            asm volatile("s_nop 15\n\ts_nop 7" : "+v"(p0), "+v"(p1));
            if (64 * kt + 63 > NMETA + i0) {
#pragma unroll
                for (int r = 0; r < 16; ++r) { const int kp = 64 * kt + crow(r, hi); if (kp > qpos) p0[r] = NEGBIG; if (kp + 32 > qpos) p1[r] = NEGBIG; }
            }
            float mx = max32(p0, p1); mx = fmaxf(mx, __shfl_xor(mx, 32));
            const float mnew = fmaxf(mrow, mx), alpha = fast_exp2(mrow - mnew); mrow = mnew;
            float sum = 0.f;
#pragma unroll
            for (int r = 0; r < 16; ++r) { p0[r] = fast_exp2(p0[r] - mnew); p1[r] = fast_exp2(p1[r] - mnew); sum += p0[r] + p1[r]; }
            lrow = lrow * alpha + sum;
#pragma unroll
            for (int r = 0; r < 16; ++r) { o0[r] *= alpha; o1[r] *= alpha; }
            const bf16x8 pf0 = PFRAG(p0, 0), pf1 = PFRAG(p0, 1), pf2 = PFRAG(p1, 0), pf3 = PFRAG(p1, 1);
#pragma unroll
            for (int s = 0; s < 4; ++s) {
                const bf16x8 pf = s == 0 ? pf0 : s == 1 ? pf1 : s == 2 ? pf2 : pf3;
#pragma unroll
                for (int db = 0; db < 2; ++db) {
                    const LAS unsigned char* va = Vb + vlane + 16 * s * FX_KP + db * 64;
                    const s16x4 lo = vtr(va), hh = vtr(va + 8 * FX_KP);
                    const bf16x8 vf = {lo[0], lo[1], lo[2], lo[3], hh[0], hh[1], hh[2], hh[3]};
                    if (db == 0) o0 = __builtin_amdgcn_mfma_f32_32x32x16_bf16(vf, pf, o0, 0, 0, 0); else o1 = __builtin_amdgcn_mfma_f32_32x32x16_bf16(vf, pf, o1, 0, 0, 0);
                }
            }
        }
        if (kt + 1 < KT) { const int nb = cur ^ 1; *(LAS u32x4*)(lds + FX_K0 + nb * FX_TB + sdst) = kreg; *(LAS u32x4*)(lds + FX_V0 + nb * FX_TB + sdst) = vreg; if (tid < 64) *(LAS float*)(lds + FX_B0 + nb * 256 + tid * 4) = breg; }
        __syncthreads();
    }
    const float inv = 1.0f / (lrow + __shfl_xor(lrow, 32));
    bf16_t* orow = (bf16_t*)(ws + WS_OA) + qrow * 512 + hd * 64;
#pragma unroll
    for (int g = 0; g < 4; ++g) {
        u32x2 w0 = {pk2(o0[4 * g] * inv, o0[4 * g + 1] * inv), pk2(o0[4 * g + 2] * inv, o0[4 * g + 3] * inv)};
        u32x2 w1 = {pk2(o1[4 * g] * inv, o1[4 * g + 1] * inv), pk2(o1[4 * g + 2] * inv, o1[4 * g + 3] * inv)};
        *(u32x2*)(orow + 8 * g + 4 * hi) = w0; *(u32x2*)(orow + 32 + 8 * g + 4 * hi) = w1;
    }
}

constexpr int IX_NP = 2116;
template <int NS>
__device__ __forceinline__ u64 idx_select(const LAS float* row, int nslots, int lane, LAS u64* mwords) {
    unsigned key[NS];
#pragma unroll
    for (int s = 0; s < NS; ++s) { const unsigned u = __float_as_uint(row[64 * (s < nslots ? s : 0) + lane]); key[s] = (s < nslots) ? ((u & 0x80000000u) ? ~u : (u | 0x80000000u)) : 0u; }
    unsigned T = 0u; int cT = 0x7fffffff;
    for (int bit = 31; bit >= 0; --bit) {
        const unsigned cand = T | (1u << bit); int cnt = 0;
#pragma unroll
        for (int s = 0; s < NS; ++s) cnt += __builtin_popcountll(__ballot(key[s] >= cand));
        if (cnt >= 256) { T = cand; cT = cnt; if (cnt == 256) break; }
    }
    int need = 0;
    if (cT != 256) {
        int cgt = 0;
#pragma unroll
        for (int s = 0; s < NS; ++s) cgt += __builtin_popcountll(__ballot(key[s] > T));
        need = 256 - cgt;
    }
    int run = 0;
#pragma unroll
    for (int s = 0; s < NS; ++s) {
        u64 sel;
        if (cT == 256) sel = __ballot(key[s] >= T);
        else {
            const u64 tb = __ballot(key[s] == T);
            const int rank = run + __builtin_popcountll(tb & ((1ull << lane) - 1ull));
            sel = __ballot(key[s] > T || (key[s] == T && rank < need));
            run += __builtin_popcountll(tb);
        }
        if (lane == 0) mwords[s] = sel;
    }
    LDS_WAIT();
    return mwords[lane < NS ? lane : 0];
}
template <int CTRL, int RM> __device__ __forceinline__ unsigned dpp_add(unsigned v) { return v + (unsigned)__builtin_amdgcn_update_dpp(0, (int)v, CTRL, RM, 0xf, false); }
__device__ __forceinline__ unsigned wave_incl_scan(unsigned v) {
    v = dpp_add<0x111, 0xf>(v); v = dpp_add<0x112, 0xf>(v); v = dpp_add<0x114, 0xf>(v); v = dpp_add<0x118, 0xf>(v);
    v = dpp_add<0x142, 0xa>(v); v = dpp_add<0x143, 0xc>(v);
    return v;
}
template <int NS>
__device__ __forceinline__ u64 idx_select_hist(const LAS float* row, int nslots, int lane, LAS u64* mwords, LAS unsigned* hist) {
    unsigned key[NS];
#pragma unroll
    for (int s = 0; s < NS; ++s) { const unsigned u = __float_as_uint(row[64 * (s < nslots ? s : 0) + lane]); key[s] = (s < nslots) ? (u ^ ((unsigned)((int)u >> 31) | 0x80000000u)) : 0u; }
    unsigned prefix = 0u, Tge = 0u; int need = 256, pass = 0; bool simple = false;
#if SELP0
    {
        unsigned km = 0u;
#pragma unroll
        for (int s = 0; s < NS; ++s) km = km > key[s] ? km : key[s];
#pragma unroll
        for (int o = 1; o < 64; o <<= 1) { const unsigned v = (unsigned)__shfl_xor((int)km, o); km = km > v ? km : v; }
        const unsigned dmax = (unsigned)__builtin_amdgcn_readfirstlane((int)(km >> 24));
        if (dmax >= 4u) {
            const unsigned th0 = dmax << 24, th1 = (dmax - 1u) << 24;
            int c0 = 0, c1 = 0;
#pragma unroll
            for (int s = 0; s < NS; ++s) { c0 += __builtin_popcountll(__ballot(key[s] >= th0)); c1 += __builtin_popcountll(__ballot(key[s] >= th1)); }
            int above = -1, cb = 0; unsigned digit = 0u;
            if (c0 >= 256) { digit = dmax; above = 0; cb = c0; } else if (c1 >= 256) { digit = dmax - 1u; above = c0; cb = c1 - c0; }
            else {
                const unsigned th2 = (dmax - 2u) << 24, th3 = (dmax - 3u) << 24;
                int c2 = 0, c3 = 0;
#pragma unroll
                for (int s = 0; s < NS; ++s) { c2 += __builtin_popcountll(__ballot(key[s] >= th2)); c3 += __builtin_popcountll(__ballot(key[s] >= th3)); }
                if (c2 >= 256) { digit = dmax - 2u; above = c1; cb = c2 - c1; } else if (c3 >= 256) { digit = dmax - 3u; above = c2; cb = c3 - c2; }
            }
            if (above >= 0) {
                prefix = digit; need = 256 - above; pass = 1;
                if (cb == need) { Tge = prefix << 24; simple = true; }
            }
        }
    }
#endif
    if (!simple) {
#pragma unroll 1
        for (; pass < 4; ++pass) {
            const int sh = 24 - 8 * pass;
            *(LAS u32x4*)(hist + 4 * lane) = (u32x4){0u, 0u, 0u, 0u};
            LDS_WAIT();
#pragma unroll
            for (int s = 0; s < NS; ++s) {
                const unsigned k = key[s];
                const bool match = (s < nslots) && (pass == 0 || (k >> (sh + 8)) == prefix);
                if (match) __hip_atomic_fetch_add(hist + ((k >> sh) & 255u), 1u, __ATOMIC_RELAXED, __HIP_MEMORY_SCOPE_WORKGROUP);
            }
            LDS_WAIT();
            const u32x4 h = *(const LAS u32x4*)(hist + 4 * (63 - lane));
            const unsigned tl = (h.x + h.y) + (h.z + h.w);
            const unsigned incl = wave_incl_scan(tl);
            const unsigned excl = incl - tl, nd = (unsigned)need;
            const bool mine = (excl < nd) && (nd <= incl);
            const int L = __builtin_ctzll(__ballot(mine));
            unsigned c = excl, bin, above, cbin;
            if (nd <= c + h.w) { bin = 3u; above = c; cbin = h.w; } else { c += h.w;
            if (nd <= c + h.z) { bin = 2u; above = c; cbin = h.z; } else { c += h.z;
            if (nd <= c + h.y) { bin = 1u; above = c; cbin = h.y; } else { c += h.y; bin = 0u; above = c; cbin = h.x; } } }
            const unsigned digit = (unsigned)__builtin_amdgcn_readlane((int)(4u * (unsigned)(63 - lane) + bin), L);
            const unsigned abv = (unsigned)__builtin_amdgcn_readlane((int)above, L);
            const unsigned cb = (unsigned)__builtin_amdgcn_readlane((int)cbin, L);
            prefix = (prefix << 8) | digit; need -= (int)abv;
            if ((int)cb == need) { Tge = prefix << sh; simple = true; break; }
        }
    }
    if (simple) {
        unsigned lo = 0u, hi = 0u;
#pragma unroll
        for (int s = 0; s < NS; ++s) {
            const u64 sel = __ballot(key[s] >= Tge);
            asm("s_nop 1\n\tv_writelane_b32 %0, %2, %4\n\tv_writelane_b32 %1, %3, %4" : "+v"(lo), "+v"(hi) : "s"((unsigned)sel), "s"((unsigned)(sel >> 32)), "n"(s));
        }
        return ((u64)hi << 32) | lo;
    }
    const unsigned T = prefix; int run = 0;
#pragma unroll 1
    for (int s = 0; s < NS; ++s) {
        const unsigned k = __float_as_uint(row[64 * (s < nslots ? s : 0) + lane]); const unsigned ks = (s < nslots) ? (k ^ ((unsigned)((int)k >> 31) | 0x80000000u)) : 0u;
        const u64 tb = __ballot(ks == T);
        const int rank = run + __builtin_popcountll(tb & ((1ull << lane) - 1ull));
        const u64 sel = __ballot(ks > T || (ks == T && rank < need));
        run += __builtin_popcountll(tb);
        if (lane == 0) mwords[s] = sel;
    }
    LDS_WAIT();
    return mwords[lane < NS ? lane : 0];
}
__device__ __forceinline__ void idx_unit(Frame& F, int b, int c, int g16) {
    const ArgsP A = fresh_args();
    const int lane = F.lane, wid = F.wave;
    unsigned char* ws = A->ws;
    const bf16_t* QIDX = (const bf16_t*)(ws + WS_QIDX); const bf16_t* KIDX = (const bf16_t*)(ws + WS_KIDX); const float* IW = (const float*)(ws + WS_IW);
    u64* MASKW = (u64*)(ws + WS_MASKW);
    LAS float* sc = (LAS float*)F.lds;
    LAS u64* mwl = (LAS u64*)(F.lds + 16 * IX_NP * 4) + wid * 40;
    LAS unsigned* hst = (LAS unsigned*)(F.lds + 138240) + wid * 256;
    const int nslots = c + 2, nadm = 80 + 64 * c;
    const int q0 = 64 * c + 16 * g16;
    if (nadm > 256) {
        const int fr = lane & 15, fq = lane >> 4;
        const size_t qrow = (size_t)b * 2048 + q0 + fr;
        bf16x8 qf[4][2];
#pragma unroll
        for (int h = 0; h < 4; ++h)
#pragma unroll
            for (int s = 0; s < 2; ++s) qf[h][s] = *(const bf16x8*)(QIDX + qrow * 256 + h * 64 + s * 32 + fq * 8);
        const f32x4 wq = *(const f32x4*)(IW + qrow * 4);
        const bf16_t* kb = KIDX + ((size_t)b * TPB + fr) * 64 + fq * 8;
        const int nt16 = 4 * nslots;
        int nrs = (IDXREP & 1) ? 2 : 1; asm volatile("" : "+s"(nrs));
        for (int rs = 0; rs < nrs; ++rs)
        for (int t0 = wid; t0 < nt16; t0 += 32) {
            bf16x8 k0[4], k1[4];
#pragma unroll
            for (int j = 0; j < 4; ++j) { const int t = (t0 + 8 * j < nt16) ? t0 + 8 * j : t0; k0[j] = *(const bf16x8*)(kb + (size_t)t * 16 * 64); k1[j] = *(const bf16x8*)(kb + (size_t)t * 16 * 64 + 32); }
#pragma unroll
            for (int j = 0; j < 4; ++j) {
                const int t = t0 + 8 * j;
                if (t < nt16) {
                    f32x4 acc = {0.f, 0.f, 0.f, 0.f};
#pragma unroll
                    for (int h = 0; h < 4; ++h) {
                        f32x4 a = {0.f, 0.f, 0.f, 0.f};
                        a = __builtin_amdgcn_mfma_f32_16x16x32_bf16(k0[j], qf[h][0], a, 0, 0, 0);
                        a = __builtin_amdgcn_mfma_f32_16x16x32_bf16(k1[j], qf[h][1], a, 0, 0, 0);
                        const float w = wq[h];
                        acc.x += w * fmaxf(a.x, 0.f); acc.y += w * fmaxf(a.y, 0.f); acc.z += w * fmaxf(a.z, 0.f); acc.w += w * fmaxf(a.w, 0.f);
                    }
                    const int kp = 16 * t + 4 * fq;
                    if (kp + 0 >= nadm) acc.x = NEGBIG; if (kp + 1 >= nadm) acc.y = NEGBIG; if (kp + 2 >= nadm) acc.z = NEGBIG; if (kp + 3 >= nadm) acc.w = NEGBIG;
                    *(LAS f32x4*)(sc + fr * IX_NP + kp) = acc;
                }
            }
        }
    }
    __syncthreads();
    int nrq = (IDXREP & 2) ? 4 : 2; asm volatile("" : "+s"(nrq));
    for (int qq = 0; qq < nrq; ++qq) {
        const int ql = 2 * wid + (qq & 1);
        const size_t qrow = (size_t)b * 2048 + q0 + ql;
        u64 myword = 0ull;
        if (nadm <= 256) {
#pragma unroll
            for (int s = 0; s < 5; ++s) { const u64 bl = __ballot(64 * s + lane < nadm); if (lane == s) myword = bl; }
        } else if (nslots <= 8) myword = SELHIST ? idx_select_hist<8>(sc + ql * IX_NP, nslots, lane, mwl, hst) : idx_select<8>(sc + ql * IX_NP, nslots, lane, mwl);
        else if (nslots <= 12) myword = SELHIST ? idx_select_hist<12>(sc + ql * IX_NP, nslots, lane, mwl, hst) : idx_select<12>(sc + ql * IX_NP, nslots, lane, mwl);
        else if (nslots <= 16) myword = SELHIST ? idx_select_hist<16>(sc + ql * IX_NP, nslots, lane, mwl, hst) : idx_select<16>(sc + ql * IX_NP, nslots, lane, mwl);
        else if (nslots <= 20) myword = SELHIST ? idx_select_hist<20>(sc + ql * IX_NP, nslots, lane, mwl, hst) : idx_select<20>(sc + ql * IX_NP, nslots, lane, mwl);
        else if (nslots <= 24) myword = SELHIST ? idx_select_hist<24>(sc + ql * IX_NP, nslots, lane, mwl, hst) : idx_select<24>(sc + ql * IX_NP, nslots, lane, mwl);
        else if (nslots <= 28) myword = SELHIST ? idx_select_hist<28>(sc + ql * IX_NP, nslots, lane, mwl, hst) : idx_select<28>(sc + ql * IX_NP, nslots, lane, mwl);
        else myword = SELHIST ? idx_select_hist<NKT>(sc + ql * IX_NP, nslots, lane, mwl, hst) : idx_select<NKT>(sc + ql * IX_NP, nslots, lane, mwl);
        if (lane < nslots) MASKW[qrow * NKT + lane] = myword;
#if SELCHECK
        if (wid == 0 && qq == 0 && g16 == 0) {
            const LAS float* row = sc + ql * IX_NP; bool bad = false;
            for (int s0 = 0; s0 < nslots; ++s0) {
                const int i = 64 * s0 + lane; const bool adm = i < nadm;
                bool sel;
                if (nadm <= 256) sel = adm;
                else {
                    const float xi = row[i]; int rank = 0;
                    for (int j2 = 0; j2 < nadm; ++j2) { const float xj = row[j2]; rank += (xj > xi || (xj == xi && j2 < i)) ? 1 : 0; }
                    sel = adm && rank < 256;
                }
                const u64 wmask = __shfl(myword, s0);
                const bool got = (wmask >> lane) & 1ull;
                if (got != sel) bad = true;
            }
            if (__any(bad) && lane == 0) atomicOr((unsigned*)(ws + WS_CTL) + CW_ERR, 1u);
        }
#endif
    }
    __syncthreads();
}

constexpr int D8_KP = 208, D8_KT = 64 * D8_KP;
constexpr int D8_VP = 80, D8_VT = 128 * D8_VP;
constexpr int D8_K0 = 0, D8_V0 = 2 * D8_KT;
__device__ __forceinline__ v8i_t ld32(const LAS unsigned char* p) { return __builtin_shufflevector(*(const LAS v4i_t*)p, *(const LAS v4i_t*)(p + 16), 0, 1, 2, 3, 4, 5, 6, 7); }
#define MFMA8(acc, a, b) asm volatile("s_nop 1\n\tv_mfma_scale_f32_32x32x64_f8f6f4 %0, %1, %2, %0, %3, %3 op_sel_hi:[0,0,0]" : "+v"(acc) : "v"(a), "v"(b), "v"(sc1))
__device__ __forceinline__ void dsa_unit(Frame& F, int b, int c, int half) {
    const ArgsP A = fresh_args();
    const int tid = F.tid, lane = F.lane, r32 = lane & 31, hi = lane >> 5, wid = F.wave;
    unsigned char* ws = A->ws;
    const unsigned char* QL8 = ws + WS_QL; const unsigned char* K8 = ws + WS_KVR + (size_t)b * TPB * 192; const unsigned char* VT8 = ws + WS_VT8 + (size_t)b * NKT * 128 * 64;
    const u64* MASKW = (const u64*)(ws + WS_MASKW);
    LAS unsigned char* lds = F.lds;
    const int i0 = 64 * c + 32 * half;
    const size_t qrow = (size_t)b * 2048 + i0 + r32;
    int sc1 = 0x7f7f7f7f; asm volatile("" : "+v"(sc1));
    v8i_t qf[3];
#pragma unroll
    for (int s3 = 0; s3 < 3; ++s3) { const unsigned char* qp = QL8 + qrow * 1536 + wid * 192 + 64 * s3 + 32 * hi;
        qf[s3] = __builtin_shufflevector(*(const v4i_t*)qp, *(const v4i_t*)(qp + 16), 0, 1, 2, 3, 4, 5, 6, 7); }
    const int KT = c + 2;
    const int kc1 = tid + 512; const bool k1ok = kc1 < 768;
    const int kr0 = tid / 12, kq0 = tid % 12, kr1 = k1ok ? kc1 / 12 : 0, kq1 = k1ok ? kc1 % 12 : 0;
    const int vd = tid >> 2, vq = tid & 3;
    u32x4 sk0, sk1, sv;
    sk0 = *(const u32x4*)(K8 + (size_t)kr0 * 192 + kq0 * 16); sk1 = *(const u32x4*)(K8 + (size_t)kr1 * 192 + kq1 * 16); sv = *(const u32x4*)(VT8 + (size_t)vd * 64 + vq * 16);
    *(LAS u32x4*)(lds + D8_K0 + kr0 * D8_KP + kq0 * 16) = sk0; if (k1ok) *(LAS u32x4*)(lds + D8_K0 + kr1 * D8_KP + kq1 * 16) = sk1; *(LAS u32x4*)(lds + D8_V0 + vd * D8_VP + vq * 16) = sv;
    u64 mw = MASKW[qrow * NKT + 0], mwn = 0ull;
    __syncthreads();
    f32x16 o[4]; o[0] = f32x16{}; o[1] = f32x16{}; o[2] = f32x16{}; o[3] = f32x16{};
    float mrow = NEGBIG, lrow = 0.f;
    for (int kt = 0; kt < KT; ++kt) {
        const int cur = kt & 1;
        if (kt + 1 < KT) {
            const unsigned char* kn = K8 + (size_t)(kt + 1) * 64 * 192; const unsigned char* vn = VT8 + (size_t)(kt + 1) * 128 * 64;
            sk0 = *(const u32x4*)(kn + (size_t)kr0 * 192 + kq0 * 16); sk1 = *(const u32x4*)(kn + (size_t)kr1 * 192 + kq1 * 16); sv = *(const u32x4*)(vn + (size_t)vd * 64 + vq * 16);
            mwn = MASKW[qrow * NKT + kt + 1];
        }
        {
            const LAS unsigned char* Kb = lds + D8_K0 + cur * D8_KT + r32 * D8_KP + 32 * hi;
            const LAS unsigned char* Vb = lds + D8_V0 + cur * D8_VT + r32 * D8_VP + 32 * hi;
            v8i_t ka[3];
            f32x16 p0 = {}, p1 = {};
#pragma unroll
            for (int s3 = 0; s3 < 3; ++s3) ka[s3] = ld32(Kb + 64 * s3);
#pragma unroll
            for (int s3 = 0; s3 < 3; ++s3) MFMA8(p0, ka[s3], qf[s3]);
            __builtin_amdgcn_sched_barrier(0);
#pragma unroll
            for (int s3 = 0; s3 < 3; ++s3) ka[s3] = ld32(Kb + 32 * D8_KP + 64 * s3);
#pragma unroll
            for (int s3 = 0; s3 < 3; ++s3) MFMA8(p1, ka[s3], qf[s3]);
            __builtin_amdgcn_sched_barrier(0);
            v8i_t vf[4];
#pragma unroll
            for (int db = 0; db < 4; ++db) vf[db] = ld32(Vb + 32 * db * D8_VP);
            asm volatile("s_nop 15\n\ts_nop 7" : "+v"(p0), "+v"(p1));
            const unsigned m0 = (unsigned)mw, m1 = (unsigned)(mw >> 32);
            constexpr float IQ = 1.0f / QSC;
#pragma unroll
            for (int r = 0; r < 16; ++r) { const int kbit = crow(r, hi);
                const int t0 = __builtin_amdgcn_sbfe((int)m0, kbit, 1), t1 = __builtin_amdgcn_sbfe((int)m1, kbit, 1);
                p0[r] = __uint_as_float((__float_as_uint(p0[r]) & (unsigned)t0) | (0xf149f2cau & ~(unsigned)t0));
                p1[r] = __uint_as_float((__float_as_uint(p1[r]) & (unsigned)t1) | (0xf149f2cau & ~(unsigned)t1)); }
            float mx = max32(p0, p1); mx = fmaxf(mx, __shfl_xor(mx, 32)) * IQ;
            const float mnew = fmaxf(mrow, mx), alpha = fast_exp2(mrow - mnew); mrow = mnew;
            const float mofs = 7.0f - mnew;
            float sum = 0.f;
#pragma unroll
            for (int r = 0; r < 16; ++r) { p0[r] = fast_exp2(fmaf(p0[r], IQ, mofs)); p1[r] = fast_exp2(fmaf(p1[r], IQ, mofs)); sum += p0[r] + p1[r]; }
            lrow = lrow * alpha + sum;
#pragma unroll
            for (int db = 0; db < 4; ++db)
#pragma unroll
                for (int r = 0; r < 16; ++r) o[db][r] *= alpha;
            v8i_t pb;
#pragma unroll
            for (int g = 0; g < 4; ++g) { pb[g] = (int)pk4_fp8(p0[4 * g], p0[4 * g + 1], p0[4 * g + 2], p0[4 * g + 3]);
                                         pb[4 + g] = (int)pk4_fp8(p1[4 * g], p1[4 * g + 1], p1[4 * g + 2], p1[4 * g + 3]); }
#pragma unroll
            for (int db = 0; db < 4; ++db) MFMA8(o[db], vf[db], pb);
            asm volatile("s_nop 15\n\ts_nop 7" : "+v"(o[0]), "+v"(o[1]), "+v"(o[2]), "+v"(o[3]));
        }
        if (kt + 1 < KT) {
            const int nb = cur ^ 1;
            *(LAS u32x4*)(lds + D8_K0 + nb * D8_KT + kr0 * D8_KP + kq0 * 16) = sk0; if (k1ok) *(LAS u32x4*)(lds + D8_K0 + nb * D8_KT + kr1 * D8_KP + kq1 * 16) = sk1;
            *(LAS u32x4*)(lds + D8_V0 + nb * D8_VT + vd * D8_VP + vq * 16) = sv;
            mw = mwn;
        }
        __syncthreads();
    }
    const float inv = 1.0f / (lrow + __shfl_xor(lrow, 32));
    unsigned char* orow = ws + WS_OLAT + qrow * 1024 + wid * 128;
    const float isc = inv * OLSC;
#pragma unroll
    for (int db = 0; db < 4; ++db)
#pragma unroll
        for (int g = 0; g < 4; ++g)
            *(unsigned*)(orow + 32 * db + 8 * g + 4 * hi) = pk4_fp8(o[db][4 * g] * isc, o[db][4 * g + 1] * isc, o[db][4 * g + 2] * isc, o[db][4 * g + 3] * isc);
}
#undef MFMA8

__device__ __forceinline__ void p8_router(Frame& F) {
    const ArgsP A = fresh_args();
    unsigned char* ws = A->ws; const int lane = F.lane, tid = F.tid;
    const bf16_t* H1 = (const bf16_t*)(ws + WS_H1B); const float* g = A->in[I_NORM_FFN_G]; const float* WR = A->in[I_W_ROUTER]; const float* BR = A->in[I_B_ROUTER];
    int* TOPE = (int*)(ws + WS_TOPE); float* TOPG = (float*)(ws + WS_TOPG); int* LR = (int*)(ws + WS_LR); int* BC = (int*)(ws + WS_BC);
    LAS unsigned char* wf = F.lds;
    LAS int* te = (LAS int*)(F.lds + 131072);
    for (int o0 = tid; o0 < 32 * 1024; o0 += 512 * 8) {
        float wv[8], gv[8];
#pragma unroll
        for (int q = 0; q < 8; ++q) { const int o = o0 + 512 * q; wv[q] = WR[o]; gv[q] = g[o >> 5]; }
#pragma unroll
        for (int q = 0; q < 8; ++q) {
            const int o = o0 + 512 * q; const int k = o >> 5, e = o & 31;
            const float w = wv[q] * gv[q];
            const unsigned hb = pk2(w, 0.f) & 0xffffu; const unsigned lb = pk2(w - bflo(hb), 0.f) & 0xffffu;
            const int st = ((k >> 5) << 1) | ((k >> 3) & 1), ln = e + 32 * ((k >> 4) & 1), j = k & 7;
            *(LAS bf16_t*)(wf + ((st * 2 + 0) * 64 + ln) * 16 + j * 2) = (bf16_t)hb;
            *(LAS bf16_t*)(wf + ((st * 2 + 1) * 64 + ln) * 16 + j * 2) = (bf16_t)lb;
        }
    }
    __syncthreads();
    const int tk = lane & 31, h = lane >> 5;
    for (int un = F.bid; un < 256; un += F.G) {
        const int rl = F.wave * 32 + tk; const int m = un * 256 + rl;
        const u32x4* xr = (const u32x4*)(H1 + (size_t)m * 1024 + 16 * h);
        f32x16 ahh, alh;
#pragma unroll
        for (int r = 0; r < 16; ++r) { ahh[r] = 0.f; alh[r] = 0.f; }
        float ss = 0.f;
        u32x4 bA[8], bB[8];
#define RT_LOAD(buf, c) { _Pragma("unroll") for (int i = 0; i < 8; ++i) buf[i] = xr[(c) * 16 + (i >> 1) * 4 + (i & 1)]; }
#define RT_PROC(buf, c) { _Pragma("unroll") for (int q = 0; q < 8; ++q) { \
            const u32x4 xp = buf[q]; \
            { const float e0 = bflo(xp.x), e1 = bfhi(xp.x), e2 = bflo(xp.y), e3 = bfhi(xp.y), e4 = bflo(xp.z), e5 = bfhi(xp.z), e6 = bflo(xp.w), e7 = bfhi(xp.w); \
              ss += (e0 * e0 + e1 * e1) + (e2 * e2 + e3 * e3) + (e4 * e4 + e5 * e5) + (e6 * e6 + e7 * e7); } \
            const LAS unsigned char* wp = wf + (size_t)((c) * 8 + q) * 2048 + lane * 16; \
            const bf16x8 wh = *(const LAS bf16x8*)wp, wl = *(const LAS bf16x8*)(wp + 1024); \
            const bf16x8 xh = __builtin_bit_cast(bf16x8, xp); \
            ahh = __builtin_amdgcn_mfma_f32_32x32x16_bf16(wh, xh, ahh, 0, 0, 0); \
            alh = __builtin_amdgcn_mfma_f32_32x32x16_bf16(wl, xh, alh, 0, 0, 0); } }
        RT_LOAD(bA, 0)
#pragma unroll 1
        for (int c = 0; c < 8; c += 2) {
            RT_LOAD(bB, c + 1)
            RT_PROC(bA, c)
            { const int cn = c + 2 < 8 ? c + 2 : 7; RT_LOAD(bA, cn) }
            RT_PROC(bB, c + 1)
        }
#undef RT_LOAD
#undef RT_PROC
        ss += __shfl_xor(ss, 32);
        const float rstd = 1.0f / sqrtf(ss * (1.f / 1024.f) + EPS);
        float t0 = -INFINITY, t1 = -INFINITY, t2 = -INFINITY, t3 = -INFINITY; int i0 = 99, i1 = 99, i2 = 99, i3 = 99;
#define RT_GT(v, id, tv, ti) ((v) > (tv) || ((v) == (tv) && (id) < (ti)))
#define RT_INS(v, id) { const bool c0 = RT_GT(v, id, t0, i0), c1 = RT_GT(v, id, t1, i1), c2 = RT_GT(v, id, t2, i2), c3 = RT_GT(v, id, t3, i3); \
            t3 = c2 ? t2 : (c3 ? (v) : t3); i3 = c2 ? i2 : (c3 ? (id) : i3); t2 = c1 ? t1 : (c2 ? (v) : t2); i2 = c1 ? i1 : (c2 ? (id) : i2); \
            t1 = c0 ? t0 : (c1 ? (v) : t1); i1 = c0 ? i0 : (c1 ? (id) : i1); t0 = c0 ? (v) : t0; i0 = c0 ? (id) : i0; }
#pragma unroll
        for (int r = 0; r < 16; ++r) { const int id = crow(r, 0) + 4 * h; const float v = (ahh[r] + alh[r]) * rstd + BR[id]; RT_INS(v, id) }
        { const float p0 = __shfl_xor(t0, 32), p1 = __shfl_xor(t1, 32), p2 = __shfl_xor(t2, 32), p3 = __shfl_xor(t3, 32);
          const int j0 = __shfl_xor(i0, 32), j1 = __shfl_xor(i1, 32), j2 = __shfl_xor(i2, 32), j3 = __shfl_xor(i3, 32);
          RT_INS(p0, j0) RT_INS(p1, j1) RT_INS(p2, j2) RT_INS(p3, j3) }
#undef RT_INS
#undef RT_GT
        const float e1 = __expf(t1 - t0), e2 = __expf(t2 - t0), e3 = __expf(t3 - t0);
        const float inv = 1.0f / (1.0f + e1 + e2 + e3);
        if (h == 0) {
            *(int4*)(TOPE + (size_t)m * 4) = make_int4(i0, i1, i2, i3);
            *(f32x4*)(TOPG + (size_t)m * 4) = (f32x4){inv, e1 * inv, e2 * inv, e3 * inv};
            *(LAS v4i_t*)(te + rl * 4) = (v4i_t){i0, i1, i2, i3};
        }
        __syncthreads();
        for (int e = F.wave * 4; e < F.wave * 4 + 4; ++e) {
            int run = 0;
            for (int r4 = 0; r4 < 4; ++r4) {
                const int rl = r4 * 64 + lane;
                const int a0 = te[rl * 4], a1 = te[rl * 4 + 1], a2 = te[rl * 4 + 2], a3 = te[rl * 4 + 3];
                const int kk = (a0 == e) ? 0 : (a1 == e) ? 1 : (a2 == e) ? 2 : (a3 == e) ? 3 : -1;
                const u64 bl = __ballot(kk >= 0);
                if (kk >= 0) LR[(size_t)(un * 256 + rl) * 4 + kk] = run + __builtin_popcountll(bl & ((1ull << lane) - 1ull));
                run += __builtin_popcountll(bl);
            }
            if (lane == 0) BC[un * 32 + e] = run;
        }
        __syncthreads();
    }
}

__device__ __forceinline__ void p9_slots(Frame& F) {
    const ArgsP A = fresh_args();
    unsigned char* ws = A->ws; const int lane = F.lane, tid = F.tid;
    const bf16_t* H1 = (const bf16_t*)(ws + WS_H1B); const float* g = A->in[I_NORM_FFN_G];
    const int* TOPE = (const int*)(ws + WS_TOPE); const float* TOPG = (const float*)(ws + WS_TOPG); const int* LR = (const int*)(ws + WS_LR); const int* BC = (const int*)(ws + WS_BC);
    int* TOKSLOT = (int*)(ws + WS_TOKSLOT); float* SLOTG = (float*)(ws + WS_SLOTG); int* TILEE = (int*)(ws + WS_TILEE); int* GRP = (int*)(ws + WS_GRP);
    bf16_t* XBY = (bf16_t*)(ws + WS_XBY);
    LAS int* tot = (LAS int*)F.lds;
    LAS int* pst = tot + 32;
    LAS int* base = pst + 40;
    for (int un = F.bid; un < 256; un += F.G) {
        if (tid < 32) { tot[tid] = 0; base[tid] = 0; }
        __syncthreads();
        { const int e = tid & 31, part = tid >> 5; int c[16];
#pragma unroll
          for (int j = 0; j < 16; ++j) c[j] = ld_agent_i(BC + (part * 16 + j) * 32 + e);
          int t = 0, bs = 0;
#pragma unroll
          for (int j = 0; j < 16; ++j) { t += c[j]; if (part * 16 + j < un) bs += c[j]; }
          __hip_atomic_fetch_add(tot + e, t, __ATOMIC_RELAXED, __HIP_MEMORY_SCOPE_WORKGROUP); __hip_atomic_fetch_add(base + e, bs, __ATOMIC_RELAXED, __HIP_MEMORY_SCOPE_WORKGROUP); }
        __syncthreads();
        if (tid == 0) { int s = 0; for (int e = 0; e < 32; ++e) { pst[e] = s; s += ((tot[e] + 255) >> 8) << 8; } pst[32] = s; }
        __syncthreads();
        if (un == 0 && tid >= 64 && tid < 96) { const int e = tid - 64; const int t0 = pst[e] >> 8, t1 = pst[e + 1] >> 8; for (int t = t0; t < t1; ++t) TILEE[t] = e; }
        if (un == 0 && tid == 0) {
            int ng = 0, gl = 0; int* gt = GRP + 4;
            for (int e = 0; e < 32; ++e) {
                const int t0 = pst[e] >> 8, t1 = pst[e + 1] >> 8;
                if (t1 - gl > ACT_CAP_TILES) { gt[ng] = gl; gt[MAXG + ng] = t0; ++ng; gl = t0; }
            }
            gt[ng] = gl; gt[MAXG + ng] = pst[32] >> 8; ++ng;
            GRP[0] = ng; GRP[1] = pst[32] >> 8;
        }
        f32x4 v[4], vn[4];
#pragma unroll
        for (int j = 0; j < 4; ++j) v[j] = ld4bf(H1 + (size_t)(un * 256 + F.wave * 32) * 1024 + 4 * lane + 256 * j);
        int4 te = *(const int4*)(TOPE + (size_t)(un * 256 + F.wave * 32) * 4), lr = *(const int4*)(LR + (size_t)(un * 256 + F.wave * 32) * 4); f32x4 tg = *(const f32x4*)(TOPG + (size_t)(un * 256 + F.wave * 32) * 4);
        for (int rr = 0; rr < 32; ++rr) {
            const int m = un * 256 + F.wave * 32 + rr; const int mn = rr < 31 ? m + 1 : m;
            const f32x4* gr = (const f32x4*)g + lane;
#pragma unroll
            for (int j = 0; j < 4; ++j) vn[j] = ld4bf(H1 + (size_t)mn * 1024 + 4 * lane + 256 * j);
            const int4 ten = *(const int4*)(TOPE + (size_t)mn * 4), lrn = *(const int4*)(LR + (size_t)mn * 4); const f32x4 tgn = *(const f32x4*)(TOPG + (size_t)mn * 4);
            float s = 0.f;
#pragma unroll
            for (int j = 0; j < 4; ++j) s += (v[j].x * v[j].x + v[j].y * v[j].y) + (v[j].z * v[j].z + v[j].w * v[j].w);
            const float rstd = 1.0f / sqrtf(wave_sum(s) * (1.f / 1024.f) + EPS);
            unsigned pk[4];
#pragma unroll
            for (int j = 0; j < 4; ++j) { const f32x4 gg = gr[64 * j]; pk[j] = pk4_fp8(v[j].x * rstd * gg.x, v[j].y * rstd * gg.y, v[j].z * rstd * gg.z, v[j].w * rstd * gg.w); }
            int sl[4];
            sl[0] = pst[te.x] + base[te.x] + lr.x; sl[1] = pst[te.y] + base[te.y] + lr.y; sl[2] = pst[te.z] + base[te.z] + lr.z; sl[3] = pst[te.w] + base[te.w] + lr.w;
#pragma unroll
            for (int k = 0; k < 4; ++k) { unsigned* o4 = (unsigned*)((unsigned char*)XBY + (size_t)sl[k] * 1024) + lane;
#pragma unroll
                for (int j = 0; j < 4; ++j) o4[64 * j] = pk[j]; }
            if (lane == 0) { *(int4*)(TOKSLOT + (size_t)m * 4) = make_int4(sl[0], sl[1], sl[2], sl[3]); SLOTG[sl[0]] = tg.x; SLOTG[sl[1]] = tg.y; SLOTG[sl[2]] = tg.z; SLOTG[sl[3]] = tg.w; }
#pragma unroll
            for (int j = 0; j < 4; ++j) v[j] = vn[j];
            te = ten; lr = lrn; tg = tgn;
        }
        __syncthreads();
    }
}

template <bool WITH_MOE>
__device__ __forceinline__ void p_final(Frame& F) {
    const ArgsP A = fresh_args();
    unsigned char* ws = A->ws; const int lane = F.lane;
    float* OUT = A->out; const bf16_t* H1 = (const bf16_t*)(ws + WS_H1B); const float* g = A->in[I_NORM_FINAL_G];
    const int* TOKSLOT = (const int*)(ws + WS_TOKSLOT); const bf16_t* Y = (const bf16_t*)(ws + WS_Y);
    const int gw = F.bid * 8 + F.wave, NGW = F.G * 8;
    const f32x4* gr = (const f32x4*)g + lane;
    f32x4 v[4], vn[4]; unsigned y[4][4], yn[4][4]; int4 sl = make_int4(0, 0, 0, 0), sln = sl;
    if (gw < M) {
        if (WITH_MOE) sl = *(const int4*)(TOKSLOT + (size_t)gw * 4);
#pragma unroll
        for (int j = 0; j < 4; ++j) v[j] = ld4bf(H1 + (size_t)gw * 1024 + 4 * lane + 256 * j);
        if (WITH_MOE) {
            const int sls[4] = {sl.x, sl.y, sl.z, sl.w};
#pragma unroll
            for (int k = 0; k < 4; ++k)
#pragma unroll
                for (int j = 0; j < 4; ++j) y[k][j] = ((const unsigned*)((const unsigned char*)Y + (size_t)sls[k] * 1024) + lane)[64 * j];
            const int m1 = (gw + NGW < M) ? gw + NGW : gw;
            sln = *(const int4*)(TOKSLOT + (size_t)m1 * 4);
        }
    }
    for (int m = gw; m < M; m += NGW) {
        const int m1 = (m + NGW < M) ? m + NGW : m, m2 = (m + 2 * NGW < M) ? m + 2 * NGW : m;
#pragma unroll
        for (int j = 0; j < 4; ++j) vn[j] = ld4bf(H1 + (size_t)m1 * 1024 + 4 * lane + 256 * j);
        int4 sl2 = sln;
        if (WITH_MOE) {
            const int sls[4] = {sln.x, sln.y, sln.z, sln.w};
#pragma unroll
            for (int k = 0; k < 4; ++k)
#pragma unroll
                for (int j = 0; j < 4; ++j) yn[k][j] = ((const unsigned*)((const unsigned char*)Y + (size_t)sls[k] * 1024) + lane)[64 * j];
            sl2 = *(const int4*)(TOKSLOT + (size_t)m2 * 4);
        }
        if (WITH_MOE) {
#pragma unroll
            for (int k = 0; k < 4; ++k)
#pragma unroll
                for (int j = 0; j < 4; ++j) { const int w = (int)y[k][j]; const f32x2 lo = __builtin_amdgcn_cvt_pk_f32_fp8(w, false), hi2 = __builtin_amdgcn_cvt_pk_f32_fp8(w, true); v[j].x += lo.x; v[j].y += lo.y; v[j].z += hi2.x; v[j].w += hi2.y; }
        }
        float s2 = 0.f;
#pragma unroll
        for (int j = 0; j < 4; ++j) s2 += (v[j].x * v[j].x + v[j].y * v[j].y) + (v[j].z * v[j].z + v[j].w * v[j].w);
        const float rstd = 1.0f / sqrtf(wave_sum(s2) * (1.f / 1024.f) + EPS);
        f32x4* xr = (f32x4*)(OUT + (size_t)m * 1024) + lane;
#pragma unroll
        for (int j = 0; j < 4; ++j) xr[64 * j] = v[j] * rstd * gr[64 * j];
#pragma unroll
        for (int j = 0; j < 4; ++j) v[j] = vn[j];
        if (WITH_MOE) {
#pragma unroll
            for (int k = 0; k < 4; ++k)
#pragma unroll
                for (int j = 0; j < 4; ++j) y[k][j] = yn[k][j];
            sln = sl2;
        }
    }
}

#if DSACHECK
__device__ __forceinline__ float fp8_byte_to_f32(unsigned b) { const f32x2 r = __builtin_amdgcn_cvt_pk_f32_fp8((int)b, false); return r.x; }
__device__ __forceinline__ void dsa_check(Frame& F) {
    const ArgsP A = fresh_args(); unsigned char* ws = A->ws; const int lane = F.lane;
    const unsigned char* QL8 = ws + WS_QL; const unsigned char* K8 = ws + WS_KVR; const u64* MASKW = (const u64*)(ws + WS_MASKW);
    const unsigned char* OL8 = ws + WS_OLAT;
    for (int rep = 0; rep < 2; ++rep) {
        const int b = F.bid & 31, i = (F.bid * 613 + rep * 977 + 5) & 2047, h = F.wave;
        const size_t m = (size_t)b * 2048 + i; const int c = i >> 6, nadm = 80 + 64 * c;
        const unsigned char* q = QL8 + m * 1536 + h * 192;
        const float q0 = fp8_byte_to_f32(q[lane]) * (1.0f / QSC), q1 = fp8_byte_to_f32(q[lane + 64]) * (1.0f / QSC), q2 = (lane < 32) ? fp8_byte_to_f32(q[lane + 128]) * (1.0f / QSC) : 0.f;
        const unsigned char* kvb = K8 + (size_t)b * TPB * 192;
        float mx = -3.0e38f;
        for (int pos = 0; pos < nadm; ++pos) {
            const u64 w = MASKW[m * NKT + (pos >> 6)];
            if (!((w >> (pos & 63)) & 1ull)) continue;
            const unsigned char* kr = kvb + (size_t)pos * 192;
            float sdot = q0 * fp8_byte_to_f32(kr[lane]) + q1 * fp8_byte_to_f32(kr[lane + 64]) + ((lane < 32) ? q2 * fp8_byte_to_f32(kr[lane + 128]) : 0.f);
            sdot = wave_sum(sdot); mx = fmaxf(mx, sdot);
        }
        float l = 0.f, o0 = 0.f, o1 = 0.f;
        for (int pos = 0; pos < nadm; ++pos) {
            const u64 w = MASKW[m * NKT + (pos >> 6)];
            if (!((w >> (pos & 63)) & 1ull)) continue;
            const unsigned char* kr = kvb + (size_t)pos * 192;
            const float k0 = fp8_byte_to_f32(kr[lane]), k1 = fp8_byte_to_f32(kr[lane + 64]);
            float sdot = q0 * k0 + q1 * k1 + ((lane < 32) ? q2 * fp8_byte_to_f32(kr[lane + 128]) : 0.f);
            sdot = wave_sum(sdot);
            const float p = exp2f(sdot - mx); l += p; o0 += p * k0; o1 += p * k1;
        }
        o0 /= l; o1 /= l;
        const unsigned char* orow = OL8 + m * 1024 + h * 128;
        const float g0 = fp8_byte_to_f32(orow[lane]) * (1.0f / OLSC), g1 = fp8_byte_to_f32(orow[lane + 64]) * (1.0f / OLSC);
        const float num = wave_sum((g0 - o0) * (g0 - o0) + (g1 - o1) * (g1 - o1)), den = wave_sum(o0 * o0 + o1 * o1);
        if (!(num <= 0.02f * den) && lane == 0) atomicOr((unsigned*)(ws + WS_CTL) + CW_ERR, 2u);
    }
}
#endif
__global__ void __launch_bounds__(512, 2) fwd_kernel(Args args) {
    volatile LAS unsigned* MISC = (volatile LAS unsigned*)((LAS unsigned char*)lds_raw + MISC_OFF);
    for (int u = threadIdx.x; u < 128; u += 512) MISC[u] = 0u;
    __syncthreads();
    XcdBarrier bar = xcd_barrier_post((unsigned*)(fresh_args()->ws + WS_CTL) + CW_BAR, MISC + 8);
    const int G = gridDim.x, bid = blockIdx.x;
#define GRID_BAR() xcd_barrier(bar)

#if DBG_STAGE == 1
    { Frame F = mkframe(); const ArgsP A = fresh_args(); const int gw = bid * 8 + F.wave, NGW = G * 8;
      for (int m = gw; m < M; m += NGW) { const f32x4* xr = (const f32x4*)(A->in[I_X] + (size_t)m * 1024) + F.lane; f32x4* orow = (f32x4*)(A->out + (size_t)m * 1024) + F.lane;
#pragma unroll
          for (int j = 0; j < 4; ++j) orow[64 * j] = xr[64 * j]; } }
    GRID_BAR();
    { Frame F = mkframe(); p_final<false>(F); }
#else
    PH(0) REPBEG(0) { Frame F = mkframe(); p0_prologue(F); } REPEND(0)
    GRID_BAR();
    PH(1) REPBEG(1) {
        Frame F = mkframe(); const ArgsP A = fresh_args(); unsigned char* const ws = A->ws;
        const bool gates_first = ((bid >> 3) & 1) != 0;
#pragma unroll 1
        for (int hf = 0; hf < 2; ++hf) {
            if ((hf == 0) != gates_first) {
                pg8::DenseSched S; S.init(ws + WS_XN, ws + WS_WIN_T, M, 2048, 1024, G, bid);
                EpiProj E{(bf16_t*)(ws + WS_QA), (bf16_t*)(ws + WS_KA), (bf16_t*)(ws + WS_VA), (bf16_t*)(ws + WS_CQ), (bf16_t*)(ws + WS_SGA), (bf16_t*)(ws + WS_SGB), (float*)(ws + WS_T7)};
                pg8::gemm_phase<EpiProj, pg8::DenseSched, true, true>(F.lds, 1024, S, E);
            } else {
                pg8::DenseSched S; S.init(ws + WS_XN8, ws + WS_WIN8, M, 2048, 512, G, bid);
                EpiGate E{(bf16_t*)(ws + WS_SGA), (bf16_t*)(ws + WS_SGB)};
                int k8 = 512; asm volatile("" : "+s"(k8));
                pg8::gemm_phase<EpiGate, pg8::DenseSched, true, true, true>(F.lds, k8, S, E);
            }
        }
    } REPEND(1)
    GRID_BAR();
    PH(2) REPBEG(2) { Frame F = mkframe(); p2_post(F); } REPEND(2)
    GRID_BAR();
    PH(3) REPBEG(3) {
        Frame F = mkframe(); const ArgsP A = fresh_args(); unsigned char* const ws = A->ws;
        pg8::DenseSched S; S.init(ws + WS_CQ, ws + WS_WQ2_T, M, 1536, 256, G, bid);
        EpiQ E{(bf16_t*)(ws + WS_QL), (bf16_t*)(ws + WS_QIDX), (const float*)(ws + WS_RSTDQ), (const float*)(ws + WS_COS), (const float*)(ws + WS_SIN)};
        int kq = 256; asm volatile("" : "+s"(kq));
        pg8::gemm_phase<EpiQ, pg8::DenseSched, true, true>(F.lds, kq, S, E);
        vt8_build(F);
    } REPEND(3)
    GRID_BAR();
    PH(4) REPBEG(4) { Frame F = mkframe(); for (int p = bid; p < 1024; p += G) {
        const int bh = p >> 2, s = p & 3;
        fox_unit(F, bh >> 3, bh & 7, s);
        fox_unit(F, bh >> 3, bh & 7, 7 - s);
    } } REPEND(4)
    PH(5) REPBEG(5) { Frame F = mkframe(); for (int p = bid; p < 2048; p += G) {
        const int g16 = p & 3, cc = (p >> 2) & 15, b = p >> 6;
        idx_unit(F, b, cc, g16);
        idx_unit(F, b, 31 - cc, g16);
    } } REPEND(5)
    GRID_BAR();
    PH(6) REPBEG(6) { Frame F = mkframe(); for (int p = bid; p < 1024; p += G) {
        int half = p & 1, cc = (p >> 1) & 15, b = p >> 5;
        if (G == 256) { const int r = bid >> 3, k2 = p >> 8; b = (bid & 7) + 8 * k2; cc = r >> 1; half = r & 1; }
        dsa_unit(F, b, cc, half);
        dsa_unit(F, b, 31 - cc, half);
    } } REPEND(6)
    GRID_BAR();
#if DSACHECK
    { Frame F = mkframe(); dsa_check(F); }
#endif
    PH(7) {
        Frame F = mkframe(); const ArgsP A = fresh_args(); unsigned char* const ws = A->ws;
        pg8::DenseSched S; S.init(ws + WS_OA, ws + WS_WA_T, M, 1024, 512, G, bid);
        EpiBranch<false> E{(bf16_t*)(ws + WS_SGA), nullptr, 1.0f};
        pg8::gemm_phase<EpiBranch<false>, pg8::DenseSched, true, true>(F.lds, 512, S, E);
    }
    PH(8) {
        Frame F = mkframe(); const ArgsP A = fresh_args(); unsigned char* const ws = A->ws;
        pg8::DenseSched S; S.init(ws + WS_OLAT, ws + WS_WOB_T, M, 1024, 512, G, bid);
        EpiBranch<true> E{(bf16_t*)(ws + WS_SGA), (const bf16_t*)(ws + WS_SGB), 1.0f / (WSC * OLSC)};
        int k8 = 512; asm volatile("" : "+s"(k8));
        pg8::gemm_phase<EpiBranch<true>, pg8::DenseSched, true, true, true>(F.lds, k8, S, E);
    }
    GRID_BAR();
    PH(9) REPBEG(9) {
        Frame F = mkframe(); const ArgsP A = fresh_args(); unsigned char* const ws = A->ws;
        pg8::DenseSched S; S.init(ws + WS_SGA, ws + WS_WOUT_T, M, 1024, 1024, G, bid);
        EpiOut E{A->in[I_X], (bf16_t*)(A->ws + WS_H1B)};
        pg8::gemm_phase<EpiOut, pg8::DenseSched, true, true>(F.lds, 1024, S, E);
    } REPEND(9)
    GRID_BAR();
#if DBG_STAGE == 2
    { Frame F = mkframe(); p_final<false>(F); }
#else
    PH(10) REPBEG(10) {
        Frame F = mkframe(); const ArgsP A = fresh_args(); unsigned char* const ws = A->ws;
        LAS float* scr = (LAS float*)(F.lds + F.wave * 16384);
        const int gw = bid * 8 + F.wave, NGW = G * 8;
        constexpr int I_GU = 16 * 32, I_D = 16 * 16;
        const float* w_gu = A->in[I_W_GU]; const float* w_dn = A->in[I_W_DOWN]; const int lane = F.lane;
        LAS float* scr2 = (LAS float*)(F.lds + F.wave * 17408);
        int ncv = (P8REP & 1) ? 2 : 1; asm volatile("" : "+s"(ncv));
        for (int rcv = 0; rcv < ncv; ++rcv)
        tr2_run(gw, NGW, 32 * (I_GU + I_D), scr2, lane, [&](int it) {
            TrItem2 t; const int e = it / (I_GU + I_D); int r = it % (I_GU + I_D);
            if (r < I_GU) { t.W = w_gu + (size_t)e * 1024 * 2048; t.WT = ws + WS_WGU_T + (size_t)e * 2048 * 1024; t.K = 1024; t.N = 2048; t.dr0 = (r % 32) * 64; t.k0 = (r / 32) * 64; t.sc0 = MapGU()(t.dr0); return t; }
            r -= I_GU; t.W = w_dn + (size_t)e * 1024 * 1024; t.WT = ws + WS_WD_T + (size_t)e * 1024 * 1024; t.K = 1024; t.N = 1024; t.dr0 = (r % 16) * 64; t.k0 = (r / 16) * 64; t.sc0 = t.dr0; return t; });
        __syncthreads();
        { int nrt = (P8REP & 2) ? 2 : 1; asm volatile("" : "+s"(nrt)); for (int rrt = 0; rrt < nrt; ++rrt) { p8_router(F); __syncthreads(); } }
    } REPEND(10)
    GRID_BAR();
    PH(11) REPBEG(11) { Frame F = mkframe(); p9_slots(F); } REPEND(11)
    GRID_BAR();
    PH(12) {
        Frame F = mkframe(); const ArgsP A = fresh_args(); unsigned char* const ws = A->ws;
        const int* GRP = (const int*)(ws + WS_GRP);
        const int ng = __builtin_amdgcn_readfirstlane(ld_agent_i(GRP));
        LAS int* te_lds = (LAS int*)(F.lds + 131072);
        { const int ntl = __builtin_amdgcn_readfirstlane(ld_agent_i(GRP + 1));
          for (int i2 = F.tid; i2 < ntl; i2 += 512) te_lds[i2] = ld_agent_i((const int*)(ws + WS_TILEE) + i2);
          __syncthreads(); }
        for (int gi = 0; gi < ng; ++gi) {
            const int t_lo = __builtin_amdgcn_readfirstlane(ld_agent_i(GRP + 4 + gi)), t_hi = __builtin_amdgcn_readfirstlane(ld_agent_i(GRP + 4 + MAXG + gi));
            {
                pg8::GroupSched<8, 1024> S; S.A = (const char*)(ws + WS_XBY); S.Bt = (const char*)(ws + WS_WGU_T);
                S.tile_e = te_lds; S.t_lo = t_lo; S.a_t0 = 0; S.nun = (t_hi - t_lo) * 8; S.G = G; S.c = bid;
                EpiGateUp E{(bf16_t*)(ws + WS_ACT), A->in[I_B_GU], t_lo};
                int nr_ = NREP(14); asm volatile("" : "+s"(nr_));
                int k8 = 512; asm volatile("" : "+s"(k8));
                for (int rp = 0; rp < nr_; ++rp) { pg8::gemm_phase<EpiGateUp, pg8::GroupSched<8, 1024>, true, true, true>(F.lds, 512, S, E); if (rp + 1 < nr_) GRID_BAR(); }
            }
            GRID_BAR();
            {
                pg8::GroupSched<4, 1024> S; S.A = (const char*)(ws + WS_ACT); S.Bt = (const char*)(ws + WS_WD_T);
                S.tile_e = te_lds; S.t_lo = t_lo; S.a_t0 = t_lo; S.nun = (t_hi - t_lo) * 4; S.G = G; S.c = bid;
                EpiDown E{(bf16_t*)(ws + WS_Y), A->in[I_B_DOWN], (const float*)(ws + WS_SLOTG)};
                int nr_ = NREP(15); asm volatile("" : "+s"(nr_));
                int k8 = 512; asm volatile("" : "+s"(k8));
                for (int rp = 0; rp < nr_; ++rp) { pg8::gemm_phase<EpiDown, pg8::GroupSched<4, 1024>, true, true, true>(F.lds, 512, S, E); if (rp + 1 < nr_) GRID_BAR(); }
            }
            GRID_BAR();
        }
    }
    PH(13) { Frame F = mkframe(); p_final<true>(F); }
#if SELCHECK || DSACHECK
    GRID_BAR();
    { const ArgsP A = fresh_args(); if (ld_agent((const unsigned*)(A->ws + WS_CTL) + CW_ERR) != 0u) { for (size_t i2 = (size_t)blockIdx.x * 512 + threadIdx.x; i2 < (size_t)M * 1024; i2 += (size_t)gridDim.x * 512) A->out[i2] = 1.0e30f; } }
#endif
#endif
#endif
}

extern "C" void kernel_launch(void* const* d_in, const int* in_sizes, int n_in, void* d_out, int out_size, void* d_ws, size_t ws_size, hipStream_t stream) {
    static int grid = 0;
    if (grid == 0) {
        if (n_in != 24 || out_size != M * DM || ws_size < WS_END) { fprintf(stderr, "kernel_launch: unexpected shapes: n_in %d out %d ws %zu\n", n_in, out_size, ws_size); grid = -1; return; }
        int dev = 0, cus = 0, per_cu = 0;
        if (hipGetDevice(&dev) != hipSuccess || hipDeviceGetAttribute(&cus, hipDeviceAttributeMultiprocessorCount, dev) != hipSuccess) { grid = -1; return; }
        if (hipFuncSetAttribute((const void*)fwd_kernel, hipFuncAttributeMaxDynamicSharedMemorySize, LDS_BYTES) != hipSuccess) { fprintf(stderr, "kernel_launch: hipFuncSetAttribute failed\n"); grid = -1; return; }
        if (hipOccupancyMaxActiveBlocksPerMultiprocessor(&per_cu, (const void*)fwd_kernel, 512, LDS_BYTES) != hipSuccess || per_cu < 1) { fprintf(stderr, "kernel_launch: occupancy query says %d\n", per_cu); }
        (void)hipGetLastError();
        grid = cus;
    }
    if (grid < 0) return;
    (void)hipMemsetAsync((char*)d_ws + WS_CTL, 0, CTL_ZERO_BYTES, stream);
    Args a{};
    for (int i = 0; i < 24; ++i) a.in[i] = (const float*)d_in[i];
    a.out = (float*)d_out; a.ws = (unsigned char*)d_ws; a.ph_lo = 0; a.ph_hi = 0;
    hipLaunchKernelGGL(fwd_kernel, dim3(grid), dim3(512), LDS_BYTES, stream, a);
}
```

```cpp
#include <hip/hip_runtime.h>
#include <cstdio>
#include <cstdint>
#include <type_traits>

#ifndef PHM
#define PHM 0xFFFFF
#endif
#define PH(k) if ((PHM >> (k)) & 1)
#ifndef REPM
#define REPM 0
#endif
#ifndef IDXREP
#define IDXREP 0
#endif
#ifndef SELHIST
#define SELP0 1
#define SELHIST 1
#endif
#ifndef P8REP
#define P8REP 0
#endif
#ifndef DSABL
#define DSABL 0
#endif
#ifndef DSACHECK
#define DSACHECK 0
#endif
#ifndef SELCHECK
#define SELCHECK 0
#endif
#define NREP(k) (((REPM >> (k)) & 1) ? 2 : 1)
#if REPM
#define REPBEG(k) { int nrep_ = NREP(k); asm volatile("" : "+s"(nrep_)); _Pragma("unroll 1") for (int rep_ = 0; rep_ < nrep_; ++rep_) {
#define REPEND(k) if (rep_ + 1 < nrep_) GRID_BAR(); } }
#else
#define REPBEG(k) {
#define REPEND(k) }
#endif
#ifndef DBG_STAGE
#define DBG_STAGE 3
#endif

#define GAS __attribute__((address_space(1)))
#define LAS __attribute__((address_space(3)))
typedef unsigned short bf16_t;
typedef short bf16x8 __attribute__((ext_vector_type(8)));
typedef short s16x4 __attribute__((ext_vector_type(4)));
typedef float f32x4 __attribute__((ext_vector_type(4)));
typedef float f32x2 __attribute__((ext_vector_type(2)));
typedef float f32x16 __attribute__((ext_vector_type(16)));
typedef unsigned u32x4 __attribute__((ext_vector_type(4)));
typedef unsigned u32x2 __attribute__((ext_vector_type(2)));
typedef __bf16 bf16x2_t __attribute__((ext_vector_type(2)));
typedef unsigned long long u64;

constexpr int NB = 32, SEQ = 2048, DM = 1024, NMETA = 16;
constexpr int M = NB * SEQ;
constexpr int TPB = 2112;
constexpr int NKT = 33;
constexpr int D_IN = 4076;
constexpr int NEXP = 32;
constexpr float EPS = 1e-6f;
constexpr float LOG2E = 1.4426950408889634f;
constexpr float FOX_C = 0.125f * LOG2E;
constexpr float DSA_C = 0.10206207261596575f * LOG2E;
constexpr float NEGBIG = -1.0e30f;

constexpr size_t MiB = 1u << 20;
constexpr size_t WS_CTL = 0, CTL_ZERO_BYTES = 1 * MiB;
constexpr size_t WS_TOPE = 1 * MiB, WS_TOPG = 2 * MiB, WS_LR = 3 * MiB, WS_TOKSLOT = 4 * MiB, WS_SLOTG = 5 * MiB;
constexpr size_t WS_BC = 6 * MiB + 512 * 1024, WS_TILEE = 6 * MiB + 768 * 1024, WS_GRP = 7 * MiB;
constexpr size_t WS_WIN_T = 16 * MiB, WS_WQ2_T = 24 * MiB, WS_WA_T = 25 * MiB, WS_WOB_T = 26 * MiB, WS_WOUT_T = 28 * MiB;
constexpr size_t WS_COS = 30 * MiB, WS_SIN = 30 * MiB + 256 * 1024, WS_PROJM = 30 * MiB + 512 * 1024, WS_RSTDQ = 30 * MiB + 768 * 1024;
constexpr size_t WS_IW = 31 * MiB, WS_BIAS = 32 * MiB, WS_MASKW = 35 * MiB;
constexpr size_t WS_OA = 408 * MiB;
constexpr size_t WS_XN = 52 * MiB, WS_OLAT = 52 * MiB, WS_QA = 180 * MiB, WS_KA = 244 * MiB, WS_VA = 310 * MiB, WS_CQ = 376 * MiB, WS_T7 = 408 * MiB;
constexpr size_t WS_XN8 = 950 * MiB, WS_WIN8 = 1014 * MiB;
constexpr size_t WS_VT8 = 888 * MiB;
constexpr size_t WS_SGA = 472 * MiB, WS_SGB = 600 * MiB, WS_KVR = 728 * MiB, WS_KIDX = 749 * MiB, WS_QIDX = 758 * MiB, WS_QL = 790 * MiB;
constexpr size_t WS_WGU_T = 16 * MiB, WS_WD_T = 80 * MiB, WS_XBY = 112 * MiB, WS_Y = WS_XBY  , WS_H1B = 600 * MiB  , WS_ACT = 728 * MiB, WS_END = 1024 * MiB;
constexpr float WSC = 32.0f, WSC_INV = 1.0f / 32.0f;
constexpr float QSC = 16.0f;
constexpr float PSC = 128.0f;
constexpr float OLSC = 16.0f;
constexpr int MAX_TILES = 1064;
constexpr int ACT_CAP_TILES = (int)((WS_END - WS_ACT) / (256 * 1024));
constexpr int MAXG = 8;
static_assert(WS_XBY + (size_t)MAX_TILES * 256 * 1024 <= WS_H1B && WS_H1B + (size_t)M * 2048 <= WS_ACT && WS_ACT + (size_t)MAX_TILES * 256 * 1024 <= WS_END && ACT_CAP_TILES >= MAX_TILES, "XBY/H1B/ACT");
static_assert(WS_MASKW + (size_t)M * NKT * 8 <= WS_XN, "maskw");
static_assert(WS_QL + (size_t)M * 1536 <= WS_VT8 && WS_VT8 + (size_t)NB * NKT * 128 * 64 <= WS_XN8 && WS_KVR + (size_t)NB * TPB * 192 <= WS_KIDX, "ql8 / vt8 / k8");

constexpr int CW_BAR = 4096;
constexpr int CW_KMAX = 1024;
constexpr int CW_ERR = 64;

constexpr int LDS_BYTES = 147456;
constexpr int MISC_OFF = LDS_BYTES - 512;

__device__ __forceinline__ unsigned pk2(float lo, float hi) { f32x2 v = {lo, hi}; bf16x2_t b = __builtin_convertvector(v, bf16x2_t); return __builtin_bit_cast(unsigned, b); }
__device__ __forceinline__ unsigned pk4_fp8(float a, float b, float c, float d) { int w = __builtin_amdgcn_cvt_pk_fp8_f32(a, b, 0, false); w = __builtin_amdgcn_cvt_pk_fp8_f32(c, d, w, true); return (unsigned)w; }
__device__ __forceinline__ float bf2f(unsigned short x) { return __uint_as_float((unsigned)x << 16); }
__device__ __forceinline__ float bflo(unsigned w) { return __uint_as_float(w << 16); }
__device__ __forceinline__ float bfhi(unsigned w) { return __uint_as_float(w & 0xffff0000u); }
__device__ __forceinline__ f32x4 ld4bf(const bf16_t* p) { const u32x2 w = *(const u32x2*)p; return (f32x4){bflo(w.x), bfhi(w.x), bflo(w.y), bfhi(w.y)}; }
template <int CTRL, int RM> __device__ __forceinline__ float dpp_addf(float v) { return v + __int_as_float(__builtin_amdgcn_update_dpp(0, __float_as_int(v), CTRL, RM, 0xf, false)); }
__device__ __forceinline__ float wave_sum(float v) {
    v = dpp_addf<0x111, 0xf>(v); v = dpp_addf<0x112, 0xf>(v); v = dpp_addf<0x114, 0xf>(v); v = dpp_addf<0x118, 0xf>(v);
    v = dpp_addf<0x142, 0xa>(v); v = dpp_addf<0x143, 0xc>(v);
    return __int_as_float(__builtin_amdgcn_readlane(__float_as_int(v), 63));
}
__device__ __forceinline__ float wave_max(float v) {
#pragma unroll
    for (int o = 1; o < 64; o <<= 1) v = fmaxf(v, __shfl_xor(v, o));
    return v;
}
__device__ __forceinline__ float fast_exp2(float x) { return __builtin_amdgcn_exp2f(x); }
__device__ __forceinline__ float fast_rcp(float x) { return __builtin_amdgcn_rcpf(x); }
__device__ __forceinline__ float sigmoidf_(float x) { return fast_rcp(1.0f + fast_exp2(-x * LOG2E)); }
__device__ __forceinline__ float log_sigmoidf_(float x) { return fminf(x, 0.f) - 0.6931471805599453f * __builtin_amdgcn_logf(1.0f + fast_exp2(-fabsf(x) * LOG2E)); }
__device__ __forceinline__ int crow(int r, int hi) { return (r & 3) + 8 * (r >> 2) + 4 * hi; }
__device__ __forceinline__ unsigned ld_agent(const unsigned* p) { return __hip_atomic_load(p, __ATOMIC_RELAXED, __HIP_MEMORY_SCOPE_AGENT); }
__device__ __forceinline__ int ld_agent_i(const int* p) { return (int)__hip_atomic_load((const unsigned*)p, __ATOMIC_RELAXED, __HIP_MEMORY_SCOPE_AGENT); }
#define LDS_WAIT() asm volatile("s_waitcnt lgkmcnt(0)" ::: "memory")

#define XB_TMO      128
#define XB_XCNT(j)  (256  + 64 * (j))
#define XB_XSUB(j)  (1280 + 64 * (j))
#define XB_XGEN(j)  (2304 + 64 * (j))
#define XB_TOP      3328
#define XB_TOPGEN   3392
#define XCD_BAR_WORDS 3456
#define XB_SPIN_CAP (1u << 24)
__device__ __forceinline__ unsigned xb_ld(unsigned* p)              { return __hip_atomic_load(p, __ATOMIC_RELAXED, __HIP_MEMORY_SCOPE_AGENT); }
__device__ __forceinline__ unsigned xb_add(unsigned* p, unsigned v) { return __hip_atomic_fetch_add(p, v, __ATOMIC_RELAXED, __HIP_MEMORY_SCOPE_AGENT); }
__device__ __forceinline__ unsigned xb_xcc_id() { return (unsigned)__builtin_amdgcn_s_getreg((3 << 11) | 20) & 0xFu; }
#define XB_SPIN(cond, bar) do { unsigned _sp = 0; while (cond) { __builtin_amdgcn_s_sleep(1); \
    if ((++_sp & 255u) == 0u) { if (xb_ld(&(bar)[XB_TMO])) break; if (_sp > XB_SPIN_CAP) { atomicAdd(&(bar)[XB_TMO], 1u); break; } } } } while (0)
struct XcdBarrier { unsigned* bar; unsigned x; volatile LAS unsigned* st; };
__device__ __forceinline__ XcdBarrier xcd_barrier_post(unsigned* bar, volatile LAS unsigned* st) {
    XcdBarrier b; b.bar = bar; b.x = xb_xcc_id(); b.st = st;
    if (threadIdx.x == 0) (void)xb_add(&bar[XB_XCNT(b.x)], 1u);
    return b;
}
__device__ __forceinline__ void xcd_barrier_complete(unsigned* bar, unsigned x, unsigned& nloc, unsigned& nx) {
    const unsigned G = gridDim.x * gridDim.y * gridDim.z;
    unsigned sum, cnt, mine, sp = 0u;
    for (;;) {
        sum = 0u; cnt = 0u; mine = 0u;
#pragma unroll 1
        for (unsigned j = 0; j < 16; ++j) { const unsigned c = xb_ld(&bar[XB_XCNT(j)]); sum += c; cnt += (c > 0u) ? 1u : 0u; mine = (j == x) ? c : mine; }
        if (sum == G) break;
        __builtin_amdgcn_s_sleep(1);
        if ((++sp & 255u) == 0u) { if (xb_ld(&bar[XB_TMO])) break; if (sp > XB_SPIN_CAP) { atomicAdd(&bar[XB_TMO], 1u); break; } }
    }
    nloc = mine > 0u ? mine : 1u; nx = cnt > 0u ? cnt : 1u;
}
__device__ __forceinline__ void xcd_barrier(const XcdBarrier& b) {
    asm volatile("s_waitcnt vmcnt(0)" ::: "memory");
    __syncthreads();
    if (threadIdx.x == 0) {
        unsigned* bar = b.bar;
        __builtin_amdgcn_s_waitcnt(0);
        unsigned nloc = b.st[0], nx = b.st[1];
        if (nloc == 0u) { xcd_barrier_complete(bar, b.x, nloc, nx); b.st[0] = nloc; b.st[1] = nx; }
        const unsigned old = xb_add(&bar[XB_XSUB(b.x)], 1u);
        const unsigned gen = old / nloc;
        if (old + 1u == (gen + 1u) * nloc) {
            __builtin_amdgcn_fence(__ATOMIC_RELEASE, "agent");
            asm volatile("s_waitcnt vmcnt(0)" ::: "memory");
            const unsigned og = xb_add(&bar[XB_TOP], 1u);
            const unsigned tg = og / nx;
            if (og + 1u == (tg + 1u) * nx) xb_add(&bar[XB_TOPGEN], 1u);
            else XB_SPIN(xb_ld(&bar[XB_TOPGEN]) == tg, bar);
            __builtin_amdgcn_fence(__ATOMIC_ACQUIRE, "agent");
            xb_add(&bar[XB_XGEN(b.x)], 1u);
            asm volatile("s_waitcnt vmcnt(0)" ::: "memory");
        } else {
            XB_SPIN(xb_ld(&bar[XB_XGEN(b.x)]) == gen, bar);
            __builtin_amdgcn_fence(__ATOMIC_ACQUIRE, "agent");
            asm volatile("s_waitcnt vmcnt(0)" ::: "memory");
        }
    }
    __syncthreads();
}

__device__ __forceinline__ int tid_fresh() { int t = threadIdx.x; asm volatile("" : "+v"(t)); return t; }
namespace pg8 {
constexpr int BM = 256, BK = 64, HALF = 128, HTB = HALF * BK * 2, STAGE_BYTES = 8 * HTB, NXCD = 8, WGM = 8;
__host__ __device__ __forceinline__ int lds_byte(int r, int c) { const int st = (r >> 4) * 2 + (c >> 5), rr = r & 15, cc = c & 31, ob = rr * 64 + cc * 2; return st * 1024 + (ob ^ (((ob >> 9) & 1) << 5)); }
__host__ __device__ __forceinline__ void stage_rc(int b, int& R, int& C) { const int st = b / 1024, sb = b % 1024, swz = sb ^ (((sb >> 9) & 1) << 5); R = (st >> 1) * 16 + swz / 64; C = (st & 1) * 32 + (swz % 64) / 2; }
__host__ __device__ __forceinline__ int perm32(int rho) { const int n = rho >> 4, i = rho & 15; return 8 * (i >> 2) + 4 * n + (i & 3); }
struct Unit { int pm, pn, aux; };

struct DenseSched {
    const char* A; const char* Bt; size_t tstep; int nM, nN, nwg, G, c;
    __device__ __forceinline__ void init(const void* A_, const void* Bt_, int Mrows, int N, int K, int G_, int c_) { A = (const char*)A_; Bt = (const char*)Bt_; tstep = (size_t)BM * K * 2; nM = Mrows / BM; nN = N / BM; nwg = nM * nN; G = G_; c = c_; }
    __device__ __forceinline__ bool next(int i, Unit& u) const {
        const long L = (long)i * G + c; if (L >= nwg) return false;
        int wgid = (int)L; { const int q = nwg / NXCD, r = nwg % NXCD, xcd = wgid % NXCD, off = wgid / NXCD; wgid = (xcd < r ? xcd * (q + 1) : r * (q + 1) + (xcd - r) * q) + off; }
        const int nig = WGM * nN, gid = wgid / nig, fm = gid * WGM, gsz = (nM - fm) < WGM ? (nM - fm) : WGM;
        u.pm = fm + ((wgid % nig) % gsz); u.pn = (wgid % nig) / gsz; u.aux = 0; return true;
    }
    __device__ __forceinline__ const char* a_ptr(const Unit& u) const { return A + (size_t)u.pm * tstep; }
    __device__ __forceinline__ const char* b_ptr(const Unit& u) const { return Bt + (size_t)u.pn * tstep; }
};
template <int nN, int ROWB> struct GroupSched {
    static constexpr size_t tstep = (size_t)256 * ROWB, estride = (size_t)nN * tstep;
    const char* A; const char* Bt; const LAS int* tile_e; int t_lo, a_t0, nun, G, c;
    __device__ __forceinline__ bool next(int i, Unit& u) const {
        int t, pn;
        if ((G & 7) == 0) {
            const int x = c & 7, r = c >> 3, W = G >> 3;
            const int q = i * W + r; t = x + 8 * (q / nN); pn = q % nN;
            if (t * nN >= nun) return false;
        } else {
            const long L = (long)i * G + c; if (L >= nun) return false;
            t = (int)(L / nN); pn = (int)(L % nN);
        }
        u.pm = t_lo + t; u.pn = pn;
        u.aux = __builtin_amdgcn_readfirstlane(tile_e[u.pm]); return true;
    }
    __device__ __forceinline__ const char* a_ptr(const Unit& u) const { return A + (size_t)(u.pm - a_t0) * tstep; }
    __device__ __forceinline__ const char* b_ptr(const Unit& u) const { return Bt + (size_t)u.aux * estride + (size_t)u.pn * tstep; }
};

typedef int v8i_t __attribute__((ext_vector_type(8)));
typedef int v4i_t __attribute__((ext_vector_type(4)));
template <class E, class = void> struct Perm64Of { static constexpr bool v = false; };
template <class E> struct Perm64Of<E, std::void_t<decltype(E::PERM64)>> { static constexpr bool v = E::PERM64; };
template <class Epi, class Sched, bool ALIGN_EPI, bool SP2, bool FP8 = false>
__device__ __forceinline__ void gemm_phase(LAS unsigned char* lds, const int K, const Sched& S, const Epi& E) {
    const int tid = tid_fresh(), wid = __builtin_amdgcn_readfirstlane(tid >> 6), lane = tid & 63, wr = wid >> 2, wc = wid & 3, fr = lane & 15, fq = lane >> 4;
    const int nt = K / BK;
    unsigned voffA[2], voffB[2];
    constexpr bool P64 = Perm64Of<Epi>::v;
#pragma unroll
    for (int i = 0; i < 2; ++i) { int R, C; stage_rc(tid * 16 + i * 8192, R, C); const int p32 = perm32(R & 31);
        const int Rb = P64 ? ((R >> 5) * 64 + 16 * (p32 >> 3) + (p32 & 7)) : (Epi::PERM ? ((R & ~31) + p32) : R);
        voffA[i] = (unsigned)(R * K + C) * 2u; voffB[i] = (unsigned)(Rb * K + C) * 2u; }
    const size_t kstep = (size_t)(BK * 2);
    const size_t hstep = (size_t)HALF * K * 2;
    const size_t hstepB = P64 ? (size_t)8 * K * 2 : hstep;
    const unsigned ldsw = (unsigned)wid * 1024u;
    const int aoff = lds_byte(wr * 64 + fr, fq * 8), boff = lds_byte(wc * 32 + fr, fq * 8);
#define PG8_SA(b, h) (((b) * 2 + (h)) * HTB)
#define PG8_SB(b, h) ((4 + (b) * 2 + (h)) * HTB)
#define PG8_STAGE(bufoff, gbase, voff) do { _Pragma("unroll") for (int _i = 0; _i < 2; ++_i) \
        __builtin_amdgcn_global_load_lds((const unsigned*)((const char*)(gbase) + (voff)[_i]), (LAS unsigned*)(lds + (bufoff) + ldsw + _i * 8192), 16, 0, 0); } while (0)
#define PG8_LD8(p) __builtin_shufflevector(*(const LAS v4i_t*)(p), *(const LAS v4i_t*)((p) + 1024), 0, 1, 2, 3, 4, 5, 6, 7)
#define PG8_LDA(dst, b, h) do { if constexpr (FP8) { _Pragma("unroll") for (int m = 0; m < 4; ++m) dst##8[m] = PG8_LD8(lds + PG8_SA(b, h) + aoff + m * 2048); } \
        else { _Pragma("unroll") for (int m = 0; m < 4; ++m) _Pragma("unroll") for (int k = 0; k < 2; ++k) dst[m][k] = *(const LAS bf16x8*)(lds + PG8_SA(b, h) + aoff + m * 2048 + k * 1024); } } while (0)
#define PG8_LDB(dst, b, h) do { if constexpr (FP8) { _Pragma("unroll") for (int n = 0; n < 2; ++n) dst##8[n] = PG8_LD8(lds + PG8_SB(b, h) + boff + n * 2048); } \
        else { _Pragma("unroll") for (int n = 0; n < 2; ++n) _Pragma("unroll") for (int k = 0; k < 2; ++k) dst[n][k] = *(const LAS bf16x8*)(lds + PG8_SB(b, h) + boff + n * 2048 + k * 1024); } } while (0)
#define PG8_CAT(x) __builtin_shufflevector(__builtin_bit_cast(v4i_t, (x)[0]), __builtin_bit_cast(v4i_t, (x)[1]), 0, 1, 2, 3, 4, 5, 6, 7)
#define PG8_MMA(ai, bj, At, Bt) do { __builtin_amdgcn_s_setprio(1); \
        if constexpr (FP8) { _Pragma("unroll") for (int m = 0; m < 4; ++m) _Pragma("unroll") for (int n = 0; n < 2; ++n) \
            asm volatile("v_mfma_scale_f32_16x16x128_f8f6f4 %0, %1, %2, %0, %3, %3 op_sel_hi:[0,0,0]" : "+v"(acc[ai][bj][m][n]) : "v"(Bt##8[n]), "v"(At##8[m]), "v"(sc1)); } \
        else { _Pragma("unroll") for (int m = 0; m < 4; ++m) _Pragma("unroll") for (int n = 0; n < 2; ++n) _Pragma("unroll") for (int k = 0; k < 2; ++k) \
            acc[ai][bj][m][n] = __builtin_amdgcn_mfma_f32_16x16x32_bf16(Bt[n][k], At[m][k], acc[ai][bj][m][n], 0, 0, 0); } \
        __builtin_amdgcn_s_setprio(0); } while (0)
#define PG8_WAIT_V(n) asm volatile("s_waitcnt vmcnt(" #n ")" ::: "memory")
#define PG8_WAIT_L(n) asm volatile("s_waitcnt lgkmcnt(" #n ")" ::: "memory")
#define PG8_BAR __builtin_amdgcn_s_barrier()
#define PG8_SCHED __builtin_amdgcn_sched_barrier(0)
    Unit cur, nxt; int ui = 0;
    if (!S.next(0, cur)) return;
    typename Epi::Pre pre;
    f32x4 acc[2][2][4][2];
#pragma unroll
    for (int a = 0; a < 2; ++a)
#pragma unroll
        for (int b = 0; b < 2; ++b)
#pragma unroll
            for (int m = 0; m < 4; ++m)
#pragma unroll
                for (int n = 0; n < 2; ++n) acc[a][b][m][n] = (f32x4){0.f, 0.f, 0.f, 0.f};
    bf16x8 At[4][2], B0[2][2], B1[2][2]; v8i_t At8[4], B08[2], B18[2];
    int sc1 = 0x7f7f7f7f; asm volatile("" : "+v"(sc1));
    const char* cA = S.a_ptr(cur); const char* cB = S.b_ptr(cur);
    if constexpr (SP2) {
        PG8_STAGE(PG8_SB(0, 0), cB, voffB); PG8_STAGE(PG8_SB(0, 1), cB + hstepB, voffB); PG8_STAGE(PG8_SA(0, 0), cA, voffA); PG8_STAGE(PG8_SA(0, 1), cA + hstep, voffA);
        if (wr == 1) PG8_BAR;
        PG8_WAIT_V(2); PG8_BAR;
        PG8_STAGE(PG8_SB(1, 0), cB + kstep, voffB); PG8_STAGE(PG8_SA(1, 0), cA + kstep, voffA); PG8_STAGE(PG8_SB(1, 1), cB + hstepB + kstep, voffB);
        PG8_WAIT_V(6); PG8_BAR;
    } else {
        PG8_STAGE(PG8_SB(0, 0), cB, voffB); PG8_STAGE(PG8_SA(0, 0), cA, voffA); PG8_STAGE(PG8_SB(0, 1), cB + hstepB, voffB); PG8_STAGE(PG8_SA(0, 1), cA + hstep, voffA);
        if (wr == 1) PG8_BAR;
        PG8_WAIT_V(4); PG8_BAR;
        PG8_STAGE(PG8_SB(1, 0), cB + kstep, voffB); PG8_STAGE(PG8_SA(1, 0), cA + kstep, voffA); PG8_STAGE(PG8_SB(1, 1), cB + hstepB + kstep, voffB);
        PG8_WAIT_V(6); PG8_BAR;
    }
    for (;;) {
        const bool has_next = S.next(ui + 1, nxt);
        const char* nA = has_next ? S.a_ptr(nxt) : cA; const char* nB = has_next ? S.b_ptr(nxt) : cB;
#pragma unroll 1
        for (int t = 0; t < nt; t += 2) {
            const bool last = (t == nt - 2);
            if (last) E.preload(cur, wr, wc, fr, fq, pre);
            const char* a1 = cA + (size_t)(t + 1) * kstep;
            const char* a2 = last ? nA : cA + (size_t)(t + 2) * kstep; const char* b2 = last ? nB : cB + (size_t)(t + 2) * kstep;
            const char* a3 = a2 + kstep; const char* b3 = b2 + kstep;
            if constexpr (SP2) {
            PG8_LDB(B0, 0, 0); PG8_LDB(B1, 0, 1); PG8_SCHED; PG8_LDA(At, 0, 0); PG8_STAGE(PG8_SA(1, 1), a1 + hstep, voffA);
            PG8_WAIT_V(8); PG8_WAIT_L(0); PG8_BAR; PG8_MMA(0, 0, At, B0); PG8_MMA(0, 1, At, B1); PG8_BAR; PG8_SCHED;
            PG8_LDA(At, 0, 1); PG8_STAGE(PG8_SB(0, 0), b2, voffB); PG8_STAGE(PG8_SB(0, 1), b2 + hstepB, voffB); PG8_STAGE(PG8_SA(0, 0), a2, voffA);
            PG8_WAIT_V(8); PG8_WAIT_L(0); PG8_BAR; PG8_MMA(1, 0, At, B0); PG8_MMA(1, 1, At, B1); PG8_BAR; PG8_SCHED;
            PG8_LDB(B0, 1, 0); PG8_LDB(B1, 1, 1); PG8_SCHED; PG8_LDA(At, 1, 0); PG8_STAGE(PG8_SA(0, 1), a2 + hstep, voffA);
            PG8_WAIT_V(8); PG8_WAIT_L(0); PG8_BAR; PG8_MMA(0, 0, At, B0); PG8_MMA(0, 1, At, B1); PG8_BAR; PG8_SCHED;
            PG8_LDA(At, 1, 1); PG8_STAGE(PG8_SB(1, 0), b3, voffB); PG8_STAGE(PG8_SB(1, 1), b3 + hstepB, voffB); PG8_STAGE(PG8_SA(1, 0), a3, voffA);
            PG8_WAIT_V(8); PG8_WAIT_L(0); PG8_BAR; PG8_MMA(1, 0, At, B0); PG8_MMA(1, 1, At, B1); PG8_BAR; PG8_SCHED;
            } else {
            PG8_LDB(B0, 0, 0); PG8_SCHED; PG8_LDA(At, 0, 0); PG8_STAGE(PG8_SA(1, 1), a1 + hstep, voffA);
            PG8_WAIT_L(8); PG8_BAR; PG8_WAIT_L(0); PG8_MMA(0, 0, At, B0); PG8_BAR; PG8_SCHED;
            PG8_LDB(B1, 0, 1); PG8_STAGE(PG8_SB(0, 0), b2, voffB);
            PG8_BAR; PG8_WAIT_L(0); PG8_MMA(0, 1, At, B1); PG8_BAR;
            PG8_LDA(At, 0, 1); PG8_STAGE(PG8_SA(0, 0), a2, voffA);
            PG8_BAR; PG8_WAIT_L(0); PG8_MMA(1, 0, At, B0); PG8_BAR; PG8_SCHED;
            PG8_STAGE(PG8_SB(0, 1), b2 + hstepB, voffB);
            PG8_WAIT_V(6); PG8_BAR; PG8_MMA(1, 1, At, B1); PG8_BAR;
            PG8_LDB(B0, 1, 0); PG8_SCHED; PG8_LDA(At, 1, 0); PG8_STAGE(PG8_SA(0, 1), a2 + hstep, voffA);
            PG8_WAIT_L(8); PG8_BAR; PG8_WAIT_L(0); PG8_MMA(0, 0, At, B0); PG8_BAR; PG8_SCHED;
            PG8_LDB(B1, 1, 1); PG8_STAGE(PG8_SB(1, 0), b3, voffB);
            PG8_BAR; PG8_WAIT_L(0); PG8_MMA(0, 1, At, B1); PG8_BAR;
            PG8_LDA(At, 1, 1); PG8_STAGE(PG8_SA(1, 0), a3, voffA);
            PG8_BAR; PG8_WAIT_L(0); PG8_MMA(1, 0, At, B0); PG8_BAR; PG8_SCHED;
            PG8_STAGE(PG8_SB(1, 1), b3 + hstepB, voffB);
            PG8_WAIT_V(6); PG8_BAR; PG8_MMA(1, 1, At, B1); PG8_BAR;
            }
        }
        if constexpr (ALIGN_EPI) { if (wr == 0) PG8_BAR; }
        if constexpr (FP8) asm volatile("s_nop 15\n\ts_nop 7" ::: "memory");
        E(acc, cur, wr, wc, fr, fq, pre);
        if (!has_next) break;
#pragma unroll
        for (int a = 0; a < 2; ++a)
#pragma unroll
            for (int b = 0; b < 2; ++b)
#pragma unroll
                for (int m = 0; m < 4; ++m)
#pragma unroll
                    for (int n = 0; n < 2; ++n) acc[a][b][m][n] = (f32x4){0.f, 0.f, 0.f, 0.f};
        cur = nxt; cA = nA; cB = nB; ++ui;
        if constexpr (ALIGN_EPI) { if (wr == 1) PG8_BAR; }
    }
    PG8_WAIT_V(0);
    if constexpr (!ALIGN_EPI) { if (wr == 0) PG8_BAR; }
    PG8_BAR;
#undef PG8_SA
#undef PG8_SB
#undef PG8_STAGE
#undef PG8_LDA
#undef PG8_LD8
#undef PG8_LDB
#undef PG8_MMA
#undef PG8_CAT
#undef PG8_WAIT_V
#undef PG8_WAIT_L
#undef PG8_BAR
#undef PG8_SCHED
}
}
using pg8::Unit; using pg8::v8i_t; using pg8::v4i_t;

typedef f32x4 AccT[2][2][4][2];
struct EpiProj {
    static constexpr bool PERM = true;
    struct Pre {}; __device__ __forceinline__ void preload(const Unit&, int, int, int, int, Pre&) const {}
    bf16_t *QA, *KA, *VA, *CQ, *SGA, *SGB; float* T7;
    __device__ __forceinline__ void operator()(const AccT& acc, const Unit& u, int wr, int wc, int fr, int fq, const Pre& P) const {
        const int pn = u.pn;
        const int row0 = u.pm * 256 + wr * 64 + fr;
        const int colw = wc * 32 + 8 * fq;
#pragma unroll
        for (int ai = 0; ai < 2; ++ai)
#pragma unroll
            for (int m = 0; m < 4; ++m) {
                const int row = row0 + ai * 128 + m * 16;
                const int b = row >> 11, i = row & 2047;
                const size_t krow = (size_t)b * TPB + NMETA + i;
#pragma unroll
                for (int bj = 0; bj < 2; ++bj) {
                    const f32x4 v0 = acc[ai][bj][m][0], v1 = acc[ai][bj][m][1];
                    const int ct = bj * 128 + colw;
                    if (pn == 7) {
                        float* d = T7 + (size_t)row * 256 + ct; *(f32x4*)d = v0; *(f32x4*)(d + 4) = v1;
                    } else {
                        f32x4 a = v0, c = v1; bf16_t* d;
                        if (pn < 2)       { a = a * FOX_C; c = c * FOX_C; d = QA + (size_t)row * 512 + pn * 256 + ct; }
                        else if (pn < 4)  { d = KA + krow * 512 + (pn - 2) * 256 + ct; }
                        else if (pn < 6)  { d = VA + krow * 512 + (pn - 4) * 256 + ct; }
                        else if (pn == 6) { d = CQ + (size_t)row * 256 + ct; }
                        else {
                            a = (f32x4){sigmoidf_(a[0]), sigmoidf_(a[1]), sigmoidf_(a[2]), sigmoidf_(a[3])};
                            c = (f32x4){sigmoidf_(c[0]), sigmoidf_(c[1]), sigmoidf_(c[2]), sigmoidf_(c[3])};
                            d = (pn < 12) ? SGA + (size_t)row * 1024 + (pn - 8) * 256 + ct : SGB + (size_t)row * 1024 + (pn - 12) * 256 + ct;
                        }
                        u32x4 w; w.x = pk2(a[0], a[1]); w.y = pk2(a[2], a[3]); w.z = pk2(c[0], c[1]); w.w = pk2(c[2], c[3]);
                        *(u32x4*)d = w;
                    }
                }
            }
    }
};
struct EpiGate {
    static constexpr bool PERM = true;
    struct Pre {}; __device__ __forceinline__ void preload(const Unit&, int, int, int, int, Pre&) const {}
    bf16_t *SGA, *SGB;
    __device__ __forceinline__ void operator()(const AccT& acc, const Unit& u, int wr, int wc, int fr, int fq, const Pre& P) const {
        const int pn = u.pn;
        const int row0 = u.pm * 256 + wr * 64 + fr, col0 = (pn & 3) * 256 + wc * 32 + 8 * fq;
        bf16_t* base = (pn < 4) ? SGA : SGB;
#pragma unroll
        for (int ai = 0; ai < 2; ++ai)
#pragma unroll
            for (int m = 0; m < 4; ++m)
#pragma unroll
                for (int bj = 0; bj < 2; ++bj) {
                    const f32x4 a = acc[ai][bj][m][0], c = acc[ai][bj][m][1];
                    const f32x2 kk = {-LOG2E * WSC_INV, -LOG2E * WSC_INV}, one2 = {1.0f, 1.0f};
                    u32x4 w;
#pragma unroll
                    for (int hh = 0; hh < 4; ++hh) {
                        const f32x2 ar = (hh < 2 ? (f32x2){a[2 * hh], a[2 * hh + 1]} : (f32x2){c[2 * hh - 4], c[2 * hh - 3]}) * kk;
                        const f32x2 dn = (f32x2){fast_exp2(ar.x), fast_exp2(ar.y)} + one2;
                        w[hh] = pk2(fast_rcp(dn.x), fast_rcp(dn.y));
                    }
                    *(u32x4*)(base + (size_t)(row0 + ai * 128 + m * 16) * 1024 + col0 + bj * 128) = w;
                }
    }
};
struct EpiQLat {
    static constexpr bool PERM = true; static constexpr bool PERM64 = true;
    struct Pre { float rs[8]; };
    bf16_t* QL; const float* RSTD;
    __device__ __forceinline__ void preload(const Unit& u, int wr, int wc, int fr, int fq, Pre& P) const {
        const unsigned row0 = (unsigned)(u.pm * 256 + wr * 64 + fr);
#pragma unroll
        for (int q = 0; q < 8; ++q) P.rs[q] = RSTD[row0 + (q >> 2) * 128 + (q & 3) * 16];
    }
    __device__ __forceinline__ void operator()(const AccT& acc, const Unit& u, int wr, int wc, int fr, int fq, const Pre& P) const {
        const unsigned row0 = (unsigned)(u.pm * 256 + wr * 64 + fr);
        const int cc = u.pn * 256 + wc * 64 + 16 * fq;
        unsigned char* base = (unsigned char*)QL + (size_t)((cc >> 7) * 192 + (cc & 127));
#pragma unroll
        for (int ai = 0; ai < 2; ++ai)
#pragma unroll
            for (int m = 0; m < 4; ++m) {
                const unsigned row = row0 + ai * 128 + m * 16;
                const float rs = P.rs[ai * 4 + m] * (DSA_C * QSC);
                u32x4 w;
#pragma unroll
                for (int bj = 0; bj < 2; ++bj) { const f32x4 x1 = acc[ai][bj][m][0], x2 = acc[ai][bj][m][1]; const f32x2 rs2 = {rs, rs};
                    const f32x2 p0 = (f32x2){x1[0], x1[1]} * rs2, p1 = (f32x2){x1[2], x1[3]} * rs2, p2 = (f32x2){x2[0], x2[1]} * rs2, p3 = (f32x2){x2[2], x2[3]} * rs2;
                    w[2 * bj] = pk4_fp8(p0.x, p0.y, p1.x, p1.y); w[2 * bj + 1] = pk4_fp8(p2.x, p2.y, p3.x, p3.y); }
                *(u32x4*)(base + (size_t)row * 1536) = w;
            }
    }
};
struct EpiQ {
    static constexpr bool PERM = false;
    struct Pre {}; __device__ __forceinline__ void preload(const Unit&, int, int, int, int, Pre&) const {}
    bf16_t *QL, *QIDX; const float *RSTD, *COS, *SIN; int pn0;
    __device__ __forceinline__ void operator()(const AccT& acc, const Unit& u, int wr, int wc, int fr, int fq, const Pre& P) const {
        const int pn = u.pn + pn0;
        const unsigned row0 = (unsigned)(u.pm * 256 + wr * 64 + fr);
        unsigned char* base = (pn == 4) ? (unsigned char*)QL : (unsigned char*)QIDX;
        const float sc = (pn == 4) ? DSA_C * QSC : 1.0f;
        float rsn = RSTD[row0]; f32x4 csn, snn;
        { const unsigned pos = NMETA + (row0 & 2047u); csn = *(const f32x4*)(COS + pos * 16 + 4 * fq); snn = *(const f32x4*)(SIN + pos * 16 + 4 * fq); }
#pragma unroll
        for (int am = 0; am < 8; ++am) {
            const int ai = am >> 2, m = am & 3;
            const unsigned row = row0 + ai * 128 + m * 16;
            const float rs = rsn * sc; const f32x4 cs = csn, sn = snn;
            if (am < 7) { const unsigned rown = row0 + ((am + 1) >> 2) * 128 + ((am + 1) & 3) * 16; const unsigned pos = NMETA + (rown & 2047u);
                rsn = RSTD[rown]; csn = *(const f32x4*)(COS + pos * 16 + 4 * fq); snn = *(const f32x4*)(SIN + pos * 16 + 4 * fq); }
#pragma unroll
            for (int bj = 0; bj < 2; ++bj) {
                const f32x4 x1 = acc[ai][bj][m][0] * rs, x2 = acc[ai][bj][m][1] * rs;
                const int g = bj * 4 + wc;
                const bool rope = (pn == 4) || ((g & 1) == 0);
                const f32x4 o1 = rope ? (x1 * cs - x2 * sn) : x1, o2 = rope ? (x1 * sn + x2 * cs) : x2;
                if (pn == 4) {
                    const unsigned off = row * 1536u + (unsigned)(g * 192 + 128 + 4 * fq);
                    *(unsigned*)(base + off) = pk4_fp8(o1[0], o1[1], o1[2], o1[3]); *(unsigned*)(base + off + 16) = pk4_fp8(o2[0], o2[1], o2[2], o2[3]);
                    *(unsigned*)(base + off + 32) = 0u; *(unsigned*)(base + off + 48) = 0u;
                } else {
                    const unsigned off = (row * 256u + (unsigned)(g * 32 + 4 * fq)) * 2u;
                    u32x2 w0 = {pk2(o1[0], o1[1]), pk2(o1[2], o1[3])}, w1 = {pk2(o2[0], o2[1]), pk2(o2[2], o2[3])};
                    *(u32x2*)(base + off) = w0; *(u32x2*)(base + off + 32) = w1;
                }
            }
        }
    }
};
template <bool SECOND> struct EpiBranch {
    static constexpr bool PERM = true;
    struct Pre {}; __device__ __forceinline__ void preload(const Unit&, int, int, int, int, Pre&) const {}
    bf16_t* T; const bf16_t* SG2; float asc;
    __device__ __forceinline__ void operator()(const AccT& acc, const Unit& u, int wr, int wc, int fr, int fq, const Pre& P) const {
        const int row0 = u.pm * 256 + wr * 64 + fr, col0 = u.pn * 256 + wc * 32 + 8 * fq;
#pragma unroll
        for (int ai = 0; ai < 2; ++ai)
#pragma unroll
            for (int mp = 0; mp < 4; mp += 2) {
                u32x4 tq[4], sq[4];
#pragma unroll
                for (int q = 0; q < 4; ++q) { const size_t off = (size_t)(row0 + ai * 128 + (mp + (q >> 1)) * 16) * 1024 + col0 + (q & 1) * 128;
                    tq[q] = *(const u32x4*)(T + off); if (SECOND) sq[q] = *(const u32x4*)(SG2 + off); }
#pragma unroll
                for (int q = 0; q < 4; ++q) {
                    const int m = mp + (q >> 1), bj = q & 1;
                    const size_t off = (size_t)(row0 + ai * 128 + m * 16) * 1024 + col0 + bj * 128;
                    const f32x4 a0 = acc[ai][bj][m][0], a1 = acc[ai][bj][m][1];
                    const u32x4 t = tq[q];
                    const f32x2 as2 = {asc, asc};
                    const f32x2 v[4] = {(f32x2){a0[0], a0[1]} * as2, (f32x2){a0[2], a0[3]} * as2, (f32x2){a1[0], a1[1]} * as2, (f32x2){a1[2], a1[3]} * as2};
                    u32x4 w;
                    if (!SECOND) {
#pragma unroll
                        for (int e = 0; e < 4; ++e) { const f32x2 r = (f32x2){bflo(t[e]), bfhi(t[e])} * v[e]; w[e] = pk2(r.x, r.y); }
                    } else {
                        const u32x4 s = sq[q];
#pragma unroll
                        for (int e = 0; e < 4; ++e) { const f32x2 r = (f32x2){bflo(t[e]), bfhi(t[e])} + (f32x2){bflo(s[e]), bfhi(s[e])} * v[e]; w[e] = pk2(r.x, r.y); }
                    }
                    *(u32x4*)(T + off) = w;
                }
            }
    }
};
struct EpiOut {
    static constexpr bool PERM = true;
    struct Pre {}; __device__ __forceinline__ void preload(const Unit&, int, int, int, int, Pre&) const {}
    const float* X; bf16_t* H1;
    __device__ __forceinline__ void operator()(const AccT& acc, const Unit& u, int wr, int wc, int fr, int fq, const Pre& P) const {
        const int row0 = u.pm * 256 + wr * 64 + fr, col0 = u.pn * 256 + wc * 32 + 8 * fq;
#pragma unroll
        for (int ai = 0; ai < 2; ++ai)
#pragma unroll
            for (int m = 0; m < 4; ++m)
#pragma unroll
                for (int bj = 0; bj < 2; ++bj) {
                    const size_t off = (size_t)(row0 + ai * 128 + m * 16) * 1024 + col0 + bj * 128;
                    const f32x4 xa = *(const f32x4*)(X + off), xb = *(const f32x4*)(X + off + 4), ca = acc[ai][bj][m][0], cb = acc[ai][bj][m][1];
                    const f32x2 s0 = (f32x2){xa.x, xa.y} + (f32x2){ca.x, ca.y}, s1 = (f32x2){xa.z, xa.w} + (f32x2){ca.z, ca.w}, s2 = (f32x2){xb.x, xb.y} + (f32x2){cb.x, cb.y}, s3 = (f32x2){xb.z, xb.w} + (f32x2){cb.z, cb.w};
                    *(u32x4*)(H1 + off) = (u32x4){pk2(s0.x, s0.y), pk2(s1.x, s1.y), pk2(s2.x, s2.y), pk2(s3.x, s3.y)};
                }
    }
};
struct EpiGateUp {
    static constexpr bool PERM = true;
    struct Pre { f32x4 bg0, bg1, bl0, bl1; };
    bf16_t* ACT; const float* BGU; int a_t0;
    __device__ __forceinline__ void preload(const Unit& u, int wr, int wc, int fr, int fq, Pre& P) const {
        const float* bg = BGU + (size_t)u.aux * 2048 + u.pn * 128 + wc * 32 + 8 * fq;
        P.bg0 = *(const f32x4*)bg; P.bg1 = *(const f32x4*)(bg + 4); P.bl0 = *(const f32x4*)(bg + 1024); P.bl1 = *(const f32x4*)(bg + 1028);
    }
    __device__ __forceinline__ void operator()(const AccT& acc, const Unit& u, int wr, int wc, int fr, int fq, const Pre& P) const {
        const int j0 = u.pn * 128 + wc * 32 + 8 * fq;
        const f32x4 bg0 = P.bg0, bg1 = P.bg1, bl0 = P.bl0 + 1.0f, bl1 = P.bl1 + 1.0f;
        const size_t row0 = (size_t)(u.pm - a_t0) * 256 + wr * 64 + fr;
        const f32x2 wsc2 = {WSC_INV, WSC_INV}, one2 = {1.0f, 1.0f}, ka2 = {-1.702f * LOG2E, -1.702f * LOG2E};
#pragma unroll
        for (int ai = 0; ai < 2; ++ai)
#pragma unroll
            for (int m = 0; m < 4; ++m) {
                f32x2 r[4];
#pragma unroll
                for (int n = 0; n < 2; ++n) {
                    const f32x4 ga = acc[ai][0][m][n], la = acc[ai][1][m][n], bgv = n ? bg1 : bg0, blv = n ? bl1 : bl0;
#pragma unroll
                    for (int hh = 0; hh < 2; ++hh) {
                        const f32x2 g = (f32x2){ga[2 * hh], ga[2 * hh + 1]} * wsc2 + (f32x2){bgv[2 * hh], bgv[2 * hh + 1]};
                        const f32x2 l = (f32x2){la[2 * hh], la[2 * hh + 1]} * wsc2 + (f32x2){blv[2 * hh], blv[2 * hh + 1]};
                        const f32x2 xg = {fminf(g.x, 7.0f), fminf(g.y, 7.0f)};
                        const f32x2 xl1 = {__builtin_amdgcn_fmed3f(l.x, -6.0f, 8.0f), __builtin_amdgcn_fmed3f(l.y, -6.0f, 8.0f)};
                        const f32x2 ar = xg * ka2;
                        const f32x2 ex = {fast_exp2(ar.x), fast_exp2(ar.y)};
                        const f32x2 dn = ex + one2;
                        const f32x2 rc = {fast_rcp(dn.x), fast_rcp(dn.y)};
                        r[n * 2 + hh] = (xg * xl1) * rc;
                    }
                }
                u32x2 w = {pk4_fp8(r[0].x, r[0].y, r[1].x, r[1].y), pk4_fp8(r[2].x, r[2].y, r[3].x, r[3].y)};
                *(u32x2*)((unsigned char*)ACT + (row0 + ai * 128 + m * 16) * 1024 + j0) = w;
            }
    }
};
struct EpiDown {
    static constexpr bool PERM = true;
    struct Pre { float gtv[8]; };
    bf16_t* Y; const float* BD; const float* SLOTG;
    __device__ __forceinline__ void preload(const Unit& u, int wr, int wc, int fr, int fq, Pre& P) const {
        const size_t row0 = (size_t)u.pm * 256 + wr * 64 + fr;
#pragma unroll
        for (int q = 0; q < 8; ++q) P.gtv[q] = SLOTG[row0 + (q >> 2) * 128 + (q & 3) * 16];
    }
    __device__ __forceinline__ void operator()(const AccT& acc, const Unit& u, int wr, int wc, int fr, int fq, const Pre& P) const {
        const int e = u.aux, col0 = u.pn * 256 + wc * 32 + 8 * fq;
        const size_t row0 = (size_t)u.pm * 256 + wr * 64 + fr;
        f32x4 bv[2][2]; float gtv[8];
#pragma unroll
        for (int bj = 0; bj < 2; ++bj) { bv[bj][0] = *(const f32x4*)(BD + (size_t)e * 1024 + col0 + bj * 128); bv[bj][1] = *(const f32x4*)(BD + (size_t)e * 1024 + col0 + bj * 128 + 4); }
#pragma unroll
        for (int q = 0; q < 8; ++q) gtv[q] = P.gtv[q];
#pragma unroll
        for (int ai = 0; ai < 2; ++ai)
#pragma unroll
            for (int m = 0; m < 4; ++m) {
                const size_t row = row0 + ai * 128 + m * 16;
                const float gt = gtv[ai * 4 + m];
#pragma unroll
                for (int bj = 0; bj < 2; ++bj) {
                    const f32x2 ws2 = {WSC_INV, WSC_INV}, gt2 = {gt, gt};
                    const f32x4 aa = acc[ai][bj][m][0], cc = acc[ai][bj][m][1], b0 = bv[bj][0], b1 = bv[bj][1];
                    const f32x2 a0 = ((f32x2){aa[0], aa[1]} * ws2 + (f32x2){b0[0], b0[1]}) * gt2, a1 = ((f32x2){aa[2], aa[3]} * ws2 + (f32x2){b0[2], b0[3]}) * gt2;
                    const f32x2 c0 = ((f32x2){cc[0], cc[1]} * ws2 + (f32x2){b1[0], b1[1]}) * gt2, c1 = ((f32x2){cc[2], cc[3]} * ws2 + (f32x2){b1[2], b1[3]}) * gt2;
                    u32x2 w = {pk4_fp8(a0.x, a0.y, a1.x, a1.y), pk4_fp8(c0.x, c0.y, c1.x, c1.y)};
                    *(u32x2*)((unsigned char*)Y + row * 1024 + col0 + bj * 128) = w;
                }
            }
    }
};

struct Args { const float* in[24]; float* out; unsigned char* ws; int ph_lo, ph_hi; };
typedef const __attribute__((address_space(4))) Args* ArgsP;
__device__ __forceinline__ ArgsP fresh_args() { ArgsP p = (ArgsP)__builtin_amdgcn_kernarg_segment_ptr(); asm volatile("" : "+s"(p)); return p; }
struct Frame {
    LAS unsigned char* lds;
    int tid, lane, wave, G, bid;
};
extern __shared__ __attribute__((aligned(16))) unsigned char lds_raw[];
__device__ __forceinline__ Frame mkframe() { Frame F; F.lds = (LAS unsigned char*)lds_raw; F.tid = tid_fresh(); F.lane = F.tid & 63; F.wave = __builtin_amdgcn_readfirstlane(F.tid >> 6); F.G = gridDim.x; F.bid = blockIdx.x; return F; }
enum { I_X = 0, I_META, I_NORM_MIX_G, I_W_IN, I_B_FORGET, I_Q_NORM_G, I_W_UQ, I_KV_NORM_G, I_W_UK, I_W_UV, I_W_QIDX, I_KIDX_G, I_KIDX_B, I_W_BA, I_W_BB, I_W_OUT,
       I_NORM_FFN_G, I_W_ROUTER, I_B_ROUTER, I_W_GU, I_B_GU, I_W_DOWN, I_B_DOWN, I_NORM_FINAL_G };

struct TrItem { const float* W; bf16_t* WT; int K, N, dr0, k0, sc, fp8; };
__device__ __forceinline__ void tr_load(const TrItem& t, float (&v)[32], int lane) {
    const float* p = t.W + (size_t)(t.k0 + (lane >> 5)) * t.N + (t.sc >= 0 ? t.sc : 0);
#pragma unroll
    for (int i = 0; i < 32; ++i) v[i] = p[(size_t)(2 * i) * t.N];
}
__device__ __forceinline__ void tr_store(const TrItem& t, const float (&v)[32], LAS float* scr, int lane) {
#pragma unroll
    for (int i = 0; i < 32; ++i) scr[(2 * i + (lane >> 5)) * 33 + (lane & 31)] = t.sc >= 0 ? v[i] : 0.f;
    LDS_WAIT(); asm volatile("" ::: "memory");
    const int c = lane & 7;
#pragma unroll
    for (int j = 0; j < 4; ++j) { const int n = (lane >> 3) + 8 * j; const LAS float* s = scr + (8 * c) * 33 + n;
        if (t.fp8) { u32x2 o8 = {pk4_fp8(s[0 * 33] * WSC, s[1 * 33] * WSC, s[2 * 33] * WSC, s[3 * 33] * WSC), pk4_fp8(s[4 * 33] * WSC, s[5 * 33] * WSC, s[6 * 33] * WSC, s[7 * 33] * WSC)};
            *(u32x2*)((unsigned char*)t.WT + (size_t)(t.dr0 + n) * t.K + t.k0 + 8 * c) = o8; }
        else { u32x4 o; o.x = pk2(s[0 * 33], s[1 * 33]); o.y = pk2(s[2 * 33], s[3 * 33]); o.z = pk2(s[4 * 33], s[5 * 33]); o.w = pk2(s[6 * 33], s[7 * 33]);
            *(u32x4*)(t.WT + (size_t)(t.dr0 + n) * t.K + t.k0 + 8 * c) = o; } }
    LDS_WAIT(); asm volatile("" ::: "memory");
}
template <class Mk>
__device__ __forceinline__ void tr_run(int it0, int stride, int nit, LAS float* scr, int lane, const Mk& mk) {
    float va[32], vb[32];
    int it = it0;
    if (it >= nit) return;
    TrItem ta = mk(it), tb = ta;
    tr_load(ta, va, lane);
    for (;;) {
        const int it2 = it + stride;
        const bool h2 = it2 < nit;
        if (h2) { tb = mk(it2); tr_load(tb, vb, lane); }
        tr_store(ta, va, scr, lane);
        if (!h2) break;
        const int it3 = it2 + stride;
        const bool h3 = it3 < nit;
        if (h3) { ta = mk(it3); tr_load(ta, va, lane); }
        tr_store(tb, vb, scr, lane);
        if (!h3) break;
        it = it3;
    }
}
struct TrItem2 { const float* W; unsigned char* WT; int K, N, dr0, k0, sc0; };
__device__ __forceinline__ void tr2_load(const TrItem2& t, f32x4 (&v)[16], int lane) {
    const float* p = t.W + (size_t)(t.k0 + (lane >> 4)) * t.N + t.sc0 + (lane & 15) * 4;
#pragma unroll
    for (int i = 0; i < 16; ++i) v[i] = *(const f32x4*)(p + (size_t)(4 * i) * t.N);
}
template <class Mk>
__device__ __forceinline__ void tr2_run(int it0, int stride, int nit, LAS float* scr, int lane, const Mk& mk) {
    if (it0 >= nit) return;
    f32x4 v[16];
    TrItem2 cur = mk(it0);
    tr2_load(cur, v, lane);
    for (int it = it0;;) {
#pragma unroll
        for (int i = 0; i < 16; ++i) *(LAS f32x4*)(scr + ((lane >> 4) + 4 * i) * 68 + (lane & 15) * 4) = v[i];
        LDS_WAIT(); asm volatile("" ::: "memory");
        const int itn = it + stride; const bool hn = itn < nit;
        TrItem2 nxt = cur;
        if (hn) { nxt = mk(itn); tr2_load(nxt, v, lane); }
        const int nl = lane >> 2, kq = lane & 3;
#pragma unroll
        for (int p = 0; p < 4; ++p) {
            const int n = 16 * p + nl; const LAS float* sp = scr + (16 * kq) * 68 + n;
            u32x4 o;
            o.x = pk4_fp8(sp[0 * 68] * WSC, sp[1 * 68] * WSC, sp[2 * 68] * WSC, sp[3 * 68] * WSC);
            o.y = pk4_fp8(sp[4 * 68] * WSC, sp[5 * 68] * WSC, sp[6 * 68] * WSC, sp[7 * 68] * WSC);
            o.z = pk4_fp8(sp[8 * 68] * WSC, sp[9 * 68] * WSC, sp[10 * 68] * WSC, sp[11 * 68] * WSC);
            o.w = pk4_fp8(sp[12 * 68] * WSC, sp[13 * 68] * WSC, sp[14 * 68] * WSC, sp[15 * 68] * WSC);
            *(u32x4*)(cur.WT + (size_t)(cur.dr0 + n) * cur.K + cur.k0 + 16 * kq) = o;
        }
        LDS_WAIT(); asm volatile("" ::: "memory");
        if (!hn) break;
        cur = nxt; it = itn;
    }
}
struct MapId { __device__ __forceinline__ int operator()(int n) const { return n; } };
struct MapWin {
    __device__ __forceinline__ int operator()(int n) const {
        if (n < 1536) return n;
        if (n < 1792) return 1544 + (n - 1536);
        if (n < 1920) return 1800 + (n - 1792);
        if (n < 1952) return 1928 + (n - 1920);
        if (n < 2016) return 1960 + (n - 1952);
        if (n < 2024) return 1536 + (n - 2016);
        if (n < 2028) return 2024 + (n - 2024);
        if (n < 2048) return -1;
        if (n < 3072) return 2028 + (n - 2048);
        return 3052 + (n - 3072);
    }
};
struct MapGU { __device__ __forceinline__ int operator()(int n) const { const int pn = n >> 8, j = n & 255; return j < 128 ? pn * 128 + j : 1024 + pn * 128 + (j - 128); } };
__device__ __forceinline__ int meta_src(int c) {
    if (c < 512) return 512 + c;
    if (c < 1024) return 1024 + (c - 512);
    const int t = c - 1024;
    if (t < 128) return 1800 + t;
    if (t < 160) return 1928 + (t - 128);
    if (t < 224) return 1960 + (t - 160);
    if (t < 232) return 1536 + (t - 224);
    if (t < 236) return 2024 + (t - 232);
    return -1;
}
__device__ __forceinline__ void rms_row_to_bf16(const float* xrow, const float* g, bf16_t* orow, int lane) {
    const f32x4* xr = (const f32x4*)xrow + lane; const f32x4* gr = (const f32x4*)g + lane;
    f32x4 v[4]; float s = 0.f;
#pragma unroll
    for (int j = 0; j < 4; ++j) { v[j] = xr[64 * j]; s += (v[j].x * v[j].x + v[j].y * v[j].y) + (v[j].z * v[j].z + v[j].w * v[j].w); }
    const float rstd = __builtin_amdgcn_rsqf(wave_sum(s) * (1.f / 1024.f) + EPS);
    u64* o8 = (u64*)orow + lane;
#pragma unroll
    for (int j = 0; j < 4; ++j) { const f32x4 gg = gr[64 * j]; o8[64 * j] = (u64)pk2(v[j].x * rstd * gg.x, v[j].y * rstd * gg.y) | ((u64)pk2(v[j].z * rstd * gg.z, v[j].w * rstd * gg.w) << 32); }
}

__device__ __forceinline__ void p0_prologue(Frame& F) {
    const ArgsP A = fresh_args();
    LAS float* scr = (LAS float*)(F.lds + F.wave * 16384);
    const int gw = F.bid * 8 + F.wave, NGW = F.G * 8, lane = F.lane;
    unsigned char* ws = A->ws;
    {
        constexpr int I_WIN = 16 * 128, I_WA = 8 * 32, I_WOUT = 16 * 32;
        const float* w_in = A->in[I_W_IN]; const float* w_ba = A->in[I_W_BA]; const float* w_out = A->in[I_W_OUT];
        tr_run(gw, NGW, I_WIN + I_WA + I_WOUT, scr, lane, [&](int it) {
            TrItem t; int r = it;
            if (r < I_WIN) { t.W = w_in; t.K = 1024; t.N = D_IN; t.dr0 = (r % 128) * 32; t.k0 = (r / 128) * 64; t.sc = MapWin()(t.dr0 + (lane & 31));
                if (t.dr0 < 2048) { t.fp8 = 0; t.WT = (bf16_t*)(ws + WS_WIN_T); } else { t.fp8 = 1; t.WT = (bf16_t*)(ws + WS_WIN8 - (size_t)2048 * 1024); }
                return t; } r -= I_WIN;
            if (r < I_WA) { t.W = w_ba; t.WT = (bf16_t*)(ws + WS_WA_T); t.fp8 = 0; t.K = 512; t.N = 1024; t.dr0 = (r % 32) * 32; t.k0 = (r / 32) * 64; t.sc = t.dr0 + (lane & 31); return t; } r -= I_WA;
            t.W = w_out; t.WT = (bf16_t*)(ws + WS_WOUT_T); t.fp8 = 0; t.K = 1024; t.N = 1024; t.dr0 = (r % 32) * 32; t.k0 = (r / 32) * 64; t.sc = t.dr0 + (lane & 31); return t; });
    }
    {
        const int gt = F.bid * 512 + F.tid, NGT = F.G * 512;
        const float* w_uq = A->in[I_W_UQ]; const float* w_uk = A->in[I_W_UK]; const float* w_uv = A->in[I_W_UV]; const float* w_qidx = A->in[I_W_QIDX];
        const float* w_bb = A->in[I_W_BB]; const float* qg = A->in[I_Q_NORM_G];
        bf16_t* WQ2 = (bf16_t*)(ws + WS_WQ2_T); bf16_t* WOB = (bf16_t*)(ws + WS_WOB_T);
        for (int o = gt; o < 1536 * 256; o += NGT) {
            const int k = o / 1536, n = o - k * 1536; float v;
            if (n < 1024) { const int h = n >> 7, r = n & 127; float s = 0.f;
#pragma unroll 8
                for (int j = 0; j < 64; ++j) s += w_uq[k * 768 + 96 * h + j] * w_uk[(h * 64 + j) * 128 + r]; v = s; }
            else if (n < 1280) { const int h = (n - 1024) >> 5, j = (n - 1024) & 31; v = w_uq[k * 768 + 96 * h + 64 + j]; }
            else v = w_qidx[k * 256 + (n - 1280)];
            WQ2[n * 256 + k] = (bf16_t)(pk2(v * qg[k], 0.f) & 0xffffu);
        }
        for (int o = gt; o < 256 * 1024; o += NGT) {
            const int k4 = (o >> 10) * 4, n = o & 1023, h = k4 >> 7; float s0 = 0.f, s1 = 0.f, s2 = 0.f, s3 = 0.f;
            const float* uv = w_uv + (size_t)k4 * 64;
#pragma unroll 8
            for (int v = 0; v < 64; ++v) { const float wb = w_bb[(size_t)(h * 64 + v) * 1024 + n]; s0 += uv[v] * wb; s1 += uv[64 + v] * wb; s2 += uv[128 + v] * wb; s3 += uv[192 + v] * wb; }
            *(unsigned*)((unsigned char*)WOB + (size_t)n * 1024 + k4) = pk4_fp8(s0 * WSC, s1 * WSC, s2 * WSC, s3 * WSC);
        }
        float* COS = (float*)(ws + WS_COS); float* SIN = (float*)(ws + WS_SIN);
        for (int o = gt; o < TPB * 16; o += NGT) {
            const int pos = o >> 4, j = o & 15;
            const float inv = exp2f(-(float)j * (13.287712379549449f / 16.0f));
            const float ang = (float)pos * inv;
            const double rev = (double)ang * 0.15915494309189535; const float fr = (float)(rev - floor(rev));
            COS[o] = __builtin_amdgcn_cosf(fr); SIN[o] = __builtin_amdgcn_sinf(fr);
        }
    }
    {
        const float* X = A->in[I_X]; const f32x4* gr = (const f32x4*)A->in[I_NORM_MIX_G] + lane; bf16_t* XN = (bf16_t*)(ws + WS_XN);
        f32x4 v[4], vn[4];
        if (gw < M) {
#pragma unroll
            for (int j = 0; j < 4; ++j) v[j] = ((const f32x4*)(X + (size_t)gw * 1024) + lane)[64 * j];
        }
        for (int m = gw; m < M; m += NGW) {
            const int mn = (m + NGW < M) ? m + NGW : m;
#pragma unroll
            for (int j = 0; j < 4; ++j) vn[j] = ((const f32x4*)(X + (size_t)mn * 1024) + lane)[64 * j];
            float s2 = 0.f;
#pragma unroll
            for (int j = 0; j < 4; ++j) s2 += (v[j].x * v[j].x + v[j].y * v[j].y) + (v[j].z * v[j].z + v[j].w * v[j].w);
            const float rstd = __builtin_amdgcn_rsqf(wave_sum(s2) * (1.f / 1024.f) + EPS);
            u64* o8 = (u64*)(XN + (size_t)m * 1024) + lane; unsigned* o4 = (unsigned*)(ws + WS_XN8 + (size_t)m * 1024) + lane;
#pragma unroll
            for (int j = 0; j < 4; ++j) { const f32x4 gg = gr[64 * j]; const float y0 = v[j].x * rstd * gg.x, y1 = v[j].y * rstd * gg.y, y2 = v[j].z * rstd * gg.z, y3 = v[j].w * rstd * gg.w;
                o8[64 * j] = (u64)pk2(y0, y1) | ((u64)pk2(y2, y3) << 32); o4[64 * j] = pk4_fp8(y0, y1, y2, y3); }
#pragma unroll
            for (int j = 0; j < 4; ++j) v[j] = vn[j];
        }
    }
    __syncthreads();
    {
        LAS float* xnm = (LAS float*)F.lds;
        LAS float* red = (LAS float*)(F.lds + 65536);
        for (int un = F.bid; un < 20; un += F.G) {
            for (int p = F.wave; p < 16; p += 8) {
                const float* mr = A->in[I_META] + p * 1024; const float* g = A->in[I_NORM_MIX_G];
                float v[16]; float s = 0.f;
#pragma unroll
                for (int j = 0; j < 16; ++j) { v[j] = mr[lane + 64 * j]; s += v[j] * v[j]; }
                const float rstd = __builtin_amdgcn_rsqf(wave_sum(s) * (1.f / 1024.f) + EPS);
#pragma unroll
                for (int j = 0; j < 16; ++j) xnm[p * 1024 + lane + 64 * j] = v[j] * rstd * g[lane + 64 * j];
            }
            __syncthreads();
            const int c = un * 64 + lane, sc = meta_src(c);
            float a[16];
#pragma unroll
            for (int p = 0; p < 16; ++p) a[p] = 0.f;
            const float* W = A->in[I_W_IN];
            for (int k0 = F.wave * 128; k0 < F.wave * 128 + 128; k0 += 16) {
                float w[16];
#pragma unroll
                for (int j = 0; j < 16; ++j) w[j] = sc >= 0 ? W[(size_t)(k0 + j) * D_IN + sc] : 0.f;
#pragma unroll
                for (int j = 0; j < 16; ++j)
#pragma unroll
                    for (int p = 0; p < 16; ++p) a[p] += xnm[p * 1024 + k0 + j] * w[j];
            }
#pragma unroll
            for (int p = 0; p < 16; ++p) red[(F.wave * 16 + p) * 64 + lane] = a[p];
            __syncthreads();
            for (int o = F.tid; o < 1024; o += 512) { const int p = o >> 6, l = o & 63; float s = 0.f;
#pragma unroll
                for (int w = 0; w < 8; ++w) s += red[(w * 16 + p) * 64 + l];
                ((float*)(ws + WS_PROJM))[p * 1280 + un * 64 + l] = s; }
            __syncthreads();
        }
    }
}

__device__ __forceinline__ f32x4 log_sigmoid4(f32x4 z) {
    f32x4 r;
#pragma unroll
    for (int k = 0; k < 4; ++k) { const float x = z[k]; r[k] = log_sigmoidf_(x); }
    return r;
}
__host__ __device__ __forceinline__ int vt8_pos(int kp) { const int sub = kp >> 5, kk = kp & 31, hi = (kk >> 2) & 1, r = (kk & 3) + 4 * (kk >> 3); return 32 * hi + 16 * sub + r; }
struct PostPtrs { const float *kvg, *lg, *lb, *COS, *SIN; };
__device__ __forceinline__ void post_row(const PostPtrs& PP, const f32x4 v, int pos, unsigned char* k8_row, unsigned char* vt8_b, bf16_t* kidx_row, int lane) {
    const float* kvg = PP.kvg; const float* lg = PP.lg; const float* lb = PP.lb;
    const float* COS = PP.COS; const float* SIN = PP.SIN;
    const float ss = (v.x * v.x + v.y * v.y) + (v.z * v.z + v.w * v.w);
    const float s_ckv = wave_sum(lane < 32 ? ss : 0.f);
    const bool isk = (lane >= 40 && lane < 56);
    const float s_k = wave_sum(isk ? (v.x + v.y) + (v.z + v.w) : 0.f);
    const float mean = s_k * (1.f / 64.f);
    const f32x4 dv = v - mean;
    const float q_k = wave_sum(isk ? (dv.x * dv.x + dv.y * dv.y) + (dv.z * dv.z + dv.w * dv.w) : 0.f);
    const float rstd_c = __builtin_amdgcn_rsqf(s_ckv * (1.f / 128.f) + EPS);
    const float rstd_k = __builtin_amdgcn_rsqf(q_k * (1.f / 64.f) + EPS);
    f32x4 y = v;
    if (isk) { const int c = 4 * (lane - 40); const f32x4 g = *(const f32x4*)(lg + c), bb = *(const f32x4*)(lb + c); y = dv * rstd_k * g + bb; }
    f32x4 pr;
    pr.x = __shfl_xor(y.x, 4); pr.y = __shfl_xor(y.y, 4); pr.z = __shfl_xor(y.z, 4); pr.w = __shfl_xor(y.w, 4);
    if (lane < 32) {
        const f32x4 g = *(const f32x4*)(kvg + 4 * lane); const f32x4 o = v * rstd_c * g;
        const unsigned w = pk4_fp8(o.x, o.y, o.z, o.w);
        *(unsigned*)(k8_row + 4 * lane) = w;
    } else if (lane < 48) {
        const int jj = 4 * (lane & 3);
        const f32x4 cs = *(const f32x4*)(COS + pos * 16 + jj), sn = *(const f32x4*)(SIN + pos * 16 + jj);
        const f32x4 o = (lane & 4) ? (pr * sn + y * cs) : (y * cs - pr * sn);
        u32x2 w = {pk2(o.x, o.y), pk2(o.z, o.w)};
        if (lane < 40) *(unsigned*)(k8_row + 128 + 4 * (lane - 32)) = pk4_fp8(o.x, o.y, o.z, o.w); else *(u32x2*)(kidx_row + 4 * (lane - 40)) = w;
    } else if (lane < 56) {
        u32x2 w = {pk2(y.x, y.y), pk2(y.z, y.w)}; *(u32x2*)(kidx_row + 4 * (lane - 40)) = w;
        *(unsigned*)(k8_row + 160 + 4 * (lane - 48)) = 0u;
    }
}
__device__ __forceinline__ void p2_post(Frame& F) {
    const ArgsP A = fresh_args();
    unsigned char* ws = A->ws; const int lane = F.lane, tid = F.tid;
    const float* T7 = (const float*)(ws + WS_T7); const float* PROJM = (const float*)(ws + WS_PROJM);
    unsigned char* K8 = ws + WS_KVR; unsigned char* VT8 = ws + WS_VT8; bf16_t* KIDX = (bf16_t*)(ws + WS_KIDX); bf16_t* KA = (bf16_t*)(ws + WS_KA); bf16_t* VA = (bf16_t*)(ws + WS_VA);
    float* BIAS = (float*)(ws + WS_BIAS); float* IW = (float*)(ws + WS_IW); float* RSTDQ = (float*)(ws + WS_RSTDQ);
    const bf16_t* CQ = (const bf16_t*)(ws + WS_CQ);
    const float* bfg = A->in[I_B_FORGET];
    const PostPtrs PP{A->in[I_KV_NORM_G], A->in[I_KIDX_G], A->in[I_KIDX_B], (const float*)(ws + WS_COS), (const float*)(ws + WS_SIN)};
    LAS float* lf = (LAS float*)F.lds;
    LAS float* part = (LAS float*)(F.lds + 8192);
    LAS float* offs = (LAS float*)(F.lds + 8192 + 2048);
    LAS float* metaF = (LAS float*)(F.lds + 8192 + 2048 + 64);
    for (int un = F.bid; un < 256; un += F.G) {
        const int b = un >> 3, blk = un & 7;
        {
            const ArgsP Ar = fresh_args(); unsigned char* wsr = Ar->ws;
            const float* T7 = (const float*)(wsr + WS_T7); const bf16_t* CQ = (const bf16_t*)(wsr + WS_CQ); unsigned char* K8 = wsr + WS_KVR; bf16_t* KIDX = (bf16_t*)(wsr + WS_KIDX);
            float* IW = (float*)(wsr + WS_IW); float* RSTDQ = (float*)(wsr + WS_RSTDQ); const float* bfg = Ar->in[I_B_FORGET];
            const PostPtrs PP{Ar->in[I_KV_NORM_G], Ar->in[I_KIDX_G], Ar->in[I_KIDX_B], (const float*)(wsr + WS_COS), (const float*)(wsr + WS_SIN)};
            const int i16 = lane & 15, rq4 = lane >> 4;
            const bool isc = i16 < 8, isk = (i16 >= 10 && i16 < 14), isr = (i16 >= 8 && i16 < 12), up = (i16 & 1) != 0;
            LAS float* rcs = (LAS float*)(F.lds + 16384);
            for (int o = tid; o < 256 * 16 / 4; o += 512) {
                *(LAS f32x4*)(rcs + 4 * o) = *((const f32x4*)(PP.COS + (size_t)(NMETA + blk * 256) * 16) + o);
                *(LAS f32x4*)(rcs + 4096 + 4 * o) = *((const f32x4*)(PP.SIN + (size_t)(NMETA + blk * 256) * 16) + o);
            }
            LAS float* gtab = rcs + 8192;
            if (tid < 256) { const int li = tid >> 4, e = tid & 15; float gg = 1.0f, bb = 0.f;
                if (li < 8) gg = PP.kvg[16 * li + e]; else if (li >= 10 && li < 14) { gg = PP.lg[16 * (li - 10) + e]; bb = PP.lb[16 * (li - 10) + e]; }
                gtab[tid] = gg; gtab[256 + tid] = bb; }
            f32x4 bf0 = {0.f, 0.f, 0.f, 0.f}, bf1 = bf0;
            if (i16 == 14) { bf0 = *(const f32x4*)bfg; bf1 = *(const f32x4*)(bfg + 4); }
            __syncthreads();
#define ROW16_SUM(x) { x += __int_as_float(__builtin_amdgcn_update_dpp(0, __float_as_int(x), 0x128, 0xf, 0xf, false)); x += __int_as_float(__builtin_amdgcn_update_dpp(0, __float_as_int(x), 0x124, 0xf, 0xf, false)); \
                       x += __int_as_float(__builtin_amdgcn_update_dpp(0, __float_as_int(x), 0x122, 0xf, 0xf, false)); x += __int_as_float(__builtin_amdgcn_update_dpp(0, __float_as_int(x), 0x121, 0xf, 0xf, false)); }
            const int mrow0 = b * 2048 + blk * 256 + F.wave * 32 + rq4;
            f32x4 vn[4]; u32x4 cn[2];
#pragma unroll
            for (int j = 0; j < 4; ++j) vn[j] = *((const f32x4*)(T7 + (size_t)mrow0 * 256 + 16 * i16) + j);
#pragma unroll
            for (int j = 0; j < 2; ++j) cn[j] = *((const u32x4*)(CQ + (size_t)mrow0 * 256 + 16 * i16) + j);
            for (int it = 0; it < 8; ++it) {
                const int rr = it * 4 + rq4, i = blk * 256 + F.wave * 32 + rr, m = b * 2048 + i; const int mn = it < 7 ? m + 4 : m;
                float v[16]; u32x4 c2[2];
#pragma unroll
                for (int j = 0; j < 4; ++j) { v[4 * j] = vn[j].x; v[4 * j + 1] = vn[j].y; v[4 * j + 2] = vn[j].z; v[4 * j + 3] = vn[j].w; }
                c2[0] = cn[0]; c2[1] = cn[1];
#pragma unroll
                for (int j = 0; j < 4; ++j) vn[j] = *((const f32x4*)(T7 + (size_t)mn * 256 + 16 * i16) + j);
#pragma unroll
                for (int j = 0; j < 2; ++j) cn[j] = *((const u32x4*)(CQ + (size_t)mn * 256 + 16 * i16) + j);
                float s1 = 0.f;
#pragma unroll
                for (int e = 0; e < 16; ++e) s1 += v[e];
                float sk = isk ? s1 : 0.f; ROW16_SUM(sk)
                const float mu = isk ? sk * (1.f / 64.f) : 0.f;
                float q = 0.f;
#pragma unroll
                for (int e = 0; e < 16; ++e) { v[e] -= mu; q += v[e] * v[e]; }
                float qc = isc ? q : 0.f, qk = isk ? q : 0.f; ROW16_SUM(qc) ROW16_SUM(qk)
                const float rstd_c = __builtin_amdgcn_rsqf(qc * (1.f / 128.f) + EPS), rstd_k = __builtin_amdgcn_rsqf(qk * (1.f / 64.f) + EPS);
                const float rsel = isc ? rstd_c : (isk ? rstd_k : 1.0f);
                float y[16];
                if (i16 == 14) {
                    const f32x4 z0 = (f32x4){v[0], v[1], v[2], v[3]} + bf0, z1 = (f32x4){v[4], v[5], v[6], v[7]} + bf1;
                    *(LAS f32x4*)(lf + (F.wave * 32 + rr) * 8) = log_sigmoid4(z0); *(LAS f32x4*)(lf + (F.wave * 32 + rr) * 8 + 4) = log_sigmoid4(z1);
                    *(f32x4*)(IW + (size_t)m * 4) = (f32x4){v[8], v[9], v[10], v[11]} * 0.0625f;
                }
#pragma unroll
                for (int e4 = 0; e4 < 4; ++e4) { const f32x4 gg = *(const LAS f32x4*)(gtab + 16 * i16 + 4 * e4), bb = *(const LAS f32x4*)(gtab + 256 + 16 * i16 + 4 * e4);
#pragma unroll
                    for (int k = 0; k < 4; ++k) y[4 * e4 + k] = v[4 * e4 + k] * rsel * gg[k] + bb[k]; }
                const LAS float* cr = rcs + (blk * 0 + (F.wave * 32 + rr)) * 16;
#pragma unroll
                for (int e4 = 0; e4 < 4; ++e4) {
                    const f32x4 cs = *(const LAS f32x4*)(cr + 4 * e4), sn = *(const LAS f32x4*)(cr + 4096 + 4 * e4);
#pragma unroll
                    for (int k = 0; k < 4; ++k) { const int e = 4 * e4 + k;
                        const float pr = __int_as_float(__builtin_amdgcn_update_dpp(0, __float_as_int(y[e]), 0xB1, 0xf, 0xf, false));
                        const float o = up ? (pr * sn[k] + y[e] * cs[k]) : (y[e] * cs[k] - pr * sn[k]);
                        y[e] = isr ? o : y[e]; }
                }
                const size_t kr = (size_t)b * TPB + NMETA + i;
                if (i16 < 12) {
                    u32x4 w8 = {pk4_fp8(y[0], y[1], y[2], y[3]), pk4_fp8(y[4], y[5], y[6], y[7]), pk4_fp8(y[8], y[9], y[10], y[11]), pk4_fp8(y[12], y[13], y[14], y[15])};
                    if (i16 >= 10) w8 = (u32x4){0u, 0u, 0u, 0u};
                    *(u32x4*)(K8 + kr * 192 + 16 * i16) = w8;
                }
                if (isk) {
                    u32x4 wa = {pk2(y[0], y[1]), pk2(y[2], y[3]), pk2(y[4], y[5]), pk2(y[6], y[7])}, wb = {pk2(y[8], y[9]), pk2(y[10], y[11]), pk2(y[12], y[13]), pk2(y[14], y[15])};
                    bf16_t* kd = KIDX + kr * 64 + 16 * (i16 - 10);
                    *(u32x4*)kd = wa; *(u32x4*)(kd + 8) = wb;
                }
                { float sq = 0.f;
#pragma unroll
                  for (int j = 0; j < 2; ++j) { const u32x4 w = c2[j]; sq += (bflo(w.x) * bflo(w.x) + bfhi(w.x) * bfhi(w.x)) + (bflo(w.y) * bflo(w.y) + bfhi(w.y) * bfhi(w.y)) + (bflo(w.z) * bflo(w.z) + bfhi(w.z) * bfhi(w.z)) + (bflo(w.w) * bflo(w.w) + bfhi(w.w) * bfhi(w.w)); }
                  ROW16_SUM(sq)
                  if (i16 == 0) RSTDQ[m] = __builtin_amdgcn_rsqf(sq * (1.f / 256.f) + EPS); }
            }
#undef ROW16_SUM
        }
        {
        const ArgsP A2 = fresh_args(); unsigned char* ws = A2->ws;
        const float* T7 = (const float*)(ws + WS_T7); const float* PROJM = (const float*)(ws + WS_PROJM);
        unsigned char* K8 = ws + WS_KVR; unsigned char* VT8 = ws + WS_VT8; bf16_t* KIDX = (bf16_t*)(ws + WS_KIDX); bf16_t* KA = (bf16_t*)(ws + WS_KA); bf16_t* VA = (bf16_t*)(ws + WS_VA);
        float* BIAS = (float*)(ws + WS_BIAS); const float* bfg = A2->in[I_B_FORGET];
        const PostPtrs PP{A2->in[I_KV_NORM_G], A2->in[I_KIDX_G], A2->in[I_KIDX_B], (const float*)(ws + WS_COS), (const float*)(ws + WS_SIN)};
        {
            float kmx = 0.f;
            for (int r8 = 0; r8 < 32; r8 += 8) {
                u32x4 w8[8];
#pragma unroll
                for (int rr = 0; rr < 8; ++rr) { const size_t kr = (size_t)b * TPB + NMETA + blk * 256 + F.wave * 32 + r8 + rr; w8[rr] = *((const u32x4*)(KA + kr * 512) + lane); }
#pragma unroll
                for (int rr = 0; rr < 8; ++rr) { const u32x4 w = w8[rr];
                    float s2 = (bflo(w.x) * bflo(w.x) + bfhi(w.x) * bfhi(w.x)) + (bflo(w.y) * bflo(w.y) + bfhi(w.y) * bfhi(w.y)) + (bflo(w.z) * bflo(w.z) + bfhi(w.z) * bfhi(w.z)) + (bflo(w.w) * bflo(w.w) + bfhi(w.w) * bfhi(w.w));
                    s2 += __shfl_xor(s2, 1); s2 += __shfl_xor(s2, 2); s2 += __shfl_xor(s2, 4);
                    kmx = fmaxf(kmx, s2); }
            }
            if (blk == 0) {
                for (int p = 0; p < 16; ++p) { const f32x4 a0 = *((const f32x4*)(PROJM + p * 1280) + 2 * lane), a1 = *((const f32x4*)(PROJM + p * 1280) + 2 * lane + 1);
                    float s2 = (a0.x * a0.x + a0.y * a0.y) + (a0.z * a0.z + a0.w * a0.w) + (a1.x * a1.x + a1.y * a1.y) + (a1.z * a1.z + a1.w * a1.w);
                    s2 += __shfl_xor(s2, 1); s2 += __shfl_xor(s2, 2); s2 += __shfl_xor(s2, 4);
                    kmx = fmaxf(kmx, s2 * 1.02f); }
            }
            if ((lane & 7) == 0) atomicMax((unsigned*)(ws + WS_CTL) + CW_KMAX + b * 8 + (lane >> 3), __float_as_uint(kmx));
        }
        {
            const int h = tid & 7; float s = 0.f;
            float zz[28];
#pragma unroll
            for (int k = 0; k < 28; ++k) { const int r = (tid >> 3) + 64 * k; zz[k] = (r < blk * 256) ? T7[(size_t)(b * 2048 + r) * 256 + 224 + h] : 1.0e30f; }
            const float bh = bfg[h];
#pragma unroll
            for (int k = 0; k < 28; ++k) { const float z = zz[k] + bh; s += log_sigmoidf_(z); }
            part[tid] = s;
            if (tid < 8) { float c = 0.f; for (int p = 0; p < 16; ++p) { const float z = PROJM[p * 1280 + 1248 + tid] + bfg[tid]; c += log_sigmoidf_(z); metaF[p * 8 + tid] = c; } }
        }
        __syncthreads();
        if (tid < 8) { float s = metaF[15 * 8 + tid]; for (int k = 0; k < 64; ++k) s += part[k * 8 + tid]; offs[tid] = s; }
        __syncthreads();
        {
            const int hh = F.wave; float* bo = BIAS + ((size_t)b * 8 + hh) * TPB + NMETA + blk * 256;
            const float a0 = lf[(4 * lane + 0) * 8 + hh], a1 = lf[(4 * lane + 1) * 8 + hh], a2 = lf[(4 * lane + 2) * 8 + hh], a3 = lf[(4 * lane + 3) * 8 + hh];
            const float t4 = (a0 + a1) + (a2 + a3); float inc = t4;
#pragma unroll
            for (int off = 1; off < 64; off <<= 1) { const float v2 = __shfl_up(inc, off); if (lane >= off) inc += v2; }
            const float c0 = offs[hh] + (inc - t4) + a0, c1 = c0 + a1, c2 = c1 + a2, c3 = c2 + a3;
            *(f32x4*)(bo + 4 * lane) = (f32x4){-c0 * LOG2E, -c1 * LOG2E, -c2 * LOG2E, -c3 * LOG2E};
        }
        if (blk == 0) {
            if (tid < 128) { const int p = tid >> 3, h = tid & 7; BIAS[((size_t)b * 8 + h) * TPB + p] = -metaF[p * 8 + h] * LOG2E; }
            if (tid >= 128 && tid < 512) { const int o = tid - 128; if (o < 48 * 8) { const int p = o >> 3, h = o & 7; BIAS[((size_t)b * 8 + h) * TPB + 2064 + p] = 0.f; } }
            for (int p = F.wave; p < 16; p += 8) {
                const float* src = PROJM + p * 1280;
                const size_t kr = (size_t)b * TPB + p;
                const f32x4 v = *((const f32x4*)(src + 1024) + lane);
                post_row(PP, v, p, K8 + kr * 192, VT8 + (size_t)b * NKT * 128 * 64, KIDX + kr * 64, lane);
#pragma unroll
                for (int j = 0; j < 2; ++j) {
                    const f32x4 a = *((const f32x4*)src + lane + 64 * j), c = *((const f32x4*)(src + 512) + lane + 64 * j);
                    u32x2 wa = {pk2(a.x, a.y), pk2(a.z, a.w)}, wc = {pk2(c.x, c.y), pk2(c.z, c.w)};
                    *((u32x2*)(KA + kr * 512) + lane + 64 * j) = wa; *((u32x2*)(VA + kr * 512) + lane + 64 * j) = wc;
                }
            }
            for (int p = F.wave; p < 48; p += 8) {
                const size_t kr = (size_t)b * TPB + 2064 + p; const u32x2 z = {0u, 0u};
                *((u32x2*)(KA + kr * 512) + lane) = z; *((u32x2*)(KA + kr * 512) + lane + 64) = z; *((u32x2*)(VA + kr * 512) + lane) = z; *((u32x2*)(VA + kr * 512) + lane + 64) = z;
                if (lane < 48) *((unsigned*)(K8 + kr * 192) + lane) = 0u;

                if (lane < 16) *((u32x2*)(KIDX + kr * 64) + lane) = z;
            }
        }
        }
        __syncthreads();
    }
}

__device__ __forceinline__ void vt8_build(Frame& F) {
    const ArgsP A = fresh_args(); unsigned char* ws = A->ws; const int tid = F.tid;
    LAS unsigned char* t8 = F.lds;
    for (int un = F.bid; un < NB * NKT; un += F.G) {
        const int b = un / NKT, kt = un % NKT;
        const unsigned char* src = ws + WS_KVR + ((size_t)b * TPB + (size_t)kt * 64) * 192;
        { const int r = tid >> 3, ch = tid & 7; *(LAS u32x4*)(t8 + r * 144 + ch * 16) = *(const u32x4*)(src + (size_t)r * 192 + ch * 16); }
        __syncthreads();
        { const int d = tid >> 2, q4 = tid & 3;
          unsigned w[4];
#pragma unroll
          for (int g = 0; g < 4; ++g) { unsigned acc = 0u;
#pragma unroll
              for (int e = 0; e < 4; ++e) { const int beta = 16 * q4 + 4 * g + e; const int hi2 = beta >> 5, i2 = beta & 31, sub = i2 >> 4, r2 = i2 & 15;
                  const int kp = 32 * sub + (r2 & 3) + 8 * (r2 >> 2) + 4 * hi2; acc |= (unsigned)t8[kp * 144 + d] << (8 * e); }
              w[g] = acc; }
          *(u32x4*)(ws + WS_VT8 + ((size_t)un * 128 + d) * 64 + 16 * q4) = (u32x4){w[0], w[1], w[2], w[3]}; }
        __syncthreads();
    }
}
__device__ __forceinline__ s16x4 vtr(const LAS unsigned char* p) { return __builtin_bit_cast(s16x4, __builtin_amdgcn_ds_read_tr16_b64_v4i16((LAS s16x4*)p)); }
__device__ __forceinline__ float max3f(float a, float b, float c) { float r; asm("v_max3_f32 %0, %1, %2, %3" : "=v"(r) : "v"(a), "v"(b), "v"(c)); return r; }
__device__ __forceinline__ float max32(const f32x16& p, const f32x16& q) {
    float a = max3f(p[0], p[1], p[2]), b = max3f(q[0], q[1], q[2]);
    a = max3f(a, p[3], p[4]); b = max3f(b, q[3], q[4]); a = max3f(a, p[5], p[6]); b = max3f(b, q[5], q[6]);
    a = max3f(a, p[7], p[8]); b = max3f(b, q[7], q[8]); a = max3f(a, p[9], p[10]); b = max3f(b, q[9], q[10]);
    a = max3f(a, p[11], p[12]); b = max3f(b, q[11], q[12]); a = max3f(a, p[13], p[14]); b = max3f(b, q[13], q[14]);
    return max3f(a, b, max3f(p[15], q[15], q[15]));
}
__device__ __forceinline__ float max16(const f32x16& p) {
    float a = fmaxf(fmaxf(p[0], p[1]), fmaxf(p[2], p[3])), b = fmaxf(fmaxf(p[4], p[5]), fmaxf(p[6], p[7]));
    float c = fmaxf(fmaxf(p[8], p[9]), fmaxf(p[10], p[11])), d = fmaxf(fmaxf(p[12], p[13]), fmaxf(p[14], p[15]));
    return fmaxf(fmaxf(a, b), fmaxf(c, d));
}
#define PFRAG(P, s) ((bf16x8)__builtin_bit_cast(bf16x8, (u32x4){pk2(P[8 * (s) + 0], P[8 * (s) + 1]), pk2(P[8 * (s) + 2], P[8 * (s) + 3]), pk2(P[8 * (s) + 4], P[8 * (s) + 5]), pk2(P[8 * (s) + 6], P[8 * (s) + 7])}))

constexpr int FX_KP = 144;
constexpr int FX_TB = 64 * FX_KP;
constexpr int FX_K0 = 0, FX_V0 = 2 * FX_TB, FX_B0 = 4 * FX_TB;
__device__ __forceinline__ void fox_unit(Frame& F, int b, int hd, int qb) {
    const ArgsP A = fresh_args();
    const int tid = F.tid, lane = F.lane, r32 = lane & 31, hi = lane >> 5, wid = F.wave;
    unsigned char* ws = A->ws;
    bf16_t* QA = (bf16_t*)(ws + WS_QA); const bf16_t* KA = (const bf16_t*)(ws + WS_KA); const bf16_t* VA = (const bf16_t*)(ws + WS_VA);
    const float* BIAS = (const float*)(ws + WS_BIAS);
    LAS unsigned char* lds = F.lds;
    const int i0 = 256 * qb + 32 * wid;
    const int qpos = NMETA + i0 + r32;
    const size_t qrow = (size_t)b * 2048 + i0 + r32;
    bf16x8 qf[4];
#pragma unroll
    for (int d = 0; d < 4; ++d) qf[d] = *(const bf16x8*)(QA + qrow * 512 + hd * 64 + d * 16 + hi * 8);
    const int KT = 4 * qb + 5;
    const float* bg = BIAS + ((size_t)b * 8 + hd) * TPB;
    int kt_lo = 0;
    {
        float q2 = 0.f;
#pragma unroll
        for (int d = 0; d < 4; ++d) { const u32x4 w = __builtin_bit_cast(u32x4, qf[d]);
            q2 += (bflo(w.x) * bflo(w.x) + bfhi(w.x) * bfhi(w.x)) + (bflo(w.y) * bflo(w.y) + bfhi(w.y) * bfhi(w.y)) + (bflo(w.z) * bflo(w.z) + bfhi(w.z) * bfhi(w.z)) + (bflo(w.w) * bflo(w.w) + bfhi(w.w) * bfhi(w.w)); }
        q2 += __shfl_xor(q2, 32);
        q2 = wave_max(q2);
        LAS float* wq = (LAS float*)(lds + FX_B0 + 512);
        if (lane == 0) wq[wid] = q2;
        __syncthreads();
        float qm = wq[0];
#pragma unroll
        for (int w2 = 1; w2 < 8; ++w2) qm = fmaxf(qm, wq[w2]);
        const float km = __uint_as_float(ld_agent((const unsigned*)(ws + WS_CTL) + CW_KMAX + b * 8 + hd));
        const float thr = -(2.04f * sqrtf(qm * km) + 50.0f);
        const int ncand = 4 * qb;
        const float b0 = bg[NMETA + 256 * qb];
        const float dk = (lane < ncand) ? bg[64 * lane + 63] - b0 : 0.f;
        const u64 keep = __ballot(lane >= ncand || dk >= thr);
        kt_lo = __builtin_amdgcn_readfirstlane(__builtin_ctzll(keep));
        __syncthreads();
    }
    const int srow = tid >> 3, sch = tid & 7;
    const bf16_t* kg = KA + ((size_t)b * TPB + (size_t)kt_lo * 64 + srow) * 512 + hd * 64 + sch * 8;
    const bf16_t* vg = VA + ((size_t)b * TPB + (size_t)kt_lo * 64 + srow) * 512 + hd * 64 + sch * 8;
    const int sdst = srow * FX_KP + sch * 16;
    u32x4 kreg = *(const u32x4*)kg, vreg = *(const u32x4*)vg; float breg = (tid < 64) ? bg[kt_lo * 64 + tid] : 0.f;
    *(LAS u32x4*)(lds + FX_K0 + sdst) = kreg; *(LAS u32x4*)(lds + FX_V0 + sdst) = vreg; if (tid < 64) *(LAS float*)(lds + FX_B0 + tid * 4) = breg;
    __syncthreads();
    f32x16 o0 = {}, o1 = {}; float mrow = NEGBIG, lrow = 0.f;
    const int vlane = ((lane & 15) >> 2) * FX_KP + (16 * ((lane >> 4) & 1) + 4 * (lane & 3)) * 2 + 4 * hi * FX_KP;
    for (int kt = kt_lo; kt < KT; ++kt) {
        const int cur = (kt - kt_lo) & 1;
        if (kt + 1 < KT) { kreg = *(const u32x4*)(kg + (size_t)(kt + 1 - kt_lo) * 64 * 512); vreg = *(const u32x4*)(vg + (size_t)(kt + 1 - kt_lo) * 64 * 512); if (tid < 64) breg = bg[(kt + 1) * 64 + tid]; }
        if (64 * kt <= NMETA + i0 + 31) {
            const LAS unsigned char* Kb = lds + FX_K0 + cur * FX_TB; const LAS unsigned char* Vb = lds + FX_V0 + cur * FX_TB; const LAS unsigned char* Bb = lds + FX_B0 + cur * 256;
            f32x16 p0, p1;
#pragma unroll
            for (int g = 0; g < 4; ++g) { const f32x4 t0 = *(const LAS f32x4*)(Bb + (8 * g + 4 * hi) * 4), t1 = *(const LAS f32x4*)(Bb + (32 + 8 * g + 4 * hi) * 4);
                p0[4 * g] = t0.x; p0[4 * g + 1] = t0.y; p0[4 * g + 2] = t0.z; p0[4 * g + 3] = t0.w; p1[4 * g] = t1.x; p1[4 * g + 1] = t1.y; p1[4 * g + 2] = t1.z; p1[4 * g + 3] = t1.w; }
#pragma unroll
            for (int d = 0; d < 4; ++d) {
                const bf16x8 k0 = *(const LAS bf16x8*)(Kb + r32 * FX_KP + (d * 16 + hi * 8) * 2), k1 = *(const LAS bf16x8*)(Kb + (32 + r32) * FX_KP + (d * 16 + hi * 8) * 2);
                p0 = __builtin_amdgcn_mfma_f32_32x32x16_bf16(k0, qf[d], p0, 0, 0, 0); p1 = __builtin_amdgcn_mfma_f32_32x32x16_bf16(k1, qf[d], p1, 0, 0, 0);
            }
            asm volatile("s_nop 15\n\ts_nop 7" : "+v"(p0), "+v"(p1));
            if (64 * kt + 63 > NMETA + i0) {
#pragma unroll
                for (int r = 0; r < 16; ++r) { const int kp = 64 * kt + crow(r, hi); if (kp > qpos) p0[r] = NEGBIG; if (kp + 32 > qpos) p1[r] = NEGBIG; }
            }
            float mx = max32(p0, p1); mx = fmaxf(mx, __shfl_xor(mx, 32));
            const float mnew = fmaxf(mrow, mx), alpha = fast_exp2(mrow - mnew); mrow = mnew;
            float sum = 0.f;
#pragma unroll
            for (int r = 0; r < 16; ++r) { p0[r] = fast_exp2(p0[r] - mnew); p1[r] = fast_exp2(p1[r] - mnew); sum += p0[r] + p1[r]; }
            lrow = lrow * alpha + sum;
#pragma unroll
            for (int r = 0; r < 16; ++r) { o0[r] *= alpha; o1[r] *= alpha; }
            const bf16x8 pf0 = PFRAG(p0, 0), pf1 = PFRAG(p0, 1), pf2 = PFRAG(p1, 0), pf3 = PFRAG(p1, 1);
#pragma unroll
            for (int s = 0; s < 4; ++s) {
                const bf16x8 pf = s == 0 ? pf0 : s == 1 ? pf1 : s == 2 ? pf2 : pf3;
#pragma unroll
                for (int db = 0; db < 2; ++db) {
                    const LAS unsigned char* va = Vb + vlane + 16 * s * FX_KP + db * 64;
                    const s16x4 lo = vtr(va), hh = vtr(va + 8 * FX_KP);
                    const bf16x8 vf = {lo[0], lo[1], lo[2], lo[3], hh[0], hh[1], hh[2], hh[3]};
                    if (db == 0) o0 = __builtin_amdgcn_mfma_f32_32x32x16_bf16(vf, pf, o0, 0, 0, 0); else o1 = __builtin_amdgcn_mfma_f32_32x32x16_bf16(vf, pf, o1, 0, 0, 0);
                }
            }
        }
        if (kt + 1 < KT) { const int nb = cur ^ 1; *(LAS u32x4*)(lds + FX_K0 + nb * FX_TB + sdst) = kreg; *(LAS u32x4*)(lds + FX_V0 + nb * FX_TB + sdst) = vreg; if (tid < 64) *(LAS float*)(lds + FX_B0 + nb * 256 + tid * 4) = breg; }
        __syncthreads();
    }
    const float inv = 1.0f / (lrow + __shfl_xor(lrow, 32));
    bf16_t* orow = (bf16_t*)(ws + WS_OA) + qrow * 512 + hd * 64;
#pragma unroll
    for (int g = 0; g < 4; ++g) {
        u32x2 w0 = {pk2(o0[4 * g] * inv, o0[4 * g + 1] * inv), pk2(o0[4 * g + 2] * inv, o0[4 * g + 3] * inv)};
        u32x2 w1 = {pk2(o1[4 * g] * inv, o1[4 * g + 1] * inv), pk2(o1[4 * g + 2] * inv, o1[4 * g + 3] * inv)};
        *(u32x2*)(orow + 8 * g + 4 * hi) = w0; *(u32x2*)(orow + 32 + 8 * g + 4 * hi) = w1;
    }
}

constexpr int IX_NP = 2116;
template <int NS>
__device__ __forceinline__ u64 idx_select(const LAS float* row, int nslots, int lane, LAS u64* mwords) {
    unsigned key[NS];
#pragma unroll
    for (int s = 0; s < NS; ++s) { const unsigned u = __float_as_uint(row[64 * (s < nslots ? s : 0) + lane]); key[s] = (s < nslots) ? ((u & 0x80000000u) ? ~u : (u | 0x80000000u)) : 0u; }
    unsigned T = 0u; int cT = 0x7fffffff;
    for (int bit = 31; bit >= 0; --bit) {
        const unsigned cand = T | (1u << bit); int cnt = 0;
#pragma unroll
        for (int s = 0; s < NS; ++s) cnt += __builtin_popcountll(__ballot(key[s] >= cand));
        if (cnt >= 256) { T = cand; cT = cnt; if (cnt == 256) break; }
    }
    int need = 0;
    if (cT != 256) {
        int cgt = 0;
#pragma unroll
        for (int s = 0; s < NS; ++s) cgt += __builtin_popcountll(__ballot(key[s] > T));
        need = 256 - cgt;
    }
    int run = 0;
#pragma unroll
    for (int s = 0; s < NS; ++s) {
        u64 sel;
        if (cT == 256) sel = __ballot(key[s] >= T);
        else {
            const u64 tb = __ballot(key[s] == T);
            const int rank = run + __builtin_popcountll(tb & ((1ull << lane) - 1ull));
            sel = __ballot(key[s] > T || (key[s] == T && rank < need));
            run += __builtin_popcountll(tb);
        }
        if (lane == 0) mwords[s] = sel;
    }
    LDS_WAIT();
    return mwords[lane < NS ? lane : 0];
}
template <int CTRL, int RM> __device__ __forceinline__ unsigned dpp_add(unsigned v) { return v + (unsigned)__builtin_amdgcn_update_dpp(0, (int)v, CTRL, RM, 0xf, false); }
__device__ __forceinline__ unsigned wave_incl_scan(unsigned v) {
    v = dpp_add<0x111, 0xf>(v); v = dpp_add<0x112, 0xf>(v); v = dpp_add<0x114, 0xf>(v); v = dpp_add<0x118, 0xf>(v);
    v = dpp_add<0x142, 0xa>(v); v = dpp_add<0x143, 0xc>(v);
    return v;
}
template <int NS>
__device__ __forceinline__ u64 idx_select_hist(const LAS float* row, int nslots, int lane, LAS u64* mwords, LAS unsigned* hist) {
    __builtin_assume(nslots > NS - 5 && nslots <= NS);
    unsigned key[NS];
#pragma unroll
    for (int s = 0; s < NS; ++s) { const unsigned u = __float_as_uint(row[64 * (s < nslots ? s : 0) + lane]); key[s] = (s < nslots) ? (u ^ ((unsigned)((int)u >> 31) | 0x80000000u)) : 0u; }
    unsigned prefix = 0u, Tge = 0u; int need = 256, pass = 0; bool simple = false;
#if SELP0
    {
        unsigned km = 0u;
#pragma unroll
        for (int s = 0; s < NS; ++s) km = km > key[s] ? km : key[s];
#pragma unroll
        for (int o = 1; o < 64; o <<= 1) { const unsigned v = (unsigned)__shfl_xor((int)km, o); km = km > v ? km : v; }
        const unsigned dmax = (unsigned)__builtin_amdgcn_readfirstlane((int)(km >> 24));
        if (dmax >= 4u) {
            const unsigned th0 = dmax << 24, th1 = (dmax - 1u) << 24;
            int c0 = 0, c1 = 0;
#pragma unroll
            for (int s = 0; s < NS; ++s) { c0 += __builtin_popcountll(__ballot(key[s] >= th0)); c1 += __builtin_popcountll(__ballot(key[s] >= th1)); }
            int above = -1, cb = 0; unsigned digit = 0u;
            if (c0 >= 256) { digit = dmax; above = 0; cb = c0; } else if (c1 >= 256) { digit = dmax - 1u; above = c0; cb = c1 - c0; }
            else {
                const unsigned th2 = (dmax - 2u) << 24, th3 = (dmax - 3u) << 24;
                int c2 = 0, c3 = 0;
#pragma unroll
                for (int s = 0; s < NS; ++s) { c2 += __builtin_popcountll(__ballot(key[s] >= th2)); c3 += __builtin_popcountll(__ballot(key[s] >= th3)); }
                if (c2 >= 256) { digit = dmax - 2u; above = c1; cb = c2 - c1; } else if (c3 >= 256) { digit = dmax - 3u; above = c2; cb = c3 - c2; }
            }
            if (above >= 0) {
                prefix = digit; need = 256 - above; pass = 1;
                if (cb == need) { Tge = prefix << 24; simple = true; }
            }
        }
    }
#endif
    if (!simple) {
#pragma unroll 1
        for (; pass < 4; ++pass) {
            const int sh = 24 - 8 * pass;
            *(LAS u32x4*)(hist + 4 * lane) = (u32x4){0u, 0u, 0u, 0u};
            LDS_WAIT();
#pragma unroll
            for (int s = 0; s < NS; ++s) {
                const unsigned k = key[s];
                const bool match = (s < nslots) && (pass == 0 || (k >> (sh + 8)) == prefix);
                if (match) __hip_atomic_fetch_add(hist + ((k >> sh) & 255u), 1u, __ATOMIC_RELAXED, __HIP_MEMORY_SCOPE_WORKGROUP);
            }
            LDS_WAIT();
            const u32x4 h = *(const LAS u32x4*)(hist + 4 * (63 - lane));
            const unsigned tl = (h.x + h.y) + (h.z + h.w);
            const unsigned incl = wave_incl_scan(tl);
            const unsigned excl = incl - tl, nd = (unsigned)need;
            const bool mine = (excl < nd) && (nd <= incl);
            const int L = __builtin_ctzll(__ballot(mine));
            unsigned c = excl, bin, above, cbin;
            if (nd <= c + h.w) { bin = 3u; above = c; cbin = h.w; } else { c += h.w;
            if (nd <= c + h.z) { bin = 2u; above = c; cbin = h.z; } else { c += h.z;
            if (nd <= c + h.y) { bin = 1u; above = c; cbin = h.y; } else { c += h.y; bin = 0u; above = c; cbin = h.x; } } }
            const unsigned digit = (unsigned)__builtin_amdgcn_readlane((int)(4u * (unsigned)(63 - lane) + bin), L);
            const unsigned abv = (unsigned)__builtin_amdgcn_readlane((int)above, L);
            const unsigned cb = (unsigned)__builtin_amdgcn_readlane((int)cbin, L);
            prefix = (prefix << 8) | digit; need -= (int)abv;
            if ((int)cb == need) { Tge = prefix << sh; simple = true; break; }
        }
    }
    if (simple) {
        unsigned lo = 0u, hi = 0u;
#pragma unroll
        for (int s = 0; s < NS; ++s) {
            const u64 sel = __ballot(key[s] >= Tge);
            asm("s_nop 1\n\tv_writelane_b32 %0, %2, %4\n\tv_writelane_b32 %1, %3, %4" : "+v"(lo), "+v"(hi) : "s"((unsigned)sel), "s"((unsigned)(sel >> 32)), "n"(s));
        }
        return ((u64)hi << 32) | lo;
    }
    const unsigned T = prefix; int run = 0;
#pragma unroll 1
    for (int s = 0; s < NS; ++s) {
        const unsigned k = __float_as_uint(row[64 * (s < nslots ? s : 0) + lane]); const unsigned ks = (s < nslots) ? (k ^ ((unsigned)((int)k >> 31) | 0x80000000u)) : 0u;
        const u64 tb = __ballot(ks == T);
        const int rank = run + __builtin_popcountll(tb & ((1ull << lane) - 1ull));
        const u64 sel = __ballot(ks > T || (ks == T && rank < need));
        run += __builtin_popcountll(tb);
        if (lane == 0) mwords[s] = sel;
    }
    LDS_WAIT();
    return mwords[lane < NS ? lane : 0];
}
__device__ __forceinline__ void idx_unit(Frame& F, int b, int c, int g16) {
    const ArgsP A = fresh_args();
    const int lane = F.lane, wid = F.wave;
    unsigned char* ws = A->ws;
    const bf16_t* QIDX = (const bf16_t*)(ws + WS_QIDX); const bf16_t* KIDX = (const bf16_t*)(ws + WS_KIDX); const float* IW = (const float*)(ws + WS_IW);
    u64* MASKW = (u64*)(ws + WS_MASKW);
    LAS float* sc = (LAS float*)F.lds;
    LAS u64* mwl = (LAS u64*)(F.lds + 16 * IX_NP * 4) + wid * 40;
    LAS unsigned* hst = (LAS unsigned*)(F.lds + 138240) + wid * 256;
    const int nslots = c + 2, nadm = 80 + 64 * c;
    const int q0 = 64 * c + 16 * g16;
    if (nadm > 256) {
        const int fr = lane & 15, fq = lane >> 4;
        const size_t qrow = (size_t)b * 2048 + q0 + fr;
        bf16x8 qf[4][2];
#pragma unroll
        for (int h = 0; h < 4; ++h)
#pragma unroll
            for (int s = 0; s < 2; ++s) qf[h][s] = *(const bf16x8*)(QIDX + qrow * 256 + h * 64 + s * 32 + fq * 8);
        const f32x4 wq = *(const f32x4*)(IW + qrow * 4);
        const bf16_t* kb = KIDX + ((size_t)b * TPB + fr) * 64 + fq * 8;
        const int nt16 = 4 * nslots;
        int nrs = (IDXREP & 1) ? 2 : 1; asm volatile("" : "+s"(nrs));
        for (int rs = 0; rs < nrs; ++rs)
        for (int t0 = wid; t0 < nt16; t0 += 32) {
            bf16x8 k0[4], k1[4];
#pragma unroll
            for (int j = 0; j < 4; ++j) { const int t = (t0 + 8 * j < nt16) ? t0 + 8 * j : t0; k0[j] = *(const bf16x8*)(kb + (size_t)t * 16 * 64); k1[j] = *(const bf16x8*)(kb + (size_t)t * 16 * 64 + 32); }
#pragma unroll
            for (int j = 0; j < 4; ++j) {
                const int t = t0 + 8 * j;
                if (t < nt16) {
                    f32x4 acc = {0.f, 0.f, 0.f, 0.f};
#pragma unroll
                    for (int h = 0; h < 4; ++h) {
                        f32x4 a = {0.f, 0.f, 0.f, 0.f};
                        a = __builtin_amdgcn_mfma_f32_16x16x32_bf16(k0[j], qf[h][0], a, 0, 0, 0);
                        a = __builtin_amdgcn_mfma_f32_16x16x32_bf16(k1[j], qf[h][1], a, 0, 0, 0);
                        const float w = wq[h];
                        acc.x += w * fmaxf(a.x, 0.f); acc.y += w * fmaxf(a.y, 0.f); acc.z += w * fmaxf(a.z, 0.f); acc.w += w * fmaxf(a.w, 0.f);
                    }
                    const int kp = 16 * t + 4 * fq;
                    if (kp + 0 >= nadm) acc.x = NEGBIG; if (kp + 1 >= nadm) acc.y = NEGBIG; if (kp + 2 >= nadm) acc.z = NEGBIG; if (kp + 3 >= nadm) acc.w = NEGBIG;
                    *(LAS f32x4*)(sc + fr * IX_NP + kp) = acc;
                }
            }
        }
    }
    __syncthreads();
    int nrq = (IDXREP & 2) ? 4 : 2; asm volatile("" : "+s"(nrq));
    for (int qq = 0; qq < nrq; ++qq) {
        const int ql = 2 * wid + (qq & 1);
        const size_t qrow = (size_t)b * 2048 + q0 + ql;
        u64 myword = 0ull;
        if (nadm <= 256) {
#pragma unroll
            for (int s = 0; s < 5; ++s) { const u64 bl = __ballot(64 * s + lane < nadm); if (lane == s) myword = bl; }
        } else if (nslots <= 8) myword = SELHIST ? idx_select_hist<8>(sc + ql * IX_NP, nslots, lane, mwl, hst) : idx_select<8>(sc + ql * IX_NP, nslots, lane, mwl);
        else if (nslots <= 12) myword = SELHIST ? idx_select_hist<12>(sc + ql * IX_NP, nslots, lane, mwl, hst) : idx_select<12>(sc + ql * IX_NP, nslots, lane, mwl);
        else if (nslots <= 16) myword = SELHIST ? idx_select_hist<16>(sc + ql * IX_NP, nslots, lane, mwl, hst) : idx_select<16>(sc + ql * IX_NP, nslots, lane, mwl);
        else if (nslots <= 20) myword = SELHIST ? idx_select_hist<20>(sc + ql * IX_NP, nslots, lane, mwl, hst) : idx_select<20>(sc + ql * IX_NP, nslots, lane, mwl);
        else if (nslots <= 24) myword = SELHIST ? idx_select_hist<24>(sc + ql * IX_NP, nslots, lane, mwl, hst) : idx_select<24>(sc + ql * IX_NP, nslots, lane, mwl);
        else if (nslots <= 28) myword = SELHIST ? idx_select_hist<28>(sc + ql * IX_NP, nslots, lane, mwl, hst) : idx_select<28>(sc + ql * IX_NP, nslots, lane, mwl);
        else myword = SELHIST ? idx_select_hist<NKT>(sc + ql * IX_NP, nslots, lane, mwl, hst) : idx_select<NKT>(sc + ql * IX_NP, nslots, lane, mwl);
        if (lane < nslots) MASKW[qrow * NKT + lane] = myword;
#if SELCHECK
        if (wid == 0 && qq == 0 && g16 == 0) {
            const LAS float* row = sc + ql * IX_NP; bool bad = false;
            for (int s0 = 0; s0 < nslots; ++s0) {
                const int i = 64 * s0 + lane; const bool adm = i < nadm;
                bool sel;
                if (nadm <= 256) sel = adm;
                else {
                    const float xi = row[i]; int rank = 0;
                    for (int j2 = 0; j2 < nadm; ++j2) { const float xj = row[j2]; rank += (xj > xi || (xj == xi && j2 < i)) ? 1 : 0; }
                    sel = adm && rank < 256;
                }
                const u64 wmask = __shfl(myword, s0);
                const bool got = (wmask >> lane) & 1ull;
                if (got != sel) bad = true;
            }
            if (__any(bad) && lane == 0) atomicOr((unsigned*)(ws + WS_CTL) + CW_ERR, 1u);
        }
#endif
    }
    __syncthreads();
}

constexpr int D8_KP = 208, D8_KT = 64 * D8_KP;
constexpr int D8_VP = 80, D8_VT = 128 * D8_VP;
constexpr int D8_K0 = 0, D8_V0 = 2 * D8_KT;
__device__ __forceinline__ v8i_t ld32(const LAS unsigned char* p) { return __builtin_shufflevector(*(const LAS v4i_t*)p, *(const LAS v4i_t*)(p + 16), 0, 1, 2, 3, 4, 5, 6, 7); }
#define MFMA8(acc, a, b) asm volatile("s_nop 1\n\tv_mfma_scale_f32_32x32x64_f8f6f4 %0, %1, %2, %0, %3, %3 op_sel_hi:[0,0,0]" : "+v"(acc) : "v"(a), "v"(b), "v"(sc1))
__device__ __forceinline__ void dsa_unit(Frame& F, int b, int c, int half) {
    const ArgsP A = fresh_args();
    const int tid = F.tid, lane = F.lane, r32 = lane & 31, hi = lane >> 5, wid = F.wave;
    unsigned char* ws = A->ws;
    const unsigned char* QL8 = ws + WS_QL; const unsigned char* K8 = ws + WS_KVR + (size_t)b * TPB * 192; const unsigned char* VT8 = ws + WS_VT8 + (size_t)b * NKT * 128 * 64;
    const u64* MASKW = (const u64*)(ws + WS_MASKW);
    LAS unsigned char* lds = F.lds;
    const int i0 = 64 * c + 32 * half;
    const size_t qrow = (size_t)b * 2048 + i0 + r32;
    int sc1 = 0x7f7f7f7f; asm volatile("" : "+v"(sc1));
    v8i_t qf[3];
#pragma unroll
    for (int s3 = 0; s3 < 3; ++s3) { const unsigned char* qp = QL8 + qrow * 1536 + wid * 192 + 64 * s3 + 32 * hi;
        qf[s3] = __builtin_shufflevector(*(const v4i_t*)qp, *(const v4i_t*)(qp + 16), 0, 1, 2, 3, 4, 5, 6, 7); }
    const int KT = c + 2;
    const int kc1 = tid + 512; const bool k1ok = kc1 < 768;
    const int kr0 = tid / 12, kq0 = tid % 12, kr1 = k1ok ? kc1 / 12 : 0, kq1 = k1ok ? kc1 % 12 : 0;
    const int vd = tid >> 2, vq = tid & 3;
    u32x4 sk0, sk1, sv;
    sk0 = *(const u32x4*)(K8 + (size_t)kr0 * 192 + kq0 * 16); sk1 = *(const u32x4*)(K8 + (size_t)kr1 * 192 + kq1 * 16); sv = *(const u32x4*)(VT8 + (size_t)vd * 64 + vq * 16);
    *(LAS u32x4*)(lds + D8_K0 + kr0 * D8_KP + kq0 * 16) = sk0; if (k1ok) *(LAS u32x4*)(lds + D8_K0 + kr1 * D8_KP + kq1 * 16) = sk1; *(LAS u32x4*)(lds + D8_V0 + vd * D8_VP + vq * 16) = sv;
    u64 mw = MASKW[qrow * NKT + 0], mwn = 0ull;
    __syncthreads();
    f32x16 o[4]; o[0] = f32x16{}; o[1] = f32x16{}; o[2] = f32x16{}; o[3] = f32x16{};
    float mrow = NEGBIG, lrow = 0.f;
    for (int kt = 0; kt < KT; ++kt) {
        const int cur = kt & 1;
        if (kt + 1 < KT) {
            const unsigned char* kn = K8 + (size_t)(kt + 1) * 64 * 192; const unsigned char* vn = VT8 + (size_t)(kt + 1) * 128 * 64;
            sk0 = *(const u32x4*)(kn + (size_t)kr0 * 192 + kq0 * 16); sk1 = *(const u32x4*)(kn + (size_t)kr1 * 192 + kq1 * 16); sv = *(const u32x4*)(vn + (size_t)vd * 64 + vq * 16);
            mwn = MASKW[qrow * NKT + kt + 1];
        }
        {
            const LAS unsigned char* Kb = lds + D8_K0 + cur * D8_KT + r32 * D8_KP + 32 * hi;
            const LAS unsigned char* Vb = lds + D8_V0 + cur * D8_VT + r32 * D8_VP + 32 * hi;
            v8i_t ka[3];
            f32x16 p0 = {}, p1 = {};
#pragma unroll
            for (int s3 = 0; s3 < 3; ++s3) ka[s3] = ld32(Kb + 64 * s3);
#pragma unroll
            for (int s3 = 0; s3 < 3; ++s3) MFMA8(p0, ka[s3], qf[s3]);
            __builtin_amdgcn_sched_barrier(0);
#pragma unroll
            for (int s3 = 0; s3 < 3; ++s3) ka[s3] = ld32(Kb + 32 * D8_KP + 64 * s3);
#pragma unroll
            for (int s3 = 0; s3 < 3; ++s3) MFMA8(p1, ka[s3], qf[s3]);
            __builtin_amdgcn_sched_barrier(0);
            v8i_t vf[4];
#pragma unroll
            for (int db = 0; db < 4; ++db) vf[db] = ld32(Vb + 32 * db * D8_VP);
            asm volatile("s_nop 15\n\ts_nop 7" : "+v"(p0), "+v"(p1));
            const unsigned m0 = (unsigned)mw, m1 = (unsigned)(mw >> 32);
            constexpr float IQ = 1.0f / QSC;
#pragma unroll
            for (int r = 0; r < 16; ++r) { const int kbit = crow(r, hi);
                const int t0 = __builtin_amdgcn_sbfe((int)m0, kbit, 1), t1 = __builtin_amdgcn_sbfe((int)m1, kbit, 1);
                p0[r] = __uint_as_float((__float_as_uint(p0[r]) & (unsigned)t0) | (0xf149f2cau & ~(unsigned)t0));
                p1[r] = __uint_as_float((__float_as_uint(p1[r]) & (unsigned)t1) | (0xf149f2cau & ~(unsigned)t1)); }
            float mx = max32(p0, p1); mx = fmaxf(mx, __shfl_xor(mx, 32)) * IQ;
            const float mnew = fmaxf(mrow, mx), alpha = fast_exp2(mrow - mnew); mrow = mnew;
            const float mofs = 7.0f - mnew;
            float sum = 0.f;
#pragma unroll
            for (int r = 0; r < 16; ++r) { p0[r] = fast_exp2(fmaf(p0[r], IQ, mofs)); p1[r] = fast_exp2(fmaf(p1[r], IQ, mofs)); sum += p0[r] + p1[r]; }
            lrow = lrow * alpha + sum;
#pragma unroll
            for (int db = 0; db < 4; ++db)
#pragma unroll
                for (int r = 0; r < 16; ++r) o[db][r] *= alpha;
            v8i_t pb;
#pragma unroll
            for (int g = 0; g < 4; ++g) { pb[g] = (int)pk4_fp8(p0[4 * g], p0[4 * g + 1], p0[4 * g + 2], p0[4 * g + 3]);
                                         pb[4 + g] = (int)pk4_fp8(p1[4 * g], p1[4 * g + 1], p1[4 * g + 2], p1[4 * g + 3]); }
#pragma unroll
            for (int db = 0; db < 4; ++db) MFMA8(o[db], vf[db], pb);
            asm volatile("s_nop 15\n\ts_nop 7" : "+v"(o[0]), "+v"(o[1]), "+v"(o[2]), "+v"(o[3]));
        }
        if (kt + 1 < KT) {
            const int nb = cur ^ 1;
            *(LAS u32x4*)(lds + D8_K0 + nb * D8_KT + kr0 * D8_KP + kq0 * 16) = sk0; if (k1ok) *(LAS u32x4*)(lds + D8_K0 + nb * D8_KT + kr1 * D8_KP + kq1 * 16) = sk1;
            *(LAS u32x4*)(lds + D8_V0 + nb * D8_VT + vd * D8_VP + vq * 16) = sv;
            mw = mwn;
        }
        __syncthreads();
    }
    const float inv = 1.0f / (lrow + __shfl_xor(lrow, 32));
    unsigned char* orow = ws + WS_OLAT + qrow * 1024 + wid * 128;
    const float isc = inv * OLSC;
#pragma unroll
    for (int db = 0; db < 4; ++db)
#pragma unroll
        for (int g = 0; g < 4; ++g)
            *(unsigned*)(orow + 32 * db + 8 * g + 4 * hi) = pk4_fp8(o[db][4 * g] * isc, o[db][4 * g + 1] * isc, o[db][4 * g + 2] * isc, o[db][4 * g + 3] * isc);
}
#undef MFMA8

__device__ __forceinline__ void p8_router(Frame& F) {
    const ArgsP A = fresh_args();
    unsigned char* ws = A->ws; const int lane = F.lane, tid = F.tid;
    const bf16_t* H1 = (const bf16_t*)(ws + WS_H1B); const float* g = A->in[I_NORM_FFN_G]; const float* WR = A->in[I_W_ROUTER]; const float* BR = A->in[I_B_ROUTER];
    int* TOPE = (int*)(ws + WS_TOPE); float* TOPG = (float*)(ws + WS_TOPG); int* LR = (int*)(ws + WS_LR); int* BC = (int*)(ws + WS_BC);
    LAS unsigned char* wf = F.lds;
    LAS int* te = (LAS int*)(F.lds + 131072);
    for (int o0 = tid; o0 < 32 * 1024; o0 += 512 * 8) {
        float wv[8], gv[8];
#pragma unroll
        for (int q = 0; q < 8; ++q) { const int o = o0 + 512 * q; wv[q] = WR[o]; gv[q] = g[o >> 5]; }
#pragma unroll
        for (int q = 0; q < 8; ++q) {
            const int o = o0 + 512 * q; const int k = o >> 5, e = o & 31;
            const float w = wv[q] * gv[q];
            const unsigned hb = pk2(w, 0.f) & 0xffffu; const unsigned lb = pk2(w - bflo(hb), 0.f) & 0xffffu;
            const int st = ((k >> 5) << 1) | ((k >> 3) & 1), ln = e + 32 * ((k >> 4) & 1), j = k & 7;
            *(LAS bf16_t*)(wf + ((st * 2 + 0) * 64 + ln) * 16 + j * 2) = (bf16_t)hb;
            *(LAS bf16_t*)(wf + ((st * 2 + 1) * 64 + ln) * 16 + j * 2) = (bf16_t)lb;
        }
    }
    __syncthreads();
    const int tk = lane & 31, h = lane >> 5;
    for (int un = F.bid; un < 256; un += F.G) {
        const int rl = F.wave * 32 + tk; const int m = un * 256 + rl;
        const u32x4* xr = (const u32x4*)(H1 + (size_t)m * 1024 + 16 * h);
        f32x16 ahh, alh;
#pragma unroll
        for (int r = 0; r < 16; ++r) { ahh[r] = 0.f; alh[r] = 0.f; }
        float ss = 0.f;
        u32x4 bA[8], bB[8];
#define RT_LOAD(buf, c) { _Pragma("unroll") for (int i = 0; i < 8; ++i) buf[i] = xr[(c) * 16 + (i >> 1) * 4 + (i & 1)]; }
#define RT_PROC(buf, c) { _Pragma("unroll") for (int q = 0; q < 8; ++q) { \
            const u32x4 xp = buf[q]; \
            { const float e0 = bflo(xp.x), e1 = bfhi(xp.x), e2 = bflo(xp.y), e3 = bfhi(xp.y), e4 = bflo(xp.z), e5 = bfhi(xp.z), e6 = bflo(xp.w), e7 = bfhi(xp.w); \
              ss += (e0 * e0 + e1 * e1) + (e2 * e2 + e3 * e3) + (e4 * e4 + e5 * e5) + (e6 * e6 + e7 * e7); } \
            const LAS unsigned char* wp = wf + (size_t)((c) * 8 + q) * 2048 + lane * 16; \
            const bf16x8 wh = *(const LAS bf16x8*)wp, wl = *(const LAS bf16x8*)(wp + 1024); \
            const bf16x8 xh = __builtin_bit_cast(bf16x8, xp); \
            ahh = __builtin_amdgcn_mfma_f32_32x32x16_bf16(wh, xh, ahh, 0, 0, 0); \
            alh = __builtin_amdgcn_mfma_f32_32x32x16_bf16(wl, xh, alh, 0, 0, 0); } }
        RT_LOAD(bA, 0)
#pragma unroll 1
        for (int c = 0; c < 8; c += 2) {
            RT_LOAD(bB, c + 1)
            RT_PROC(bA, c)
            { const int cn = c + 2 < 8 ? c + 2 : 7; RT_LOAD(bA, cn) }
            RT_PROC(bB, c + 1)
        }
#undef RT_LOAD
#undef RT_PROC
        ss += __shfl_xor(ss, 32);
        const float rstd = __builtin_amdgcn_rsqf(ss * (1.f / 1024.f) + EPS);
        float t0 = -INFINITY, t1 = -INFINITY, t2 = -INFINITY, t3 = -INFINITY; int i0 = 99, i1 = 99, i2 = 99, i3 = 99;
#define RT_GT(v, id, tv, ti) ((v) > (tv) || ((v) == (tv) && (id) < (ti)))
#define RT_INS(v, id) { const bool c0 = RT_GT(v, id, t0, i0), c1 = RT_GT(v, id, t1, i1), c2 = RT_GT(v, id, t2, i2), c3 = RT_GT(v, id, t3, i3); \
            t3 = c2 ? t2 : (c3 ? (v) : t3); i3 = c2 ? i2 : (c3 ? (id) : i3); t2 = c1 ? t1 : (c2 ? (v) : t2); i2 = c1 ? i1 : (c2 ? (id) : i2); \
            t1 = c0 ? t0 : (c1 ? (v) : t1); i1 = c0 ? i0 : (c1 ? (id) : i1); t0 = c0 ? (v) : t0; i0 = c0 ? (id) : i0; }
#pragma unroll
        for (int r = 0; r < 16; ++r) { const int id = crow(r, 0) + 4 * h; const float v = (ahh[r] + alh[r]) * rstd + BR[id]; RT_INS(v, id) }
        { const float p0 = __shfl_xor(t0, 32), p1 = __shfl_xor(t1, 32), p2 = __shfl_xor(t2, 32), p3 = __shfl_xor(t3, 32);
          const int j0 = __shfl_xor(i0, 32), j1 = __shfl_xor(i1, 32), j2 = __shfl_xor(i2, 32), j3 = __shfl_xor(i3, 32);
          RT_INS(p0, j0) RT_INS(p1, j1) RT_INS(p2, j2) RT_INS(p3, j3) }
#undef RT_INS
#undef RT_GT
        const float e1 = __expf(t1 - t0), e2 = __expf(t2 - t0), e3 = __expf(t3 - t0);
        const float inv = 1.0f / (1.0f + e1 + e2 + e3);
        if (h == 0) {
            *(int4*)(TOPE + (size_t)m * 4) = make_int4(i0, i1, i2, i3);
            *(f32x4*)(TOPG + (size_t)m * 4) = (f32x4){inv, e1 * inv, e2 * inv, e3 * inv};
            *(LAS v4i_t*)(te + rl * 4) = (v4i_t){i0, i1, i2, i3};
        }
        __syncthreads();
        for (int e = F.wave * 4; e < F.wave * 4 + 4; ++e) {
            int run = 0;
            for (int r4 = 0; r4 < 4; ++r4) {
                const int rl = r4 * 64 + lane;
                const int a0 = te[rl * 4], a1 = te[rl * 4 + 1], a2 = te[rl * 4 + 2], a3 = te[rl * 4 + 3];
                const int kk = (a0 == e) ? 0 : (a1 == e) ? 1 : (a2 == e) ? 2 : (a3 == e) ? 3 : -1;
                const u64 bl = __ballot(kk >= 0);
                if (kk >= 0) LR[(size_t)(un * 256 + rl) * 4 + kk] = run + __builtin_popcountll(bl & ((1ull << lane) - 1ull));
                run += __builtin_popcountll(bl);
            }
            if (lane == 0) BC[un * 32 + e] = run;
        }
        __syncthreads();
    }
}

__device__ __forceinline__ void p9_slots(Frame& F) {
    const ArgsP A = fresh_args();
    unsigned char* ws = A->ws; const int lane = F.lane, tid = F.tid;
    const bf16_t* H1 = (const bf16_t*)(ws + WS_H1B); const float* g = A->in[I_NORM_FFN_G];
    const int* TOPE = (const int*)(ws + WS_TOPE); const float* TOPG = (const float*)(ws + WS_TOPG); const int* LR = (const int*)(ws + WS_LR); const int* BC = (const int*)(ws + WS_BC);
    int* TOKSLOT = (int*)(ws + WS_TOKSLOT); float* SLOTG = (float*)(ws + WS_SLOTG); int* TILEE = (int*)(ws + WS_TILEE); int* GRP = (int*)(ws + WS_GRP);
    bf16_t* XBY = (bf16_t*)(ws + WS_XBY);
    LAS int* tot = (LAS int*)F.lds;
    LAS int* pst = tot + 32;
    LAS int* base = pst + 40;
    for (int un = F.bid; un < 256; un += F.G) {
        if (tid < 32) { tot[tid] = 0; base[tid] = 0; }
        __syncthreads();
        { const int e = tid & 31, part = tid >> 5; int c[16];
#pragma unroll
          for (int j = 0; j < 16; ++j) c[j] = ld_agent_i(BC + (part * 16 + j) * 32 + e);
          int t = 0, bs = 0;
#pragma unroll
          for (int j = 0; j < 16; ++j) { t += c[j]; if (part * 16 + j < un) bs += c[j]; }
          __hip_atomic_fetch_add(tot + e, t, __ATOMIC_RELAXED, __HIP_MEMORY_SCOPE_WORKGROUP); __hip_atomic_fetch_add(base + e, bs, __ATOMIC_RELAXED, __HIP_MEMORY_SCOPE_WORKGROUP); }
        __syncthreads();
        if (tid == 0) { int s = 0; for (int e = 0; e < 32; ++e) { pst[e] = s; s += ((tot[e] + 255) >> 8) << 8; } pst[32] = s; }
        __syncthreads();
        if (un == 0 && tid >= 64 && tid < 96) { const int e = tid - 64; const int t0 = pst[e] >> 8, t1 = pst[e + 1] >> 8; for (int t = t0; t < t1; ++t) TILEE[t] = e; }
        if (un == 0 && tid == 0) {
            int ng = 0, gl = 0; int* gt = GRP + 4;
            for (int e = 0; e < 32; ++e) {
                const int t0 = pst[e] >> 8, t1 = pst[e + 1] >> 8;
                if (t1 - gl > ACT_CAP_TILES) { gt[ng] = gl; gt[MAXG + ng] = t0; ++ng; gl = t0; }
            }
            gt[ng] = gl; gt[MAXG + ng] = pst[32] >> 8; ++ng;
            GRP[0] = ng; GRP[1] = pst[32] >> 8;
        }
        f32x4 v[4], vn[4];
#pragma unroll
        for (int j = 0; j < 4; ++j) v[j] = ld4bf(H1 + (size_t)(un * 256 + F.wave * 32) * 1024 + 4 * lane + 256 * j);
        int4 te = *(const int4*)(TOPE + (size_t)(un * 256 + F.wave * 32) * 4), lr = *(const int4*)(LR + (size_t)(un * 256 + F.wave * 32) * 4); f32x4 tg = *(const f32x4*)(TOPG + (size_t)(un * 256 + F.wave * 32) * 4);
        for (int rr = 0; rr < 32; ++rr) {
            const int m = un * 256 + F.wave * 32 + rr; const int mn = rr < 31 ? m + 1 : m;
            const f32x4* gr = (const f32x4*)g + lane;
#pragma unroll
            for (int j = 0; j < 4; ++j) vn[j] = ld4bf(H1 + (size_t)mn * 1024 + 4 * lane + 256 * j);
            const int4 ten = *(const int4*)(TOPE + (size_t)mn * 4), lrn = *(const int4*)(LR + (size_t)mn * 4); const f32x4 tgn = *(const f32x4*)(TOPG + (size_t)mn * 4);
            float s = 0.f;
#pragma unroll
            for (int j = 0; j < 4; ++j) s += (v[j].x * v[j].x + v[j].y * v[j].y) + (v[j].z * v[j].z + v[j].w * v[j].w);
            const float rstd = __builtin_amdgcn_rsqf(wave_sum(s) * (1.f / 1024.f) + EPS);
            unsigned pk[4];
#pragma unroll
            for (int j = 0; j < 4; ++j) { const f32x4 gg = gr[64 * j]; pk[j] = pk4_fp8(v[j].x * rstd * gg.x, v[j].y * rstd * gg.y, v[j].z * rstd * gg.z, v[j].w * rstd * gg.w); }
            int sl[4];
            sl[0] = pst[te.x] + base[te.x] + lr.x; sl[1] = pst[te.y] + base[te.y] + lr.y; sl[2] = pst[te.z] + base[te.z] + lr.z; sl[3] = pst[te.w] + base[te.w] + lr.w;
#pragma unroll
            for (int k = 0; k < 4; ++k) { unsigned* o4 = (unsigned*)((unsigned char*)XBY + (size_t)sl[k] * 1024) + lane;
#pragma unroll
                for (int j = 0; j < 4; ++j) o4[64 * j] = pk[j]; }
            if (lane == 0) { *(int4*)(TOKSLOT + (size_t)m * 4) = make_int4(sl[0], sl[1], sl[2], sl[3]); SLOTG[sl[0]] = tg.x; SLOTG[sl[1]] = tg.y; SLOTG[sl[2]] = tg.z; SLOTG[sl[3]] = tg.w; }
#pragma unroll
            for (int j = 0; j < 4; ++j) v[j] = vn[j];
            te = ten; lr = lrn; tg = tgn;
        }
        __syncthreads();
    }
}

template <bool WITH_MOE>
__device__ __forceinline__ void p_final(Frame& F) {
    const ArgsP A = fresh_args();
    unsigned char* ws = A->ws; const int lane = F.lane;
    float* OUT = A->out; const bf16_t* H1 = (const bf16_t*)(ws + WS_H1B); const float* g = A->in[I_NORM_FINAL_G];
    const int* TOKSLOT = (const int*)(ws + WS_TOKSLOT); const bf16_t* Y = (const bf16_t*)(ws + WS_Y);
    const int gw = F.bid * 8 + F.wave, NGW = F.G * 8;
    const f32x4* gr = (const f32x4*)g + lane;
    f32x4 v[4], vn[4]; unsigned y[4][4], yn[4][4]; int4 sl = make_int4(0, 0, 0, 0), sln = sl;
    if (gw < M) {
        if (WITH_MOE) sl = *(const int4*)(TOKSLOT + (size_t)gw * 4);
#pragma unroll
        for (int j = 0; j < 4; ++j) v[j] = ld4bf(H1 + (size_t)gw * 1024 + 4 * lane + 256 * j);
        if (WITH_MOE) {
            const int sls[4] = {sl.x, sl.y, sl.z, sl.w};
#pragma unroll
            for (int k = 0; k < 4; ++k)
#pragma unroll
                for (int j = 0; j < 4; ++j) y[k][j] = ((const unsigned*)((const unsigned char*)Y + (size_t)sls[k] * 1024) + lane)[64 * j];
            const int m1 = (gw + NGW < M) ? gw + NGW : gw;
            sln = *(const int4*)(TOKSLOT + (size_t)m1 * 4);
        }
    }
    for (int m = gw; m < M; m += NGW) {
        const int m1 = (m + NGW < M) ? m + NGW : m, m2 = (m + 2 * NGW < M) ? m + 2 * NGW : m;
#pragma unroll
        for (int j = 0; j < 4; ++j) vn[j] = ld4bf(H1 + (size_t)m1 * 1024 + 4 * lane + 256 * j);
        int4 sl2 = sln;
        if (WITH_MOE) {
            const int sls[4] = {sln.x, sln.y, sln.z, sln.w};
#pragma unroll
            for (int k = 0; k < 4; ++k)
#pragma unroll
                for (int j = 0; j < 4; ++j) yn[k][j] = ((const unsigned*)((const unsigned char*)Y + (size_t)sls[k] * 1024) + lane)[64 * j];
            sl2 = *(const int4*)(TOKSLOT + (size_t)m2 * 4);
        }
        if (WITH_MOE) {
#pragma unroll
            for (int k = 0; k < 4; ++k)
#pragma unroll
                for (int j = 0; j < 4; ++j) { const int w = (int)y[k][j]; const f32x2 lo = __builtin_amdgcn_cvt_pk_f32_fp8(w, false), hi2 = __builtin_amdgcn_cvt_pk_f32_fp8(w, true); v[j].x += lo.x; v[j].y += lo.y; v[j].z += hi2.x; v[j].w += hi2.y; }
        }
        float s2 = 0.f;
#pragma unroll
        for (int j = 0; j < 4; ++j) s2 += (v[j].x * v[j].x + v[j].y * v[j].y) + (v[j].z * v[j].z + v[j].w * v[j].w);
        const float rstd = __builtin_amdgcn_rsqf(wave_sum(s2) * (1.f / 1024.f) + EPS);
        f32x4* xr = (f32x4*)(OUT + (size_t)m * 1024) + lane;
#pragma unroll
        for (int j = 0; j < 4; ++j) xr[64 * j] = v[j] * rstd * gr[64 * j];
#pragma unroll
        for (int j = 0; j < 4; ++j) v[j] = vn[j];
        if (WITH_MOE) {
#pragma unroll
            for (int k = 0; k < 4; ++k)
#pragma unroll
                for (int j = 0; j < 4; ++j) y[k][j] = yn[k][j];
            sln = sl2;
        }
    }
}

#if DSACHECK
__device__ __forceinline__ float fp8_byte_to_f32(unsigned b) { const f32x2 r = __builtin_amdgcn_cvt_pk_f32_fp8((int)b, false); return r.x; }
__device__ __forceinline__ void dsa_check(Frame& F) {
    const ArgsP A = fresh_args(); unsigned char* ws = A->ws; const int lane = F.lane;
    const unsigned char* QL8 = ws + WS_QL; const unsigned char* K8 = ws + WS_KVR; const u64* MASKW = (const u64*)(ws + WS_MASKW);
    const unsigned char* OL8 = ws + WS_OLAT;
    for (int rep = 0; rep < 2; ++rep) {
        const int b = F.bid & 31, i = (F.bid * 613 + rep * 977 + 5) & 2047, h = F.wave;
        const size_t m = (size_t)b * 2048 + i; const int c = i >> 6, nadm = 80 + 64 * c;
        const unsigned char* q = QL8 + m * 1536 + h * 192;
        const float q0 = fp8_byte_to_f32(q[lane]) * (1.0f / QSC), q1 = fp8_byte_to_f32(q[lane + 64]) * (1.0f / QSC), q2 = (lane < 32) ? fp8_byte_to_f32(q[lane + 128]) * (1.0f / QSC) : 0.f;
        const unsigned char* kvb = K8 + (size_t)b * TPB * 192;
        float mx = -3.0e38f;
        for (int pos = 0; pos < nadm; ++pos) {
            const u64 w = MASKW[m * NKT + (pos >> 6)];
            if (!((w >> (pos & 63)) & 1ull)) continue;
            const unsigned char* kr = kvb + (size_t)pos * 192;
            float sdot = q0 * fp8_byte_to_f32(kr[lane]) + q1 * fp8_byte_to_f32(kr[lane + 64]) + ((lane < 32) ? q2 * fp8_byte_to_f32(kr[lane + 128]) : 0.f);
            sdot = wave_sum(sdot); mx = fmaxf(mx, sdot);
        }
        float l = 0.f, o0 = 0.f, o1 = 0.f;
        for (int pos = 0; pos < nadm; ++pos) {
            const u64 w = MASKW[m * NKT + (pos >> 6)];
            if (!((w >> (pos & 63)) & 1ull)) continue;
            const unsigned char* kr = kvb + (size_t)pos * 192;
            const float k0 = fp8_byte_to_f32(kr[lane]), k1 = fp8_byte_to_f32(kr[lane + 64]);
            float sdot = q0 * k0 + q1 * k1 + ((lane < 32) ? q2 * fp8_byte_to_f32(kr[lane + 128]) : 0.f);
            sdot = wave_sum(sdot);
            const float p = exp2f(sdot - mx); l += p; o0 += p * k0; o1 += p * k1;
        }
        o0 /= l; o1 /= l;
        const unsigned char* orow = OL8 + m * 1024 + h * 128;
        const float g0 = fp8_byte_to_f32(orow[lane]) * (1.0f / OLSC), g1 = fp8_byte_to_f32(orow[lane + 64]) * (1.0f / OLSC);
        const float num = wave_sum((g0 - o0) * (g0 - o0) + (g1 - o1) * (g1 - o1)), den = wave_sum(o0 * o0 + o1 * o1);
        if (!(num <= 0.02f * den) && lane == 0) atomicOr((unsigned*)(ws + WS_CTL) + CW_ERR, 2u);
    }
}
#endif
__global__ void __launch_bounds__(512, 2) fwd_kernel(Args args) {
    volatile LAS unsigned* MISC = (volatile LAS unsigned*)((LAS unsigned char*)lds_raw + MISC_OFF);
    for (int u = threadIdx.x; u < 128; u += 512) MISC[u] = 0u;
    __syncthreads();
    XcdBarrier bar = xcd_barrier_post((unsigned*)(fresh_args()->ws + WS_CTL) + CW_BAR, MISC + 8);
    const int G = gridDim.x, bid = blockIdx.x;
#define GRID_BAR() xcd_barrier(bar)

#if DBG_STAGE == 1
    { Frame F = mkframe(); const ArgsP A = fresh_args(); const int gw = bid * 8 + F.wave, NGW = G * 8;
      for (int m = gw; m < M; m += NGW) { const f32x4* xr = (const f32x4*)(A->in[I_X] + (size_t)m * 1024) + F.lane; f32x4* orow = (f32x4*)(A->out + (size_t)m * 1024) + F.lane;
#pragma unroll
          for (int j = 0; j < 4; ++j) orow[64 * j] = xr[64 * j]; } }
    GRID_BAR();
    { Frame F = mkframe(); p_final<false>(F); }
#else
    PH(0) REPBEG(0) { Frame F = mkframe(); p0_prologue(F); } REPEND(0)
    GRID_BAR();
    PH(1) REPBEG(1) {
        Frame F = mkframe(); const ArgsP A = fresh_args(); unsigned char* const ws = A->ws;
        const bool gates_first = ((bid >> 3) & 1) != 0;
#pragma unroll 1
        for (int hf = 0; hf < 2; ++hf) {
            if ((hf == 0) != gates_first) {
                pg8::DenseSched S; S.init(ws + WS_XN, ws + WS_WIN_T, M, 2048, 1024, G, bid);
                EpiProj E{(bf16_t*)(ws + WS_QA), (bf16_t*)(ws + WS_KA), (bf16_t*)(ws + WS_VA), (bf16_t*)(ws + WS_CQ), (bf16_t*)(ws + WS_SGA), (bf16_t*)(ws + WS_SGB), (float*)(ws + WS_T7)};
                pg8::gemm_phase<EpiProj, pg8::DenseSched, true, true>(F.lds, 1024, S, E);
            } else {
                pg8::DenseSched S; S.init(ws + WS_XN8, ws + WS_WIN8, M, 2048, 512, G, bid);
                EpiGate E{(bf16_t*)(ws + WS_SGA), (bf16_t*)(ws + WS_SGB)};
                int k8 = 512; asm volatile("" : "+s"(k8));
                pg8::gemm_phase<EpiGate, pg8::DenseSched, true, true, true>(F.lds, k8, S, E);
            }
        }
    } REPEND(1)
    GRID_BAR();
    PH(2) REPBEG(2) { Frame F = mkframe(); p2_post(F); } REPEND(2)
    GRID_BAR();
    PH(3) REPBEG(3) {
        Frame F = mkframe(); const ArgsP A = fresh_args(); unsigned char* const ws = A->ws;
        int kq = 256; asm volatile("" : "+s"(kq));
        {
            pg8::DenseSched S; S.init(ws + WS_CQ, ws + WS_WQ2_T, M, 1024, 256, G, bid);
            EpiQLat E{(bf16_t*)(ws + WS_QL), (const float*)(ws + WS_RSTDQ)};
            pg8::gemm_phase<EpiQLat, pg8::DenseSched, true, true>(F.lds, kq, S, E);
        }
        {
            pg8::DenseSched S; S.init(ws + WS_CQ, ws + WS_WQ2_T + (size_t)1024 * 256 * 2, M, 512, 256, G, bid);
            EpiQ E{(bf16_t*)(ws + WS_QL), (bf16_t*)(ws + WS_QIDX), (const float*)(ws + WS_RSTDQ), (const float*)(ws + WS_COS), (const float*)(ws + WS_SIN), 4};
            pg8::gemm_phase<EpiQ, pg8::DenseSched, true, true>(F.lds, kq, S, E);
        }
        vt8_build(F);
    } REPEND(3)
    GRID_BAR();
    PH(4) REPBEG(4) { Frame F = mkframe(); for (int p = bid; p < 1024; p += G) {
        const int bh = p >> 2, s = p & 3;
        fox_unit(F, bh >> 3, bh & 7, s);
        fox_unit(F, bh >> 3, bh & 7, 7 - s);
    } } REPEND(4)
    PH(5) REPBEG(5) { Frame F = mkframe(); for (int p = bid; p < 2048; p += G) {
        const int g16 = p & 3, cc = (p >> 2) & 15, b = p >> 6;
        idx_unit(F, b, cc, g16);
        idx_unit(F, b, 31 - cc, g16);
    } } REPEND(5)
    GRID_BAR();
    PH(6) REPBEG(6) { Frame F = mkframe(); for (int p = bid; p < 1024; p += G) {
        int half = p & 1, cc = (p >> 1) & 15, b = p >> 5;
        if (G == 256) { const int r = bid >> 3, k2 = p >> 8; b = (bid & 7) + 8 * k2; cc = r >> 1; half = r & 1; }
        dsa_unit(F, b, cc, half);
        dsa_unit(F, b, 31 - cc, half);
    } } REPEND(6)
    GRID_BAR();
#if DSACHECK
    { Frame F = mkframe(); dsa_check(F); }
#endif
    PH(7) {
        Frame F = mkframe(); const ArgsP A = fresh_args(); unsigned char* const ws = A->ws;
        pg8::DenseSched S; S.init(ws + WS_OA, ws + WS_WA_T, M, 1024, 512, G, bid);
        EpiBranch<false> E{(bf16_t*)(ws + WS_SGA), nullptr, 1.0f};
        pg8::gemm_phase<EpiBranch<false>, pg8::DenseSched, true, true>(F.lds, 512, S, E);
    }
    PH(8) {
        Frame F = mkframe(); const ArgsP A = fresh_args(); unsigned char* const ws = A->ws;
        pg8::DenseSched S; S.init(ws + WS_OLAT, ws + WS_WOB_T, M, 1024, 512, G, bid);
        EpiBranch<true> E{(bf16_t*)(ws + WS_SGA), (const bf16_t*)(ws + WS_SGB), 1.0f / (WSC * OLSC)};
        int k8 = 512; asm volatile("" : "+s"(k8));
        pg8::gemm_phase<EpiBranch<true>, pg8::DenseSched, true, true, true>(F.lds, k8, S, E);
    }
    GRID_BAR();
    PH(9) REPBEG(9) {
        Frame F = mkframe(); const ArgsP A = fresh_args(); unsigned char* const ws = A->ws;
        pg8::DenseSched S; S.init(ws + WS_SGA, ws + WS_WOUT_T, M, 1024, 1024, G, bid);
        EpiOut E{A->in[I_X], (bf16_t*)(A->ws + WS_H1B)};
        pg8::gemm_phase<EpiOut, pg8::DenseSched, true, true>(F.lds, 1024, S, E);
    } REPEND(9)
    GRID_BAR();
#if DBG_STAGE == 2
    { Frame F = mkframe(); p_final<false>(F); }
#else
    PH(10) REPBEG(10) {
        Frame F = mkframe(); const ArgsP A = fresh_args(); unsigned char* const ws = A->ws;
        LAS float* scr = (LAS float*)(F.lds + F.wave * 16384);
        const int gw = bid * 8 + F.wave, NGW = G * 8;
        constexpr int I_GU = 16 * 32, I_D = 16 * 16;
        const float* w_gu = A->in[I_W_GU]; const float* w_dn = A->in[I_W_DOWN]; const int lane = F.lane;
        LAS float* scr2 = (LAS float*)(F.lds + F.wave * 17408);
        int ncv = (P8REP & 1) ? 2 : 1; asm volatile("" : "+s"(ncv));
        for (int rcv = 0; rcv < ncv; ++rcv)
        tr2_run(gw, NGW, 32 * (I_GU + I_D), scr2, lane, [&](int it) {
            TrItem2 t; const int e = it / (I_GU + I_D); int r = it % (I_GU + I_D);
            if (r < I_GU) { t.W = w_gu + (size_t)e * 1024 * 2048; t.WT = ws + WS_WGU_T + (size_t)e * 2048 * 1024; t.K = 1024; t.N = 2048; t.dr0 = (r % 32) * 64; t.k0 = (r / 32) * 64; t.sc0 = MapGU()(t.dr0); return t; }
            r -= I_GU; t.W = w_dn + (size_t)e * 1024 * 1024; t.WT = ws + WS_WD_T + (size_t)e * 1024 * 1024; t.K = 1024; t.N = 1024; t.dr0 = (r % 16) * 64; t.k0 = (r / 16) * 64; t.sc0 = t.dr0; return t; });
        __syncthreads();
        { int nrt = (P8REP & 2) ? 2 : 1; asm volatile("" : "+s"(nrt)); for (int rrt = 0; rrt < nrt; ++rrt) { p8_router(F); __syncthreads(); } }
    } REPEND(10)
    GRID_BAR();
    PH(11) REPBEG(11) { Frame F = mkframe(); p9_slots(F); } REPEND(11)
    GRID_BAR();
    PH(12) {
        Frame F = mkframe(); const ArgsP A = fresh_args(); unsigned char* const ws = A->ws;
        const int* GRP = (const int*)(ws + WS_GRP);
        const int ng = __builtin_amdgcn_readfirstlane(ld_agent_i(GRP));
        LAS int* te_lds = (LAS int*)(F.lds + 131072);
        { const int ntl = __builtin_amdgcn_readfirstlane(ld_agent_i(GRP + 1));
          for (int i2 = F.tid; i2 < ntl; i2 += 512) te_lds[i2] = ld_agent_i((const int*)(ws + WS_TILEE) + i2);
          __syncthreads(); }
        for (int gi = 0; gi < ng; ++gi) {
            const int t_lo = __builtin_amdgcn_readfirstlane(ld_agent_i(GRP + 4 + gi)), t_hi = __builtin_amdgcn_readfirstlane(ld_agent_i(GRP + 4 + MAXG + gi));
            {
                pg8::GroupSched<8, 1024> S; S.A = (const char*)(ws + WS_XBY); S.Bt = (const char*)(ws + WS_WGU_T);
                S.tile_e = te_lds; S.t_lo = t_lo; S.a_t0 = 0; S.nun = (t_hi - t_lo) * 8; S.G = G; S.c = bid;
                EpiGateUp E{(bf16_t*)(ws + WS_ACT), A->in[I_B_GU], t_lo};
                int nr_ = NREP(14); asm volatile("" : "+s"(nr_));
                int k8 = 512; asm volatile("" : "+s"(k8));
                for (int rp = 0; rp < nr_; ++rp) { pg8::gemm_phase<EpiGateUp, pg8::GroupSched<8, 1024>, true, true, true>(F.lds, 512, S, E); if (rp + 1 < nr_) GRID_BAR(); }
            }
            GRID_BAR();
            {
                pg8::GroupSched<4, 1024> S; S.A = (const char*)(ws + WS_ACT); S.Bt = (const char*)(ws + WS_WD_T);
                S.tile_e = te_lds; S.t_lo = t_lo; S.a_t0 = t_lo; S.nun = (t_hi - t_lo) * 4; S.G = G; S.c = bid;
                EpiDown E{(bf16_t*)(ws + WS_Y), A->in[I_B_DOWN], (const float*)(ws + WS_SLOTG)};
                int nr_ = NREP(15); asm volatile("" : "+s"(nr_));
                int k8 = 512; asm volatile("" : "+s"(k8));
                for (int rp = 0; rp < nr_; ++rp) { pg8::gemm_phase<EpiDown, pg8::GroupSched<4, 1024>, true, true, true>(F.lds, 512, S, E); if (rp + 1 < nr_) GRID_BAR(); }
            }
            GRID_BAR();
        }
    }
    PH(13) { Frame F = mkframe(); p_final<true>(F); }
#if SELCHECK || DSACHECK
    GRID_BAR();
    { const ArgsP A = fresh_args(); if (ld_agent((const unsigned*)(A->ws + WS_CTL) + CW_ERR) != 0u) { for (size_t i2 = (size_t)blockIdx.x * 512 + threadIdx.x; i2 < (size_t)M * 1024; i2 += (size_t)gridDim.x * 512) A->out[i2] = 1.0e30f; } }
#endif
#endif
#endif
}

extern "C" void kernel_launch(void* const* d_in, const int* in_sizes, int n_in, void* d_out, int out_size, void* d_ws, size_t ws_size, hipStream_t stream) {
    static int grid = 0;
    if (grid == 0) {
        if (n_in != 24 || out_size != M * DM || ws_size < WS_END) { fprintf(stderr, "kernel_launch: unexpected shapes: n_in %d out %d ws %zu\n", n_in, out_size, ws_size); grid = -1; return; }
        int dev = 0, cus = 0, per_cu = 0;
        if (hipGetDevice(&dev) != hipSuccess || hipDeviceGetAttribute(&cus, hipDeviceAttributeMultiprocessorCount, dev) != hipSuccess) { grid = -1; return; }
        if (hipFuncSetAttribute((const void*)fwd_kernel, hipFuncAttributeMaxDynamicSharedMemorySize, LDS_BYTES) != hipSuccess) { fprintf(stderr, "kernel_launch: hipFuncSetAttribute failed\n"); grid = -1; return; }
        if (hipOccupancyMaxActiveBlocksPerMultiprocessor(&per_cu, (const void*)fwd_kernel, 512, LDS_BYTES) != hipSuccess || per_cu < 1) { fprintf(stderr, "kernel_launch: occupancy query says %d\n", per_cu); }
        (void)hipGetLastError();
        grid = cus;
    }
    if (grid < 0) return;
    (void)hipMemsetAsync((char*)d_ws + WS_CTL, 0, CTL_ZERO_BYTES, stream);
    Args a{};
    for (int i = 0; i < 24; ++i) a.in[i] = (const float*)d_in[i];
    a.out = (float*)d_out; a.ws = (unsigned char*)d_ws; a.ph_lo = 0; a.ph_hi = 0;
    hipLaunchKernelGGL(fwd_kernel, dim3(grid), dim3(512), LDS_BYTES, stream, a);
}
```
